# Optimizing an MI355X kernel written in HIP

```python
import math
import jax, jax.numpy as jnp
from jax import lax
import numpy as np

D_MODEL = 1024
BATCH = 4
SEQ = 8192
DEPTH = 2

A_HEADS = 4
A_QK_DIM = 64
A_V_DIM = 2 * A_QK_DIM
A_QK_COLS = A_HEADS * 2 * A_QK_DIM
A_WIDTH = A_HEADS * A_V_DIM
ROPE_THETA = 500000.0
ROPE_DIM = A_QK_DIM // 4
Q_BLOCK = 128
NEG_INF = -1e30
C_WIDTH = 512
CONV_WIDTH = 3
R_HEADS = 4
R_QK_DIM = 64
R_V_DIM = 2 * R_QK_DIM
R_QK_COLS = R_HEADS * R_QK_DIM
R_WIDTH = R_HEADS * R_V_DIM
R_CHUNK = 128
RET_THETA = 10000.0
N_BRANCH = 3
BRANCH_WIDTH = 512
EPS = 1e-6

SPLIT_SIZES = (A_QK_COLS, A_QK_COLS, A_WIDTH, A_WIDTH,
               C_WIDTH, C_WIDTH, C_WIDTH, C_WIDTH,
               R_QK_COLS, R_QK_COLS, R_WIDTH, R_WIDTH,
               N_BRANCH * D_MODEL)
IN_COLS = sum(SPLIT_SIZES)

kernel_name = "gated_parallel_diffattn_shortconv_retention"


def rms_norm(x, g=None):
    xf = x.astype(jnp.float32)
    y = xf * lax.rsqrt(jnp.mean(xf * xf, axis=-1, keepdims=True) + EPS)
    return y if g is None else y * g.astype(jnp.float32)


def rotate(x, cos, sin):
    x1, x2 = jnp.split(x, 2, axis=-1)
    return jnp.concatenate([x1 * cos - x2 * sin, x2 * cos + x1 * sin], axis=-1)


def diff_attention(q, k, v, lam, subln_g, lam_init):
    b, s = q.shape[0], q.shape[1]
    pos = jnp.arange(s, dtype=jnp.float32)
    inv = ROPE_THETA ** (-jnp.arange(0, ROPE_DIM, 2, dtype=jnp.float32) / ROPE_DIM)
    ang = pos[:, None] * inv[None, :]
    cos = jnp.cos(ang)[:, None, None, :]
    sin = jnp.sin(ang)[:, None, None, :]
    q = jnp.concatenate([rotate(q[..., :ROPE_DIM], cos, sin), q[..., ROPE_DIM:]], axis=-1)
    k = jnp.concatenate([rotate(k[..., :ROPE_DIM], cos, sin), k[..., ROPE_DIM:]], axis=-1)
    q = q * (A_QK_DIM ** -0.5)
    kh = k.transpose(0, 2, 3, 1, 4)
    vh = v.transpose(0, 2, 1, 3)
    nb = s // Q_BLOCK
    qb = q.transpose(0, 2, 3, 1, 4).reshape(b, A_HEADS, 2, nb, Q_BLOCK, A_QK_DIM)
    qb = qb.transpose(3, 0, 1, 2, 4, 5)
    kpos = jnp.arange(s)

    def block(args):
        qi, start = args
        sc = jnp.einsum('bhcqd,bhckd->bhcqk', qi, kh).astype(jnp.float32)
        qpos = start + jnp.arange(Q_BLOCK)
        mask = kpos[None, :] <= qpos[:, None]
        p = jax.nn.softmax(jnp.where(mask, sc, NEG_INF), axis=-1)
        w = p[:, :, 0] - lam * p[:, :, 1]
        return jnp.einsum('bhqk,bhkv->bhqv', w, vh)

    out = lax.map(block, (qb, jnp.arange(nb, dtype=jnp.int32) * Q_BLOCK))
    out = out.transpose(1, 0, 3, 2, 4).reshape(b, s, A_HEADS, A_V_DIM)
    out = rms_norm(out, subln_g) * (1.0 - lam_init)
    return out.reshape(b, s, A_WIDTH)


def short_conv(x_in, gate_b, gate_c, w):
    u = gate_c * x_in
    y = lax.conv_general_dilated(u, w[:, None, :].astype(u.dtype), window_strides=(1,),
                                 padding=[(CONV_WIDTH - 1, 0)],
                                 dimension_numbers=('NWC', 'WIO', 'NWC'),
                                 feature_group_count=C_WIDTH)
    return gate_b * y


def retention(q, k, v):
    b, s = q.shape[0], q.shape[1]
    pos = jnp.arange(s, dtype=jnp.float32)
    inv = 1.0 / (RET_THETA ** jnp.linspace(0.0, 1.0, R_QK_DIM // 2, dtype=jnp.float32))
    ang = pos[:, None] * inv[None, :]
    cos = jnp.cos(ang)[:, None, :]
    sin = jnp.sin(ang)[:, None, :]
    q = rotate(q, cos, sin)
    k = rotate(k, cos, sin) * (R_QK_DIM ** -0.5)
    log_g = jnp.log(1.0 - 2.0 ** (-5.0 - jnp.arange(R_HEADS, dtype=jnp.float32)))
    nc = s // R_CHUNK

    def chunks(t):
        return t.reshape(b, nc, R_CHUNK, R_HEADS, t.shape[-1]).transpose(0, 3, 1, 2, 4)

    qc, kc, vc = chunks(q), chunks(k), chunks(v)
    idx = jnp.arange(R_CHUNK, dtype=jnp.float32)
    diff = idx[:, None] - idx[None, :]
    dmask = jnp.where(diff >= 0,
                      jnp.exp(jnp.where(diff >= 0, diff, 0.0)[None] * log_g[:, None, None]),
                      0.0)
    inner = jnp.einsum('bhncd,bhnmd->bhncm', qc, kc) * dmask[None, :, None]
    inner = jnp.einsum('bhncm,bhnme->bhnce', inner, vc)
    zeta = jnp.exp((R_CHUNK - 1 - idx)[None, :] * log_g[:, None])
    kv = jnp.einsum('bhnmd,bhnme->bhnde', kc * zeta[None, :, None, :, None], vc)
    chunk_decay = jnp.exp(R_CHUNK * log_g)[None, :, None, None]

    def step(state, kv_n):
        return (chunk_decay * state + kv_n).astype(kv_n.dtype), state

    init = jnp.zeros((b, R_HEADS, R_QK_DIM, R_V_DIM), kv.dtype)
    _, prev = lax.scan(step, init, kv.transpose(2, 0, 1, 3, 4))
    prev = prev.transpose(1, 2, 0, 3, 4)
    xi = jnp.exp((idx + 1.0)[None, :] * log_g[:, None])
    cross = jnp.einsum('bhncd,bhnde->bhnce', qc, prev) * xi[None, :, None, :, None]
    out = (inner + cross).transpose(0, 2, 3, 1, 4).reshape(b, s, R_HEADS, R_V_DIM)
    out = rms_norm(out)
    return out.reshape(b, s, R_WIDTH)


def hybrid_layer(x, norm_g, w_in, attn_lambda, attn_subln_g, conv_w, w_branch, w_out, layer):
    b, s, _ = x.shape
    h = rms_norm(x, norm_g)
    proj = h @ w_in
    split_points = [int(p) for p in np.cumsum(SPLIT_SIZES)[:-1]]
    (aq, ak, av, az, cx, cb, cc, cz, rq, rk, rv, rz, gates) = jnp.split(proj, split_points, axis=-1)

    lam_init = 0.8 - 0.6 * math.exp(-0.3 * layer)
    lp = attn_lambda.astype(jnp.float32)
    lam = jnp.exp(jnp.sum(lp[0] * lp[1])) - jnp.exp(jnp.sum(lp[2] * lp[3])) + lam_init
    a = diff_attention(aq.reshape(b, s, A_HEADS, 2, A_QK_DIM),
                       ak.reshape(b, s, A_HEADS, 2, A_QK_DIM),
                       av.reshape(b, s, A_HEADS, A_V_DIM),
                       lam, attn_subln_g, lam_init) * jax.nn.silu(az)
    c = short_conv(cx, cb, cc, conv_w) * jax.nn.silu(cz)
    r = retention(rq.reshape(b, s, R_HEADS, R_QK_DIM),
                  rk.reshape(b, s, R_HEADS, R_QK_DIM),
                  rv.reshape(b, s, R_HEADS, R_V_DIM)) * jax.nn.silu(rz)

    g = jax.nn.sigmoid(gates.astype(jnp.float32)).reshape(b, s, N_BRANCH, D_MODEL)
    branches = (a, c, r)
    merged = g[:, :, 0] * (branches[0] @ w_branch[0])
    for i in range(1, N_BRANCH):
        merged = merged + g[:, :, i] * (branches[i] @ w_branch[i])
    return x + (merged @ w_out).astype(x.dtype)


def setup_inputs(seed: int = 0) -> dict:
    key = jax.random.key(seed)
    ks = jax.random.split(key, 10)
    f32 = jnp.float32
    x = jax.random.normal(ks[0], (BATCH, SEQ, D_MODEL), f32)
    norm_g = 1.0 + 0.01 * jax.random.normal(ks[1], (DEPTH, D_MODEL), f32)
    w_in = jax.random.normal(ks[2], (DEPTH, D_MODEL, IN_COLS), f32) * D_MODEL ** -0.5
    attn_lambda = 0.1 * jax.random.normal(ks[3], (DEPTH, 4, A_QK_DIM), f32)
    attn_subln_g = 1.0 + 0.01 * jax.random.normal(ks[4], (DEPTH, A_V_DIM), f32)
    conv_w = jax.random.normal(ks[5], (DEPTH, CONV_WIDTH, C_WIDTH), f32) * CONV_WIDTH ** -0.5
    w_branch = jax.random.normal(ks[6], (DEPTH, N_BRANCH, BRANCH_WIDTH, D_MODEL), f32) * BRANCH_WIDTH ** -0.5
    w_out = jax.random.normal(ks[7], (DEPTH, D_MODEL, D_MODEL), f32) * D_MODEL ** -0.5
    final_norm_g = 1.0 + 0.01 * jax.random.normal(ks[8], (D_MODEL,), f32)
    return {"x": x, "norm_g": norm_g, "w_in": w_in, "attn_lambda": attn_lambda,
            "attn_subln_g": attn_subln_g, "conv_w": conv_w, "w_branch": w_branch,
            "w_out": w_out, "final_norm_g": final_norm_g}


def reference(x, norm_g, w_in, attn_lambda, attn_subln_g, conv_w, w_branch, w_out, final_norm_g):
    for layer in range(DEPTH):
        x = hybrid_layer(x, norm_g[layer], w_in[layer], attn_lambda[layer], attn_subln_g[layer],
                         conv_w[layer], w_branch[layer], w_out[layer], layer)
    return rms_norm(x, final_norm_g).astype(x.dtype)
```

```cpp
#include <hip/hip_runtime.h>
#include <hip/hip_cooperative_groups.h>
#include <hip/hip_bf16.h>
#include <cstdio>
#include <cstdint>
#include <cmath>
namespace cg = cooperative_groups;
namespace pg8 {
#define PG8_LAS __attribute__((address_space(3)))
typedef unsigned short bf16_t;
typedef short bf16x8 __attribute__((ext_vector_type(8)));
typedef float f32x4 __attribute__((ext_vector_type(4)));
typedef unsigned u32x4 __attribute__((ext_vector_type(4)));
constexpr int BM = 256, BK = 64, HALF = 128, HTB = HALF * BK * 2  , STAGE_BYTES = 8 * HTB, NXCD = 8, WGM = 8;

__host__ __device__ __forceinline__ int lds_byte(int r, int c) { const int st = (r >> 4) * 2 + (c >> 5), rr = r & 15, cc = c & 31, ob = rr * 64 + cc * 2; return st * 1024 + (ob ^ (((ob >> 9) & 1) << 5)); }
__host__ __device__ __forceinline__ void stage_rc(int b, int& R, int& C) { const int st = b / 1024, sb = b % 1024, swz = sb ^ (((sb >> 9) & 1) << 5); R = (st >> 1) * 16 + swz / 64; C = (st & 1) * 32 + (swz % 64) / 2; }
__host__ __device__ __forceinline__ int perm32(int rho) { const int n = rho >> 4, i = rho & 15; return 8 * (i >> 2) + 4 * n + (i & 3); }

struct Unit { int pm, pn, seg; };
struct Gemm { const bf16_t* A0; const bf16_t* A1; const bf16_t* A2; const bf16_t* Bt; size_t bseg  ; int M, N, K; };
__device__ __forceinline__ const char* gemm_abase(const Gemm& g, int seg) { return (const char*)(seg == 0 ? g.A0 : (seg == 1 ? g.A1 : g.A2)); }

struct StaticOrder {
    int nM, nN, nwg, G, c;
    __host__ __device__ void init(int M, int N, int G_, int c_) { nM = M / BM; nN = N / BM; nwg = nM * nN; G = G_; c = c_; }
    __host__ __device__ bool next(int i, Unit& u) const {
        const long L = (long)i * G + c; if (L >= nwg) return false;
        int wgid = (int)L; { const int q = nwg / NXCD, r = nwg % NXCD, xcd = wgid % NXCD, off = wgid / NXCD; wgid = (xcd < r ? xcd * (q + 1) : r * (q + 1) + (xcd - r) * q) + off; }
        const int nig = WGM * nN, gid = wgid / nig, fm = gid * WGM, gsz = (nM - fm) < WGM ? (nM - fm) : WGM;
        u.pm = fm + ((wgid % nig) % gsz); u.pn = (wgid % nig) / gsz; u.seg = 0; return true;
    }
    __device__ __forceinline__ void a_ready(const Unit&) const {}
    __device__ __forceinline__ void done(const Unit&) const {}
};

__device__ __forceinline__ unsigned cvt_pk_bf16(float lo, float hi) { unsigned r; asm volatile("v_cvt_pk_bf16_f32 %0, %1, %2" : "=v"(r) : "v"(lo), "v"(hi)); return r; }
typedef float f32x2 __attribute__((ext_vector_type(2)));
template <class Epi, class Sched, bool ALIGN_EPI = false, bool SP2 = false>
__device__ __forceinline__ void gemm_phase(PG8_LAS unsigned char* lds, const Gemm g, const Sched& S, const Epi& E) {
    int tid = threadIdx.x; asm volatile("" : "+v"(tid));
    const int wid = __builtin_amdgcn_readfirstlane(tid >> 6), lane = tid & 63, wr = wid >> 2, wc = wid & 3, fr = lane & 15, fq = lane >> 4;
    const int K = g.K, nt = K / BK;
    unsigned voffA[2], voffB[2];
#pragma unroll
    for (int i = 0; i < 2; ++i) { int R, C; stage_rc(tid * 16 + i * 8192, R, C); const int Rb = Epi::PERM ? ((R & ~31) + perm32(R & 31)) : R;
        voffA[i] = (unsigned)(R * K + C) * 2u; voffB[i] = (unsigned)(Rb * K + C) * 2u; }
    const size_t kstep = (size_t)(BK * 2);
    const size_t hstep = (size_t)HALF * K * 2;
    const size_t tstep = 2 * hstep;
    const unsigned ldsw = (unsigned)wid * 1024u;
    const int aoff = lds_byte(wr * 64 + fr, fq * 8), boff = lds_byte(wc * 32 + fr, fq * 8);
#define PG8_SA(b, h) (((b) * 2 + (h)) * HTB)
#define PG8_SB(b, h) ((4 + (b) * 2 + (h)) * HTB)
#define PG8_STAGE(bufoff, gbase, voff) do { _Pragma("unroll") for (int _i = 0; _i < 2; ++_i) \
        __builtin_amdgcn_global_load_lds((const unsigned*)((const char*)(gbase) + (voff)[_i]), (PG8_LAS unsigned*)(lds + (bufoff) + ldsw + _i * 8192), 16, 0, 0); } while (0)
#define PG8_LDA(dst, b, h) do { _Pragma("unroll") for (int m = 0; m < 4; ++m) _Pragma("unroll") for (int k = 0; k < 2; ++k) dst[m][k] = *(const PG8_LAS bf16x8*)(lds + PG8_SA(b, h) + aoff + m * 2048 + k * 1024); } while (0)
#define PG8_LDB(dst, b, h) do { _Pragma("unroll") for (int n = 0; n < 2; ++n) _Pragma("unroll") for (int k = 0; k < 2; ++k) dst[n][k] = *(const PG8_LAS bf16x8*)(lds + PG8_SB(b, h) + boff + n * 2048 + k * 1024); } while (0)
#define PG8_MMA(ai, bj, At, Bt) do { __builtin_amdgcn_s_setprio(1); _Pragma("unroll") for (int m = 0; m < 4; ++m) _Pragma("unroll") for (int n = 0; n < 2; ++n) _Pragma("unroll") for (int k = 0; k < 2; ++k) \
        acc[ai][bj][m][n] = __builtin_amdgcn_mfma_f32_16x16x32_bf16(Bt[n][k], At[m][k], acc[ai][bj][m][n], 0, 0, 0); __builtin_amdgcn_s_setprio(0); } while (0)
#define PG8_WAIT_V(n) asm volatile("s_waitcnt vmcnt(" #n ")" ::: "memory")
#define PG8_WAIT_L(n) asm volatile("s_waitcnt lgkmcnt(" #n ")" ::: "memory")
#define PG8_BAR __builtin_amdgcn_s_barrier()
#define PG8_SCHED __builtin_amdgcn_sched_barrier(0)
    Unit cur, nxt; int ui = 0;
    if (!S.next(0, cur)) return;
    f32x4 acc[2][2][4][2];
#pragma unroll
    for (int a = 0; a < 2; ++a)
#pragma unroll
        for (int b = 0; b < 2; ++b)
#pragma unroll
            for (int m = 0; m < 4; ++m)
#pragma unroll
                for (int n = 0; n < 2; ++n) acc[a][b][m][n] = (f32x4){0.f, 0.f, 0.f, 0.f};
    bf16x8 At[4][2], B0[2][2], B1[2][2];
    const char* cA = gemm_abase(g, cur.seg) + (size_t)cur.pm * tstep; const char* cB = (const char*)g.Bt + (size_t)cur.seg * g.bseg + (size_t)cur.pn * tstep;
    S.a_ready(cur);
    if constexpr (SP2) {
        PG8_STAGE(PG8_SB(0, 0), cB, voffB); PG8_STAGE(PG8_SB(0, 1), cB + hstep, voffB); PG8_STAGE(PG8_SA(0, 0), cA, voffA); PG8_STAGE(PG8_SA(0, 1), cA + hstep, voffA);
        if (wr == 1) PG8_BAR;
        PG8_WAIT_V(2); PG8_BAR;
        PG8_STAGE(PG8_SB(1, 0), cB + kstep, voffB); PG8_STAGE(PG8_SA(1, 0), cA + kstep, voffA); PG8_STAGE(PG8_SB(1, 1), cB + hstep + kstep, voffB);
        PG8_WAIT_V(6); PG8_BAR;
    } else {
        PG8_STAGE(PG8_SB(0, 0), cB, voffB); PG8_STAGE(PG8_SA(0, 0), cA, voffA); PG8_STAGE(PG8_SB(0, 1), cB + hstep, voffB); PG8_STAGE(PG8_SA(0, 1), cA + hstep, voffA);
        if (wr == 1) PG8_BAR;
        PG8_WAIT_V(4); PG8_BAR;
        PG8_STAGE(PG8_SB(1, 0), cB + kstep, voffB); PG8_STAGE(PG8_SA(1, 0), cA + kstep, voffA); PG8_STAGE(PG8_SB(1, 1), cB + hstep + kstep, voffB);
        PG8_WAIT_V(6); PG8_BAR;
    }
    for (;;) {
        const bool has_next = S.next(ui + 1, nxt);
        const char* nA = has_next ? gemm_abase(g, nxt.seg) + (size_t)nxt.pm * tstep : cA; const char* nB = has_next ? (const char*)g.Bt + (size_t)nxt.seg * g.bseg + (size_t)nxt.pn * tstep : cB;
        for (int t = 0; t < nt; t += 2) {
            const bool last = (t == nt - 2);
            const char* a1 = cA + (size_t)(t + 1) * kstep;
            const char* a2 = last ? nA : cA + (size_t)(t + 2) * kstep; const char* b2 = last ? nB : cB + (size_t)(t + 2) * kstep;
            const char* a3 = a2 + kstep; const char* b3 = b2 + kstep;
            if (last && has_next) S.a_ready(nxt);
            if constexpr (SP2) {
            PG8_LDB(B0, 0, 0); PG8_LDB(B1, 0, 1); PG8_SCHED; PG8_LDA(At, 0, 0); PG8_STAGE(PG8_SA(1, 1), a1 + hstep, voffA);
            PG8_WAIT_V(8); PG8_WAIT_L(0); PG8_BAR; PG8_MMA(0, 0, At, B0); PG8_MMA(0, 1, At, B1); PG8_BAR; PG8_SCHED;
            PG8_LDA(At, 0, 1); PG8_STAGE(PG8_SB(0, 0), b2, voffB); PG8_STAGE(PG8_SB(0, 1), b2 + hstep, voffB); PG8_STAGE(PG8_SA(0, 0), a2, voffA);
            PG8_WAIT_V(8); PG8_WAIT_L(0); PG8_BAR; PG8_MMA(1, 0, At, B0); PG8_MMA(1, 1, At, B1); PG8_BAR; PG8_SCHED;
            PG8_LDB(B0, 1, 0); PG8_LDB(B1, 1, 1); PG8_SCHED; PG8_LDA(At, 1, 0); PG8_STAGE(PG8_SA(0, 1), a2 + hstep, voffA);
            PG8_WAIT_V(8); PG8_WAIT_L(0); PG8_BAR; PG8_MMA(0, 0, At, B0); PG8_MMA(0, 1, At, B1); PG8_BAR; PG8_SCHED;
            PG8_LDA(At, 1, 1); PG8_STAGE(PG8_SB(1, 0), b3, voffB); PG8_STAGE(PG8_SB(1, 1), b3 + hstep, voffB); PG8_STAGE(PG8_SA(1, 0), a3, voffA);
            PG8_WAIT_V(8); PG8_WAIT_L(0); PG8_BAR; PG8_MMA(1, 0, At, B0); PG8_MMA(1, 1, At, B1); PG8_BAR; PG8_SCHED;
            } else {
            PG8_LDB(B0, 0, 0); PG8_SCHED; PG8_LDA(At, 0, 0); PG8_STAGE(PG8_SA(1, 1), a1 + hstep, voffA);
            PG8_WAIT_L(8); PG8_BAR; PG8_WAIT_L(0); PG8_MMA(0, 0, At, B0); PG8_BAR; PG8_SCHED;
            PG8_LDB(B1, 0, 1); PG8_STAGE(PG8_SB(0, 0), b2, voffB);
            PG8_BAR; PG8_WAIT_L(0); PG8_MMA(0, 1, At, B1); PG8_BAR;
            PG8_LDA(At, 0, 1); PG8_STAGE(PG8_SA(0, 0), a2, voffA);
            PG8_BAR; PG8_WAIT_L(0); PG8_MMA(1, 0, At, B0); PG8_BAR; PG8_SCHED;
            PG8_STAGE(PG8_SB(0, 1), b2 + hstep, voffB);
            PG8_WAIT_V(6); PG8_BAR; PG8_MMA(1, 1, At, B1); PG8_BAR;
            PG8_LDB(B0, 1, 0); PG8_SCHED; PG8_LDA(At, 1, 0); PG8_STAGE(PG8_SA(0, 1), a2 + hstep, voffA);
            PG8_WAIT_L(8); PG8_BAR; PG8_WAIT_L(0); PG8_MMA(0, 0, At, B0); PG8_BAR; PG8_SCHED;
            PG8_LDB(B1, 1, 1); PG8_STAGE(PG8_SB(1, 0), b3, voffB);
            PG8_BAR; PG8_WAIT_L(0); PG8_MMA(0, 1, At, B1); PG8_BAR;
            PG8_LDA(At, 1, 1); PG8_STAGE(PG8_SA(1, 0), a3, voffA);
            PG8_BAR; PG8_WAIT_L(0); PG8_MMA(1, 0, At, B0); PG8_BAR; PG8_SCHED;
            PG8_STAGE(PG8_SB(1, 1), b3 + hstep, voffB);
            PG8_WAIT_V(6); PG8_BAR; PG8_MMA(1, 1, At, B1); PG8_BAR;
            }
        }
        if constexpr (ALIGN_EPI) { if (wr == 0) PG8_BAR; }
        if constexpr (!Epi::AFTER_DRAIN) { E(acc, cur, wr, wc, fr, fq); S.done(cur); }
        if (!has_next) break;
        if (!E.keep(cur)) {
#pragma unroll
        for (int a = 0; a < 2; ++a)
#pragma unroll
            for (int b = 0; b < 2; ++b)
#pragma unroll
                for (int m = 0; m < 4; ++m)
#pragma unroll
                    for (int n = 0; n < 2; ++n) acc[a][b][m][n] = (f32x4){0.f, 0.f, 0.f, 0.f};
        }
        cur = nxt; cA = nA; cB = nB; ++ui;
        if constexpr (ALIGN_EPI) { if (wr == 1) PG8_BAR; }
    }
    PG8_WAIT_V(0);
    if constexpr (!ALIGN_EPI) { if (wr == 0) PG8_BAR; }
    PG8_BAR;
    if constexpr (Epi::AFTER_DRAIN) { E.fused(acc, cur, wr, wc, fr, fq, lds, wid, lane); S.done(cur); }
#undef PG8_SA
#undef PG8_SB
#undef PG8_STAGE
#undef PG8_LDA
#undef PG8_LDB
#undef PG8_MMA
#undef PG8_WAIT_V
#undef PG8_WAIT_L
#undef PG8_BAR
#undef PG8_SCHED
}
}
namespace attn_body {
using bf16=__hip_bfloat16;
using bf16x8=__attribute__((ext_vector_type(8)))short;
using s16x4=__attribute__((ext_vector_type(4)))short;
using f32x16=__attribute__((ext_vector_type(16)))float;
using u32x4=__attribute__((ext_vector_type(4)))unsigned;
constexpr int SEQ=8192,D=64;
constexpr int NW=8,QBLK=32,QB=QBLK*NW,KVBLK=64,NQB=SEQ/QB;
constexpr int ATTN_UNIT_ROWS=QB;
__device__ __forceinline__ int crow(int r,int hi){return (r&3)+8*(r>>2)+4*hi;}
#define SBAR() __builtin_amdgcn_sched_barrier(0)
__device__ __forceinline__ void cmask(f32x16&p0,f32x16&p1,int jb,int qrel,int hi){
  const float NEG=-INFINITY; int kb=64*jb+4*hi;
  #pragma unroll
  for(int r=0;r<16;++r){int kv=kb+(r&3)+8*(r>>2); if(kv>qrel)p0[r]=NEG; if(kv+32>qrel)p1[r]=NEG;}
}

constexpr int NSLOT=3, SLOTB=8192;
constexpr int LDS_K=0, LDS_V=NSLOT*SLOTB, LDS_WS=2*NSLOT*SLOTB, LDS_OST=LDS_WS+NW*64*4, LDS_BYTES=LDS_OST+NW*4096;
constexpr float C2=0.125f*1.4426950408889634f;
__device__ __forceinline__ void glds16(const void*gsrc,unsigned lds_dst){unsigned keep;
  asm volatile("s_mov_b32 %0, m0\n\ts_mov_b32 m0, %2\n\ts_nop 0\n\tglobal_load_lds_dwordx4 %1, off\n\ts_mov_b32 m0, %0":"=&s"(keep):"v"(gsrc),"s"(lds_dst):"memory");}
__device__ __forceinline__ float max3f(float a,float b,float c){float r;asm("v_max3_f32 %0, %1, %2, %3":"=v"(r):"v"(a),"v"(b),"v"(c));return r;}
__device__ __forceinline__ float max2f(float a,float b){float r;asm("v_max_f32_e32 %0, %1, %2":"=v"(r):"v"(a),"v"(b));return r;}
__device__ __forceinline__ float fadd_s(float a,float b){float r;asm("v_add_f32_e32 %0, %1, %2":"=v"(r):"v"(a),"v"(b));return r;}
__device__ __forceinline__ float fsub_s(float a,float b){float r;asm("v_sub_f32_e32 %0, %1, %2":"=v"(r):"v"(a),"v"(b));return r;}
typedef float f32x2_t __attribute__((ext_vector_type(2))); typedef __bf16 bf16x2_t __attribute__((ext_vector_type(2)));
__device__ __forceinline__ unsigned cvtpk_s(float lo,float hi){f32x2_t v={lo,hi};bf16x2_t b=__builtin_convertvector(v,bf16x2_t);return __builtin_bit_cast(unsigned,b);}
#define WAIT_BAR(N) asm volatile("s_waitcnt vmcnt(" #N ") lgkmcnt(0)\n\ts_barrier":::"memory")

__device__ __forceinline__ void qkt(f32x16&p0,f32x16&p1,const char*Kslot,const bf16x8*qr,const f32x16&negm,int r32,int hi){
  const char*kb=Kslot+hi*1024+r32*16;
  #pragma unroll
  for(int d0=0;d0<4;++d0){
    const bf16x8 b0=*reinterpret_cast<const bf16x8*>(kb+d0*2048);
    const bf16x8 b1=*reinterpret_cast<const bf16x8*>(kb+d0*2048+512);
    if(d0==0){p0=__builtin_amdgcn_mfma_f32_32x32x16_bf16(b0,qr[0],negm,0,0,0);p1=__builtin_amdgcn_mfma_f32_32x32x16_bf16(b1,qr[0],negm,0,0,0);}
    else{p0=__builtin_amdgcn_mfma_f32_32x32x16_bf16(b0,qr[d0],p0,0,0,0);p1=__builtin_amdgcn_mfma_f32_32x32x16_bf16(b1,qr[d0],p1,0,0,0);}}
}
typedef __attribute__((address_space(3))) const char* lds_cptr;
typedef short v4i16_t __attribute__((ext_vector_type(4)));
__device__ __forceinline__ void kload8(bf16x8*kf,lds_cptr kp){
  kf[0]=*(const __attribute__((address_space(3))) bf16x8*)(kp);      kf[1]=*(const __attribute__((address_space(3))) bf16x8*)(kp+512);
  kf[2]=*(const __attribute__((address_space(3))) bf16x8*)(kp+2048); kf[3]=*(const __attribute__((address_space(3))) bf16x8*)(kp+2560);
  kf[4]=*(const __attribute__((address_space(3))) bf16x8*)(kp+4096); kf[5]=*(const __attribute__((address_space(3))) bf16x8*)(kp+4608);
  kf[6]=*(const __attribute__((address_space(3))) bf16x8*)(kp+6144); kf[7]=*(const __attribute__((address_space(3))) bf16x8*)(kp+6656);
}
__device__ __forceinline__ void kload2(bf16x8*kf,lds_cptr kp,int j){ kf[2*j]=*(const __attribute__((address_space(3))) bf16x8*)(kp+j*2048); kf[2*j+1]=*(const __attribute__((address_space(3))) bf16x8*)(kp+j*2048+512); }
__device__ __forceinline__ s16x4 vtr(lds_cptr p){ return __builtin_bit_cast(s16x4,__builtin_amdgcn_ds_read_tr16_b64_v4i16((__attribute__((address_space(3))) v4i16_t*)p)); }
__device__ __forceinline__ float rowmax(const f32x16&p0,const f32x16&p1){
  float a=max3f(p0[0],p0[1],p1[0]),b=max3f(p0[2],p0[3],p1[1]);a=max3f(a,p1[2],p1[3]);
  #pragma unroll
  for(int r=4;r<16;r+=4){a=max3f(a,p0[r],p0[r+1]);b=max3f(b,p0[r+2],p0[r+3]);a=max3f(a,p1[r],p1[r+1]);b=max3f(b,p1[r+2],p1[r+3]);}
  const float m=max2f(a,b);
  auto rr=__builtin_amdgcn_permlane32_swap(__float_as_uint(m),__float_as_uint(m),false,false);
  return max2f(__uint_as_float(rr[0]),__uint_as_float(rr[1]));
}
__device__ __forceinline__ void pv(f32x16*o,int vb,bf16x8 pa0,bf16x8 pa1,bf16x8 pa2,bf16x8 pa3){
  #pragma unroll
  for(int d0=0;d0<2;++d0){s16x4 lo[4],hi[4];
    #pragma unroll
    for(int ks=0;ks<4;++ks){
      asm volatile("ds_read_b64_tr_b16 %0,%1 offset:%c2":"=&v"(lo[ks]):"v"(vb),"i"(d0*4096+ks*1024):"memory");
      asm volatile("ds_read_b64_tr_b16 %0,%1 offset:%c2":"=&v"(hi[ks]):"v"(vb),"i"(d0*4096+ks*1024+512):"memory");}
    asm volatile("s_waitcnt lgkmcnt(0)":::"memory");SBAR();
    #define PK(k) (bf16x8){lo[k][0],lo[k][1],lo[k][2],lo[k][3],hi[k][0],hi[k][1],hi[k][2],hi[k][3]}
    o[d0]=__builtin_amdgcn_mfma_f32_32x32x16_bf16(pa0,PK(0),o[d0],0,0,0);
    o[d0]=__builtin_amdgcn_mfma_f32_32x32x16_bf16(pa1,PK(1),o[d0],0,0,0);
    o[d0]=__builtin_amdgcn_mfma_f32_32x32x16_bf16(pa2,PK(2),o[d0],0,0,0);
    o[d0]=__builtin_amdgcn_mfma_f32_32x32x16_bf16(pa3,PK(3),o[d0],0,0,0);
    #undef PK
  }
}

#ifndef ATTN_STORE16
#define ATTN_STORE16(p,v) (*(u32x4*)(p)=(v))
#endif
template<int THRL,int PQ,int PK,int PV,int PO> __device__ __forceinline__ void attn_unit(int q0,const bf16*Qu,const bf16*__restrict__ Kh,const bf16*__restrict__ Vh,bf16*Ou,char*shm){
  int tid=threadIdx.x; asm volatile("":"+v"(tid)); const int lane=tid&63,r32=lane&31,hi=lane>>5; const int wid=__builtin_amdgcn_readfirstlane(tid>>6);
  const bf16*Qw=Qu+(long)(wid*QBLK)*PQ;
  const unsigned lds0=(unsigned)(uintptr_t)shm;
  float*wsf=(float*)(shm+LDS_WS)+wid*64;
  const bf16*ksrc=Kh+(long)lane*PK+wid*8;
  const bf16*vsrc=Vh+(long)(16*(wid&3)+(lane>>2))*PV+(wid>>2)*32+(lane&3)*8;
  const unsigned kdst=lds0+LDS_K+wid*1024, vdst=lds0+LDS_V+wid*1024;
  #define DMA_K(t,slot) glds16(ksrc+(long)(t)*KVBLK*PK,(unsigned)__builtin_amdgcn_readfirstlane(kdst+(slot)))
  #define DMA_V(t,slot) glds16(vsrc+(long)(t)*KVBLK*PV,(unsigned)__builtin_amdgcn_readfirstlane(vdst+(slot)))
  const int vb0=(int)(lds0+LDS_V)+((lane>>4)&1)*32+(lane&3)*8+(4*hi+((lane&15)>>2))*64;
  const char*Kbase=shm+LDS_K; bf16x8 kf[8];
  const lds_cptr shm3=(lds_cptr)shm; const lds_cptr kp0=shm3+LDS_K+hi*1024+r32*16; const lds_cptr vp0=shm3+LDS_V+((lane>>4)&1)*32+(lane&3)*8+(4*hi+((lane&15)>>2))*64;
  const int NT=(q0+QB)/KVBLK;
  DMA_K(0,0);DMA_V(0,0);DMA_K(1,SLOTB);
  bf16x8 qr[4];
  #pragma unroll
  for(int d0=0;d0<4;++d0)qr[d0]=*reinterpret_cast<const bf16x8*>(&Qw[(long)r32*PQ+d0*16+hi*8]);
  float mhat=0.f,l_reg=0.f;f32x16 o[2];o[0]=f32x16{};o[1]=f32x16{};f32x16 negm=f32x16{};asm volatile("":"+v"(negm));
  const int qrel=wid*QBLK+r32;
  #define CMASK(P0,P1,t) do{int jb_=(t)-(NT-4); if(jb_>=0)cmask(P0,P1,jb_,qrel,hi);}while(0)
  bool resc=false;
  #define START(P0,P1) do{ const float rm=rowmax(P0,P1); resc=false; \
    { const float dl=rm; mhat=fadd_s(mhat,dl); \
      _Pragma("unroll") for(int r=0;r<16;++r){P0[r]=fsub_s(P0[r],dl);P1[r]=fsub_s(P1[r],dl);} \
      _Pragma("unroll") for(int r=0;r<16;++r)negm[r]=-mhat; asm volatile("":"+v"(negm)); } \
    _Pragma("unroll") for(int r=0;r<16;++r)P0[r]=__builtin_amdgcn_exp2f(P0[r]); }while(0)
  #define RESC() do{ if(resc){ asm volatile("s_waitcnt lgkmcnt(0)":::"memory"); \
      _Pragma("unroll") for(int d_=0;d_<2;++d_) _Pragma("unroll") for(int r=0;r<16;++r)o[d_][r]*=wsf[crow(r,hi)]; } }while(0)
  f32x16 pA0,pA1,pB0,pB1;
  int sl_prev=0,sl_cur=0,sl_next=SLOTB;
  #define ROT() do{sl_prev=sl_cur;sl_cur=sl_next;sl_next=(sl_next==(NSLOT-1)*SLOTB)?0:sl_next+SLOTB;}while(0)
  DMA_K(2,2*SLOTB);
  WAIT_BAR(3);
  qkt(pA0,pA1,Kbase,qr,negm,r32,hi);asm volatile("s_nop 15\n\ts_nop 7":"+v"(pA0),"+v"(pA1));CMASK(pA0,pA1,0);
  START(pA0,pA1);
  _Pragma("unroll") for(int r=0;r<16;++r)pA1[r]=__builtin_amdgcn_exp2f(pA1[r]);
  WAIT_BAR(0);
  DMA_K(3,0);DMA_V(1,SLOTB);
  ROT();
  kload8(kf,kp0+sl_cur);
  WAIT_BAR(2);
  s16x4 vlo[8],vhi[8]; u32x4 pw0,pw1,pw2,pw3;
  #define PKW(P,B) cvtpk_s(P[B],P[B+1])
  #define PAF(k) __builtin_bit_cast(bf16x8,pw##k)
  #define VFR(i) (bf16x8){vlo[i][0],vlo[i][1],vlo[i][2],vlo[i][3],vhi[i][0],vhi[i][1],vhi[i][2],vhi[i][3]}
  #define PIN(x) asm volatile("":"+v"(x))
  #define MX3(a,b,c) __builtin_fmaxf(__builtin_fmaxf((a),(b)),(c))
  #define GAPA(MF,A0,A1,A2,A3,W0,W1,PW) do{ MF; sacc+=A0; sacc+=A1; sacc+=A2; sacc+=A3; PIN(sacc); W0; W1; PIN(PW); SBAR(); }while(0)
  #define EX(v) __builtin_amdgcn_exp2f(v)
  #define GAPB(MF,X,B) do{ MF; X[B]=EX(X[B]); X[B+1]=EX(X[B+1]); X[B+2]=EX(X[B+2]); X[B+3]=EX(X[B+3]); PIN(X); SBAR(); }while(0)
  #define VRD(i) do{ vlo[i]=vtr(vp_+(((i)>>2)*4096+((i)&3)*1024)); vhi[i]=vtr(vp_+(((i)>>2)*4096+((i)&3)*1024+512)); }while(0)
  #define KRD(G,j) do{ if(G){ kload2(kf,kp0+sl_next,j); SBAR(); } }while(0)
  #define STEP(C0,C1,P0,P1,t,GK,GV,GL) do{ SBAR(); \
    const lds_cptr vp_=vp0+sl_prev; \
    VRD(0); SBAR(); float sacc=(P0[0]+P0[1]); \
    GAPA(C0=__builtin_amdgcn_mfma_f32_32x32x16_bf16(kf[0],qr[0],negm,0,0,0), P0[2],P0[3],P0[4],P0[5],     pw0[0]=PKW(P0,0), pw0[1]=PKW(P0,2), pw0); \
    VRD(4); SBAR(); GAPA(C1=__builtin_amdgcn_mfma_f32_32x32x16_bf16(kf[1],qr[0],negm,0,0,0), P0[6],P0[7],P0[8],P0[9],     pw0[2]=PKW(P0,4), pw0[3]=PKW(P0,6), pw0); \
    VRD(1); SBAR(); GAPA(C0=__builtin_amdgcn_mfma_f32_32x32x16_bf16(kf[2],qr[1],C0,0,0,0),   P0[10],P0[11],P0[12],P0[13], pw1[0]=PKW(P0,8), pw1[1]=PKW(P0,10), pw1); \
    VRD(5); SBAR(); GAPA(C1=__builtin_amdgcn_mfma_f32_32x32x16_bf16(kf[3],qr[1],C1,0,0,0),   P0[14],P0[15],P1[0],P1[1],   pw1[2]=PKW(P0,12),pw1[3]=PKW(P0,14), pw1); \
    VRD(2); SBAR(); GAPA(C0=__builtin_amdgcn_mfma_f32_32x32x16_bf16(kf[4],qr[2],C0,0,0,0),   P1[2],P1[3],P1[4],P1[5],     pw2[0]=PKW(P1,0), pw2[1]=PKW(P1,2), pw2); \
    VRD(6); SBAR(); GAPA(C1=__builtin_amdgcn_mfma_f32_32x32x16_bf16(kf[5],qr[2],C1,0,0,0),   P1[6],P1[7],P1[8],P1[9],     pw2[2]=PKW(P1,4), pw2[3]=PKW(P1,6), pw2); \
    VRD(3); SBAR(); GAPA(C0=__builtin_amdgcn_mfma_f32_32x32x16_bf16(kf[6],qr[3],C0,0,0,0),   P1[10],P1[11],P1[12],P1[13], pw3[0]=PKW(P1,8), pw3[1]=PKW(P1,10), pw3); \
    VRD(7); SBAR(); GAPA(C1=__builtin_amdgcn_mfma_f32_32x32x16_bf16(kf[7],qr[3],C1,0,0,0),   P1[14],P1[15],0.f,0.f,       pw3[2]=PKW(P1,12),pw3[3]=PKW(P1,14), pw3); \
    l_reg+=sacc; \
    if(GK){DMA_K((t)+3,sl_cur);} if(GV){DMA_V((t)+1,sl_next);} \
    CMASK(C0,C1,t); \
    { float a=MX3(C0[0],C0[1],C1[0]),b=MX3(C0[2],C0[3],C1[1]); a=MX3(a,C1[2],C1[3]); \
      _Pragma("unroll") for(int r=4;r<16;r+=4){a=MX3(a,C0[r],C0[r+1]);b=MX3(b,C0[r+2],C0[r+3]);a=MX3(a,C1[r],C1[r+1]);b=MX3(b,C1[r+2],C1[r+3]);} \
      float rm=__builtin_fmaxf(a,b); { auto rr=__builtin_amdgcn_permlane32_swap(__float_as_uint(rm),__float_as_uint(rm),false,false); rm=__builtin_fmaxf(__uint_as_float(rr[0]),__uint_as_float(rr[1])); } \
      resc=false; \
      if(__builtin_expect(__any(rm>(float)THRL),0)){ const float dl=__builtin_fmaxf(rm,0.f); mhat+=dl; \
        _Pragma("unroll") for(int r=0;r<16;++r){C0[r]-=dl;C1[r]-=dl;} \
        _Pragma("unroll") for(int r=0;r<16;++r)negm[r]=-mhat; asm volatile("":"+v"(negm)); \
        const float f=__builtin_amdgcn_exp2f(-dl); l_reg*=f; if(hi==0)wsf[r32]=f; resc=true; } } \
    SBAR(); \
    GAPB(o[0]=__builtin_amdgcn_mfma_f32_32x32x16_bf16(PAF(0),VFR(0),o[0],0,0,0), C0,0); \
    GAPB(o[1]=__builtin_amdgcn_mfma_f32_32x32x16_bf16(PAF(0),VFR(4),o[1],0,0,0), C0,4); \
    KRD(GL,0); GAPB(o[0]=__builtin_amdgcn_mfma_f32_32x32x16_bf16(PAF(1),VFR(1),o[0],0,0,0), C0,8); \
    KRD(GL,1); GAPB(o[1]=__builtin_amdgcn_mfma_f32_32x32x16_bf16(PAF(1),VFR(5),o[1],0,0,0), C0,12); \
    KRD(GL,2); GAPB(o[0]=__builtin_amdgcn_mfma_f32_32x32x16_bf16(PAF(2),VFR(2),o[0],0,0,0), C1,0); \
    KRD(GL,3); GAPB(o[1]=__builtin_amdgcn_mfma_f32_32x32x16_bf16(PAF(2),VFR(6),o[1],0,0,0), C1,4); \
    GAPB(o[0]=__builtin_amdgcn_mfma_f32_32x32x16_bf16(PAF(3),VFR(3),o[0],0,0,0), C1,8); \
    GAPB(o[1]=__builtin_amdgcn_mfma_f32_32x32x16_bf16(PAF(3),VFR(7),o[1],0,0,0), C1,12); \
    }while(0)
  int t=1;
  #undef CMASK
  #define CMASK(P0,P1,t) do{}while(0)
  for(;t+5<NT;t+=2){
    STEP(pB0,pB1,pA0,pA1,t,true,true,true);     WAIT_BAR(2); RESC(); ROT();
    STEP(pA0,pA1,pB0,pB1,t+1,true,true,true);   WAIT_BAR(2); RESC(); ROT();
  }
  #undef CMASK
  #define CMASK(P0,P1,t) do{int jb_=(t)-(NT-4); if(jb_>=0)cmask(P0,P1,jb_,qrel,hi);}while(0)
  #define ENDW(tt) do{ if((tt)+3<NT){WAIT_BAR(2);} else if((tt)+2<NT){WAIT_BAR(1);} else {WAIT_BAR(0);} }while(0)
  for(;t+1<NT;t+=2){
    STEP(pB0,pB1,pA0,pA1,t,(t+3<NT),(t+1<NT),(t+1<NT));       ENDW(t);   RESC(); ROT();
    STEP(pA0,pA1,pB0,pB1,t+1,(t+4<NT),(t+2<NT),(t+2<NT));     ENDW(t+1); RESC(); ROT();
  }
  STEP(pB0,pB1,pA0,pA1,NT-1,false,false,false); RESC();
  { float sacc=pB0[0]+pB0[1]; _Pragma("unroll") for(int r=2;r<16;++r)sacc+=pB0[r]; _Pragma("unroll") for(int r=0;r<16;++r)sacc+=pB1[r]; l_reg+=sacc;
    pw0=(u32x4){PKW(pB0,0),PKW(pB0,2),PKW(pB0,4),PKW(pB0,6)};pw1=(u32x4){PKW(pB0,8),PKW(pB0,10),PKW(pB0,12),PKW(pB0,14)};pw2=(u32x4){PKW(pB1,0),PKW(pB1,2),PKW(pB1,4),PKW(pB1,6)};pw3=(u32x4){PKW(pB1,8),PKW(pB1,10),PKW(pB1,12),PKW(pB1,14)};
    SBAR(); pv(o,vb0+sl_cur,PAF(0),PAF(1),PAF(2),PAF(3)); }
  #undef PKW
  #undef PAF
  #undef VFR
  #undef PIN
  #undef MX3
  #undef GAPA
  #undef GAPB
  #undef EX
  #undef VRD
  #undef KRD
  #undef STEP
  #undef ENDW
  {auto rr=__builtin_amdgcn_permlane32_swap(__float_as_uint(l_reg),__float_as_uint(l_reg),false,false);l_reg=__uint_as_float(rr[0])+__uint_as_float(rr[1]);}
  if(hi==0)wsf[32+r32]=l_reg;asm volatile("s_waitcnt lgkmcnt(0)":::"memory");
  float rli[16];
  #pragma unroll
  for(int r=0;r<16;++r)rli[r]=__builtin_amdgcn_rcpf(wsf[32+crow(r,hi)]);
  bf16*Ow=Ou+(long)(wid*QBLK)*PO;
  { bf16*stg=(bf16*)(shm+LDS_OST)+wid*2048;
    #pragma unroll
    for(int r=0;r<16;++r){const int orow=crow(r,hi);
      #pragma unroll
      for(int d0=0;d0<2;++d0)stg[orow*64+d0*32+r32]=__float2bfloat16(o[d0][r]*rli[r]);}
    asm volatile("s_waitcnt lgkmcnt(0)":::"memory");
    #pragma unroll
    for(int i=0;i<4;++i){const int row=i*8+(lane>>3),ch=lane&7; const u32x4 v=*(const u32x4*)(stg+row*64+ch*8); ATTN_STORE16(Ow+(long)row*PO+ch*8,v);} }
  asm volatile("s_waitcnt lgkmcnt(0)\n\ts_barrier":::"memory");
  #undef DMA_K
  #undef DMA_V
  #undef CMASK
  #undef START
  #undef RESC
  #undef ROT
}
constexpr int ATTN_LDS_BYTES=LDS_BYTES;
#undef SBAR
#undef WAIT_BAR
}

#ifndef MK_MULTI
#define MK_MULTI 0
#endif
#define LAS __attribute__((address_space(3)))
typedef unsigned short bf16;
typedef float f32x4 __attribute__((ext_vector_type(4)));
typedef unsigned u32x4 __attribute__((ext_vector_type(4)));
typedef unsigned u32x2 __attribute__((ext_vector_type(2)));
typedef short bf16x8 __attribute__((ext_vector_type(8)));
using pg8::cvt_pk_bf16;

constexpr int DM = 1024, NB = 4, SEQ = 8192, T = NB * SEQ, DEPTH = 2;
constexpr int NIN = 8704, NPROJ = 5632, NGATE = 3072;
constexpr float EPS = 1e-6f;
constexpr float C2 = 0.18033688011112042f;
__device__ const float LG2[4] = {-0.04580368961312479f, -0.02272007650008353f, -0.011315313227834146f, -0.005646563141142063f};
__device__ const float INV_A[8] = {1.0f, 0.19392274474868576f, 0.03760603093086393f, 0.007292664737217109f, 0.001414213562373095f, 0.0002742481756762073f, 5.318295896944988e-05f, 1.031338537721246e-05f};
__device__ const float INV_R[32] = {1.0f, 0.7429639507594948f, 0.551995432128157f, 0.41011270705513014f, 0.30469895709035083f, 0.22638034095214482f, 0.16819243248808696f, 0.1249609141291987f,
    0.09284145445194744f, 0.06897785379387654f, 0.05124805876960934f, 0.038075460212223716f, 0.028288694346259694f, 0.021017480113324882f, 0.015615230060004972f, 0.011601553017399714f,
    0.008619535664753033f, 0.006404004271197283f, 0.004757944314009409f, 0.0035349811050301057f, 0.0026263635276533325f, 0.0019512934226359642f, 0.0014497406703726315f, 0.001077105056036769f,
    0.0008002502278161052f, 0.0005945570708544394f, 0.00044173447031400687f, 0.0003281927872511474f, 0.0002438354098268829f, 0.00018116091942004152f, 0.00013459603241553644f, 0.0001f};

constexpr size_t MiB = 1u << 20;
constexpr size_t WS_WIN = 2 * MiB;
constexpr size_t WIN_L = (size_t)NIN * DM * 2;
constexpr size_t WS_WBR = 36 * MiB;
constexpr size_t WBR_L = (size_t)3 * DM * 512 * 2;
constexpr size_t WS_WOUT = 42 * MiB;
constexpr size_t WOUT_L = (size_t)DM * DM * 2;
constexpr size_t WS_ROPEA = 46 * MiB;
constexpr size_t WS_ROPER = 46 * MiB + 512 * 1024;
constexpr size_t WS_SSQ = 49 * MiB;
constexpr size_t WS_XB = 52 * MiB;
constexpr size_t WS_KV = 116 * MiB;
constexpr size_t WS_ACT = 148 * MiB;
constexpr size_t SEG512 = (size_t)T * 512 * 2;
constexpr size_t WS_QA = WS_ACT, WS_KA = WS_QA + SEG512, WS_VA = WS_KA + SEG512, WS_CX = WS_VA + SEG512, WS_CC = WS_CX + SEG512, WS_SCZ = WS_CC + SEG512,
                 WS_SZA = WS_SCZ + SEG512, WS_CB = WS_SZA + SEG512, WS_RQ = WS_CB + SEG512, WS_RK = WS_RQ + SEG512 / 2, WS_RV = WS_RK + SEG512 / 2, WS_SRZ = WS_RV + SEG512,
                 WS_END = WS_SRZ + SEG512;
constexpr size_t WS_G = WS_QA;
constexpr size_t WS_MERGED = WS_RQ;
constexpr size_t WS_OTMP = WS_CX;
static_assert(WS_END == 500 * MiB, "ws map");
constexpr int LDS_BYTES = 147456;
constexpr int NWAVES = 8;

__device__ __forceinline__ int orig_col(int p) {
    if (p < 1024) { int d = p & 63; if (d < 16) { const int blk = d >> 3, half = (d >> 2) & 1, e = d & 3; d = half * 8 + blk * 4 + e; } return (p & ~63) | d; }
    if (p >= 4096 && p < 4608) { const int d = p & 63, blk = d >> 3, half = (d >> 2) & 1, e = d & 3; return (p & ~63) | (half * 32 + blk * 4 + e); }
    return p;
}
__device__ __forceinline__ float wave_sum(float v) {
#pragma unroll
    for (int o = 1; o < 64; o <<= 1) v += __shfl_xor(v, o);
    return v;
}
__device__ __forceinline__ float bf2f(unsigned short b) { return __uint_as_float((unsigned)b << 16); }
__device__ __forceinline__ float bflo(unsigned w) { return __uint_as_float(w << 16); }
__device__ __forceinline__ float bfhi(unsigned w) { return __uint_as_float(w & 0xffff0000u); }
__device__ __forceinline__ float sigmoidf_(float x) { return 1.0f / (1.0f + __expf(-x)); }
__device__ __forceinline__ float siluf_(float x) { return x / (1.0f + __expf(-x)); }

struct EpiProj {
    static constexpr bool PERM = true, AFTER_DRAIN = false;
    unsigned char* ws; const float* ssq; const float2* ropeA; const float2* ropeR;
    __device__ __forceinline__ bool keep(const pg8::Unit&) const { return false; }
    __device__ __forceinline__ void operator()(f32x4 (&acc)[2][2][4][2], const pg8::Unit& u, int wr, int wc, int fr, int fq) const {
        const int pn = u.pn;
        int seg, lt;
        if (pn < 16) { seg = pn >> 1; lt = pn & 1; } else if (pn < 18) { seg = 8 + (pn - 16); lt = 0; } else { seg = 10 + ((pn - 18) >> 1); lt = (pn - 18) & 1; }
        size_t off; int pitch = 512;
        switch (seg) {
            case 0: off = WS_QA; break; case 1: off = WS_KA; break; case 2: off = WS_VA; break; case 3: off = WS_SZA; break;
            case 4: off = WS_CX; break; case 5: off = WS_CB; break; case 6: off = WS_CC; break; case 7: off = WS_SCZ; break;
            case 8: off = WS_RQ; pitch = 256; break; case 9: off = WS_RK; pitch = 256; break; case 10: off = WS_RV; break; default: off = WS_SRZ; break;
        }
        bf16* dst = (bf16*)(ws + off);
        const int lc0 = lt * 256 + wc * 32 + 8 * fq;
        const int row0 = u.pm * 256 + wr * 64 + fr;
        const int ropemode = (seg <= 1) ? 1 : ((seg == 8 || seg == 9) ? 2 : 0);
        const bool dosilu = (seg == 3 || seg == 7 || seg == 11);
        const float scale = (seg == 0) ? C2 : ((seg == 9) ? 0.125f : 1.0f);
        const bool ropeA_lane = ((wc & 1) == 0) && (fq < 2);
        const int jA = 4 * fq, jR = (4 * (wc & 1) + fq) * 4;
#pragma unroll
        for (int ai = 0; ai < 2; ++ai)
#pragma unroll
            for (int m = 0; m < 4; ++m) {
                const int row = row0 + ai * 128 + m * 16;
                const f32x4* sp = (const f32x4*)(ssq + (size_t)row * 16);
                const f32x4 s0 = sp[0], s1 = sp[1], s2 = sp[2], s3 = sp[3];
                const float ss = ((s0[0] + s0[1]) + (s0[2] + s0[3])) + ((s1[0] + s1[1]) + (s1[2] + s1[3])) + ((s2[0] + s2[1]) + (s2[2] + s2[3])) + ((s3[0] + s3[1]) + (s3[2] + s3[3]));
                const float rs = rsqrtf(ss * (1.0f / DM) + EPS) * scale;
                const int pos = row & (SEQ - 1);
#pragma unroll
                for (int bj = 0; bj < 2; ++bj) {
                    f32x4 v0 = acc[ai][bj][m][0] * rs, v1 = acc[ai][bj][m][1] * rs;
                    if (ropemode == 1) {
                        if (ropeA_lane) {
                            const float2* cs = ropeA + pos * 8 + jA;
#pragma unroll
                            for (int e = 0; e < 4; ++e) { const float2 c = cs[e]; const float x1 = v0[e], x2 = v1[e]; v0[e] = x1 * c.x - x2 * c.y; v1[e] = x2 * c.x + x1 * c.y; }
                        }
                    } else if (ropemode == 2) {
                        const float2* cs = ropeR + pos * 32 + jR;
#pragma unroll
                        for (int e = 0; e < 4; ++e) { const float2 c = cs[e]; const float x1 = v0[e], x2 = v1[e]; v0[e] = x1 * c.x - x2 * c.y; v1[e] = x2 * c.x + x1 * c.y; }
                    }
                    if (dosilu) {
#pragma unroll
                        for (int e = 0; e < 4; ++e) { v0[e] = siluf_(v0[e]); v1[e] = siluf_(v1[e]); }
                    }
                    u32x4 w; w.x = cvt_pk_bf16(v0[0], v0[1]); w.y = cvt_pk_bf16(v0[2], v0[3]); w.z = cvt_pk_bf16(v1[0], v1[1]); w.w = cvt_pk_bf16(v1[2], v1[3]);
                    *(u32x4*)(dst + (size_t)row * pitch + lc0 + bj * 128) = w;
                }
            }
    }
};
struct EpiGate {
    static constexpr bool PERM = true, AFTER_DRAIN = false;
    bf16* G; const float* ssq;
    __device__ __forceinline__ bool keep(const pg8::Unit&) const { return false; }
    __device__ __forceinline__ void operator()(f32x4 (&acc)[2][2][4][2], const pg8::Unit& u, int wr, int wc, int fr, int fq) const {
        const int col0 = u.pn * 256 + wc * 32 + 8 * fq, row0 = u.pm * 256 + wr * 64 + fr;
#pragma unroll
        for (int ai = 0; ai < 2; ++ai)
#pragma unroll
            for (int m = 0; m < 4; ++m) {
                const int row = row0 + ai * 128 + m * 16;
                const f32x4* sp = (const f32x4*)(ssq + (size_t)row * 16);
                const f32x4 s0 = sp[0], s1 = sp[1], s2 = sp[2], s3 = sp[3];
                const float ss = ((s0[0] + s0[1]) + (s0[2] + s0[3])) + ((s1[0] + s1[1]) + (s1[2] + s1[3])) + ((s2[0] + s2[1]) + (s2[2] + s2[3])) + ((s3[0] + s3[1]) + (s3[2] + s3[3]));
                const float rs = rsqrtf(ss * (1.0f / DM) + EPS);
#pragma unroll
                for (int bj = 0; bj < 2; ++bj) {
                    f32x4 v0 = acc[ai][bj][m][0] * rs, v1 = acc[ai][bj][m][1] * rs;
#pragma unroll
                    for (int e = 0; e < 4; ++e) { v0[e] = fmaxf(sigmoidf_(v0[e]), 1e-30f); v1[e] = fmaxf(sigmoidf_(v1[e]), 1e-30f); }
                    u32x4 w; w.x = cvt_pk_bf16(v0[0], v0[1]); w.y = cvt_pk_bf16(v0[2], v0[3]); w.z = cvt_pk_bf16(v1[0], v1[1]); w.w = cvt_pk_bf16(v1[2], v1[3]);
                    *(u32x4*)(G + (size_t)row * NGATE + col0 + bj * 128) = w;
                }
            }
    }
};
struct EpiChain {
    static constexpr bool PERM = true, AFTER_DRAIN = false;
    const bf16* G; bf16* out;
    __device__ __forceinline__ bool keep(const pg8::Unit& u) const { return u.seg != 2; }
    __device__ __forceinline__ void operator()(f32x4 (&acc)[2][2][4][2], const pg8::Unit& u, int wr, int wc, int fr, int fq) const {
        const int col0 = u.pn * 256 + wc * 32 + 8 * fq, row0 = u.pm * 256 + wr * 64 + fr;
        const int seg = u.seg;
#pragma unroll
        for (int ai = 0; ai < 2; ++ai)
#pragma unroll
            for (int m = 0; m < 4; ++m) {
                const int row = row0 + ai * 128 + m * 16;
#pragma unroll
                for (int bj = 0; bj < 2; ++bj) {
                    const bf16* gp = G + (size_t)row * NGATE + seg * DM + col0 + bj * 128;
                    const u32x4 ga = *(const u32x4*)gp;
                    float f[8] = {bflo(ga.x), bfhi(ga.x), bflo(ga.y), bfhi(ga.y), bflo(ga.z), bfhi(ga.z), bflo(ga.w), bfhi(ga.w)};
                    if (seg != 2) {
                        const u32x4 gb = *(const u32x4*)(gp + DM);
                        const float h[8] = {bflo(gb.x), bfhi(gb.x), bflo(gb.y), bfhi(gb.y), bflo(gb.z), bfhi(gb.z), bflo(gb.w), bfhi(gb.w)};
#pragma unroll
                        for (int e = 0; e < 8; ++e) f[e] = f[e] / h[e];
                    }
                    f32x4 v0 = acc[ai][bj][m][0], v1 = acc[ai][bj][m][1];
#pragma unroll
                    for (int e = 0; e < 4; ++e) { v0[e] *= f[e]; v1[e] *= f[4 + e]; }
                    if (seg != 2) { acc[ai][bj][m][0] = v0; acc[ai][bj][m][1] = v1; }
                    else {
                        u32x4 w; w.x = cvt_pk_bf16(v0[0], v0[1]); w.y = cvt_pk_bf16(v0[2], v0[3]); w.z = cvt_pk_bf16(v1[0], v1[1]); w.w = cvt_pk_bf16(v1[2], v1[3]);
                        *(u32x4*)(out + (size_t)row * DM + col0 + bj * 128) = w;
                    }
                }
            }
    }
};
struct ChainOrder {
    pg8::StaticOrder S;
    __device__ bool next(int i, pg8::Unit& u) const { if (!S.next(i / 3, u)) return false; u.seg = i % 3; return true; }
    __device__ __forceinline__ void a_ready(const pg8::Unit&) const {}
    __device__ __forceinline__ void done(const pg8::Unit&) const {}
};
struct EpiOut {
    static constexpr bool PERM = true, AFTER_DRAIN = false;
    const float* xres; float* xout; bf16* xb; float* ssq;
    __device__ __forceinline__ bool keep(const pg8::Unit&) const { return false; }
    __device__ __forceinline__ void operator()(f32x4 (&acc)[2][2][4][2], const pg8::Unit& u, int wr, int wc, int fr, int fq) const {
        const int col0 = u.pn * 256 + wc * 32 + 8 * fq, row0 = u.pm * 256 + wr * 64 + fr;
#pragma unroll
        for (int ai = 0; ai < 2; ++ai)
#pragma unroll
            for (int m = 0; m < 4; ++m) {
                const int row = row0 + ai * 128 + m * 16;
                float q = 0.f;
#pragma unroll
                for (int bj = 0; bj < 2; ++bj) {
                    const size_t o = (size_t)row * DM + col0 + bj * 128;
                    const f32x4 r0 = *(const f32x4*)(xres + o), r1 = *(const f32x4*)(xres + o + 4);
                    const f32x4 v0 = acc[ai][bj][m][0] + r0, v1 = acc[ai][bj][m][1] + r1;
                    *(f32x4*)(xout + o) = v0; *(f32x4*)(xout + o + 4) = v1;
                    q += ((v0[0] * v0[0] + v0[1] * v0[1]) + (v0[2] * v0[2] + v0[3] * v0[3])) + ((v1[0] * v1[0] + v1[1] * v1[1]) + (v1[2] * v1[2] + v1[3] * v1[3]));
                    u32x4 w; w.x = cvt_pk_bf16(v0[0], v0[1]); w.y = cvt_pk_bf16(v0[2], v0[3]); w.z = cvt_pk_bf16(v1[0], v1[1]); w.w = cvt_pk_bf16(v1[2], v1[3]);
                    *(u32x4*)(xb + o) = w;
                }
                q += __shfl_xor(q, 16); q += __shfl_xor(q, 32);
                if (fq == 0) ssq[(size_t)row * 16 + u.pn * 4 + wc] = q;
            }
    }
};

template <bool PERMUTE>
__device__ __forceinline__ void p0_transpose_item(const float* W, int K, int N, bf16* WT, const float* gk, LAS float* scr, int item, int lane) {
    const int nblk = N / 32, kb = item / nblk, nb = item % nblk, k0 = 64 * kb, n0 = 32 * nb;
    const int nsrc = PERMUTE ? orig_col(n0 + (lane & 31)) : (n0 + (lane & 31));
#pragma unroll 8
    for (int i = 0; i < 32; ++i) { const int kk = 2 * i + (lane >> 5); float v = W[(size_t)(k0 + kk) * N + nsrc]; if (gk) v *= gk[k0 + kk]; scr[kk * 33 + (lane & 31)] = v; }
    asm volatile("s_waitcnt lgkmcnt(0)" ::: "memory");
    const int c = lane & 7;
#pragma unroll
    for (int j = 0; j < 4; ++j) { const int n = (lane >> 3) + 8 * j; const LAS float* s = scr + (8 * c) * 33 + n;
        u32x4 o; o.x = cvt_pk_bf16(s[0 * 33], s[1 * 33]); o.y = cvt_pk_bf16(s[2 * 33], s[3 * 33]); o.z = cvt_pk_bf16(s[4 * 33], s[5 * 33]); o.w = cvt_pk_bf16(s[6 * 33], s[7 * 33]);
        *(u32x4*)(WT + (size_t)(n0 + n) * K + k0 + 8 * c) = o; }
    asm volatile("s_waitcnt lgkmcnt(0)" ::: "memory");
}

struct Args { const float* in[9]; float* out; unsigned char* ws; int ph_lo, ph_hi; };

__device__ __forceinline__ void phase_prologue(const Args& a, LAS unsigned char* lds, int vcu, int G, int wave, int lane) {
    unsigned char* ws = a.ws;
    LAS float* scr = (LAS float*)(lds + wave * 16384);
    const int gw = vcu * NWAVES + wave, NGW = G * NWAVES;
    constexpr int I_IN = (DM / 64) * (NIN / 32), I_BR = (512 / 64) * (DM / 32), I_OUT = (DM / 64) * (DM / 32), I_L = I_IN + 3 * I_BR + I_OUT;
    for (int it = gw; it < DEPTH * I_L; it += NGW) {
        const int l = it / I_L; int r = it % I_L;
        if (r < I_IN) { p0_transpose_item<true>(a.in[2] + (size_t)l * DM * NIN, DM, NIN, (bf16*)(ws + WS_WIN + l * WIN_L), a.in[1] + l * DM, scr, r, lane); continue; } r -= I_IN;
        if (r < 3 * I_BR) { const int i = r / I_BR; p0_transpose_item<false>(a.in[6] + ((size_t)l * 3 + i) * 512 * DM, 512, DM, (bf16*)(ws + WS_WBR + l * WBR_L) + (size_t)i * DM * 512, nullptr, scr, r % I_BR, lane); continue; } r -= 3 * I_BR;
        p0_transpose_item<false>(a.in[7] + (size_t)l * DM * DM, DM, DM, (bf16*)(ws + WS_WOUT + l * WOUT_L), nullptr, scr, r, lane);
    }
    const float* x = a.in[0]; bf16* xb = (bf16*)(ws + WS_XB); float* ssq = (float*)(ws + WS_SSQ);
    for (int m = gw; m < T; m += NGW) {
        const f32x4* xr = (const f32x4*)(x + (size_t)m * DM) + lane;
        f32x4 v[4]; float s = 0.f;
#pragma unroll
        for (int j = 0; j < 4; ++j) { v[j] = xr[64 * j]; s += (v[j][0] * v[j][0] + v[j][1] * v[j][1]) + (v[j][2] * v[j][2] + v[j][3] * v[j][3]); }
        s = wave_sum(s);
        u32x2* o8 = (u32x2*)(xb + (size_t)m * DM) + lane;
#pragma unroll
        for (int j = 0; j < 4; ++j) { u32x2 w; w.x = cvt_pk_bf16(v[j][0], v[j][1]); w.y = cvt_pk_bf16(v[j][2], v[j][3]); o8[64 * j] = w; }
        if (lane < 16) ssq[(size_t)m * 16 + lane] = (lane == 0) ? s : 0.f;
    }
    float2* ropeA = (float2*)(ws + WS_ROPEA); float2* ropeR = (float2*)(ws + WS_ROPER);
    const int gt = gw * 64 + lane, NT_ = NGW * 64;
    for (int i = gt; i < SEQ * 40; i += NT_) {
        float inv; float2* dst;
        if (i < SEQ * 8) { inv = INV_A[i & 7]; dst = ropeA + i; } else { const int k = i - SEQ * 8; inv = INV_R[k & 31]; dst = ropeR + k; }
        const int pos = (i < SEQ * 8) ? (i >> 3) : ((i - SEQ * 8) >> 5);
        const float ang = (float)pos * inv;
        double rev = (double)ang * 0.15915494309189533577; rev -= __builtin_rint(rev);
        const float rf = (float)rev;
        *dst = make_float2(__builtin_amdgcn_cosf(rf), __builtin_amdgcn_sinf(rf));
    }
}

__device__ __forceinline__ void conv_item(unsigned char* ws, const float* cw, int item, int tid) {
    const bf16* CX = (const bf16*)(ws + WS_CX); const bf16* CC = (const bf16*)(ws + WS_CC); const bf16* SCZ = (const bf16*)(ws + WS_SCZ); bf16* CB = (bf16*)(ws + WS_CB);
    const int ch = (tid & 63) * 8, t0 = item * 64 + (tid >> 6) * 8;
    float w0[8], w1[8], w2[8];
#pragma unroll
    for (int e = 0; e < 8; ++e) { w0[e] = cw[ch + e]; w1[e] = cw[512 + ch + e]; w2[e] = cw[1024 + ch + e]; }
    float um2[8], um1[8];
#pragma unroll
    for (int e = 0; e < 8; ++e) { um2[e] = 0.f; um1[e] = 0.f; }
    const int s0 = t0 & (SEQ - 1);
    if (s0 >= 2) {
        const u32x4 a2 = *(const u32x4*)(CX + (size_t)(t0 - 2) * 512 + ch), b2 = *(const u32x4*)(CC + (size_t)(t0 - 2) * 512 + ch);
        const u32x4 a1 = *(const u32x4*)(CX + (size_t)(t0 - 1) * 512 + ch), b1 = *(const u32x4*)(CC + (size_t)(t0 - 1) * 512 + ch);
        um2[0] = bflo(a2.x) * bflo(b2.x); um2[1] = bfhi(a2.x) * bfhi(b2.x); um2[2] = bflo(a2.y) * bflo(b2.y); um2[3] = bfhi(a2.y) * bfhi(b2.y);
        um2[4] = bflo(a2.z) * bflo(b2.z); um2[5] = bfhi(a2.z) * bfhi(b2.z); um2[6] = bflo(a2.w) * bflo(b2.w); um2[7] = bfhi(a2.w) * bfhi(b2.w);
        um1[0] = bflo(a1.x) * bflo(b1.x); um1[1] = bfhi(a1.x) * bfhi(b1.x); um1[2] = bflo(a1.y) * bflo(b1.y); um1[3] = bfhi(a1.y) * bfhi(b1.y);
        um1[4] = bflo(a1.z) * bflo(b1.z); um1[5] = bfhi(a1.z) * bfhi(b1.z); um1[6] = bflo(a1.w) * bflo(b1.w); um1[7] = bfhi(a1.w) * bfhi(b1.w);
    }
#pragma unroll
    for (int i = 0; i < 8; ++i) {
        const size_t o = (size_t)(t0 + i) * 512 + ch;
        const u32x4 a = *(const u32x4*)(CX + o), b = *(const u32x4*)(CC + o), g = *(const u32x4*)(CB + o), z = *(const u32x4*)(SCZ + o);
        float u[8] = {bflo(a.x) * bflo(b.x), bfhi(a.x) * bfhi(b.x), bflo(a.y) * bflo(b.y), bfhi(a.y) * bfhi(b.y), bflo(a.z) * bflo(b.z), bfhi(a.z) * bfhi(b.z), bflo(a.w) * bflo(b.w), bfhi(a.w) * bfhi(b.w)};
        const float gb[8] = {bflo(g.x) * bflo(z.x), bfhi(g.x) * bfhi(z.x), bflo(g.y) * bflo(z.y), bfhi(g.y) * bfhi(z.y), bflo(g.z) * bflo(z.z), bfhi(g.z) * bfhi(z.z), bflo(g.w) * bflo(z.w), bfhi(g.w) * bfhi(z.w)};
        float y[8];
#pragma unroll
        for (int e = 0; e < 8; ++e) { y[e] = gb[e] * (w0[e] * um2[e] + w1[e] * um1[e] + w2[e] * u[e]); um2[e] = um1[e]; um1[e] = u[e]; }
        u32x4 w; w.x = cvt_pk_bf16(y[0], y[1]); w.y = cvt_pk_bf16(y[2], y[3]); w.z = cvt_pk_bf16(y[4], y[5]); w.w = cvt_pk_bf16(y[6], y[7]);
        *(u32x4*)(CB + o) = w;
    }
}

constexpr int R_SQ = 0, R_SK = 18432, R_SVT = 36864, R_SPT = 71680, R_SP = 90112;
__device__ __forceinline__ bf16x8 lds_frag(LAS const unsigned char* p) { return *(LAS const bf16x8*)p; }

__device__ __forceinline__ void stage_vT(LAS unsigned char* lds, const bf16* Rv, int t0, int h, int tid) {
#pragma unroll
    for (int i = 0; i < 4; ++i) {
        const int id = tid + i * 512, m = id & 127, chn = id >> 7;
        const u32x4 v = *(const u32x4*)(Rv + (size_t)(t0 + m) * 512 + h * 128 + chn * 8);
        LAS bf16* d = (LAS bf16*)(lds + R_SVT) + (chn * 8) * 136 + m;
        d[0 * 136] = (bf16)(v.x & 0xffff); d[1 * 136] = (bf16)(v.x >> 16); d[2 * 136] = (bf16)(v.y & 0xffff); d[3 * 136] = (bf16)(v.y >> 16);
        d[4 * 136] = (bf16)(v.z & 0xffff); d[5 * 136] = (bf16)(v.z >> 16); d[6 * 136] = (bf16)(v.w & 0xffff); d[7 * 136] = (bf16)(v.w >> 16);
    }
}
__device__ __forceinline__ void retkv_item(unsigned char* ws, LAS unsigned char* lds, int item, int tid, int wave, int lane) {
    const int bh = item >> 6, n = item & 63, b = bh >> 2, h = bh & 3, t0 = b * SEQ + n * 128;
    const bf16* Rk = (const bf16*)(ws + WS_RK); const bf16* Rv = (const bf16*)(ws + WS_RV); float* KV = (float*)(ws + WS_KV) + (size_t)item * 8192;
    const float lg = LG2[h];
    stage_vT(lds, Rv, t0, h, tid);
#pragma unroll
    for (int i = 0; i < 2; ++i) {
        const int id = tid + i * 512, m = id & 127, chn = id >> 7;
        const u32x4 v = *(const u32x4*)(Rk + (size_t)(t0 + m) * 256 + h * 64 + chn * 8);
        const float z = exp2f((float)(127 - m) * lg);
        LAS bf16* d = (LAS bf16*)(lds + R_SQ) + (chn * 8) * 136 + m;
        const unsigned p0 = cvt_pk_bf16(bflo(v.x) * z, bfhi(v.x) * z), p1 = cvt_pk_bf16(bflo(v.y) * z, bfhi(v.y) * z), p2 = cvt_pk_bf16(bflo(v.z) * z, bfhi(v.z) * z), p3 = cvt_pk_bf16(bflo(v.w) * z, bfhi(v.w) * z);
        d[0 * 136] = (bf16)(p0 & 0xffff); d[1 * 136] = (bf16)(p0 >> 16); d[2 * 136] = (bf16)(p1 & 0xffff); d[3 * 136] = (bf16)(p1 >> 16);
        d[4 * 136] = (bf16)(p2 & 0xffff); d[5 * 136] = (bf16)(p2 >> 16); d[6 * 136] = (bf16)(p3 & 0xffff); d[7 * 136] = (bf16)(p3 >> 16);
    }
    __syncthreads();
    const int dt = wave & 3, eg = wave >> 2, lr = lane & 15, lq = lane >> 4;
    f32x4 acc[4];
#pragma unroll
    for (int j = 0; j < 4; ++j) acc[j] = (f32x4){0.f, 0.f, 0.f, 0.f};
#pragma unroll
    for (int kk = 0; kk < 4; ++kk) {
        const bf16x8 af = lds_frag(lds + R_SQ + ((dt * 16 + lr) * 136 + kk * 32 + 8 * lq) * 2);
#pragma unroll
        for (int j = 0; j < 4; ++j) {
            const bf16x8 bfr = lds_frag(lds + R_SVT + (((eg * 4 + j) * 16 + lr) * 136 + kk * 32 + 8 * lq) * 2);
            acc[j] = __builtin_amdgcn_mfma_f32_16x16x32_bf16(af, bfr, acc[j], 0, 0, 0);
        }
    }
#pragma unroll
    for (int j = 0; j < 4; ++j)
#pragma unroll
        for (int i = 0; i < 4; ++i) KV[(size_t)(dt * 16 + lq * 4 + i) * 128 + (eg * 4 + j) * 16 + lr] = acc[j][i];
    __syncthreads();
}
__device__ __forceinline__ void scan_phase(unsigned char* ws, int vcu, int G, int tid) {
    float* KV = (float*)(ws + WS_KV);
    for (int gid = vcu * 512 + tid; gid < 16 * 8192; gid += G * 512) {
        const int bh = gid >> 13, rem = gid & 8191, h = bh & 3;
        const float decay = exp2f(128.0f * LG2[h]);
        float* p = KV + ((size_t)bh * 64) * 8192 + rem;
        float st = 0.f;
#pragma unroll 8
        for (int n = 0; n < 64; ++n) { const float kv = p[(size_t)n * 8192]; p[(size_t)n * 8192] = st; st = decay * st + kv; }
    }
}
__device__ __forceinline__ void retout_item(unsigned char* ws, LAS unsigned char* lds, int item, int tid, int wave, int lane) {
    const int bh = item >> 6, n = item & 63, b = bh >> 2, h = bh & 3, t0 = b * SEQ + n * 128;
    const bf16* Rq = (const bf16*)(ws + WS_RQ); const bf16* Rk = (const bf16*)(ws + WS_RK); const bf16* Rv = (const bf16*)(ws + WS_RV);
    bf16* R = (bf16*)(ws + WS_SRZ); const float* PV = (const float*)(ws + WS_KV) + (size_t)item * 8192;
    const float lg = LG2[h];
#pragma unroll
    for (int i = 0; i < 2; ++i) {
        const int id = tid + i * 512, row = id >> 3, chn = id & 7;
        *(LAS u32x4*)(lds + R_SQ + row * 144 + chn * 16) = *(const u32x4*)(Rq + (size_t)(t0 + row) * 256 + h * 64 + chn * 8);
        *(LAS u32x4*)(lds + R_SK + row * 144 + chn * 16) = *(const u32x4*)(Rk + (size_t)(t0 + row) * 256 + h * 64 + chn * 8);
    }
    stage_vT(lds, Rv, t0, h, tid);
#pragma unroll
    for (int i = 0; i < 16; ++i) {
        const int id = tid + i * 512, d = id >> 7, e = id & 127;
        const float v = PV[id];
        ((LAS bf16*)(lds + R_SPT))[e * 72 + d] = (bf16)(cvt_pk_bf16(v, 0.f) & 0xffff);
    }
    __syncthreads();
    const int lr = lane & 15, lq = lane >> 4, c0 = wave * 16;
    bf16x8 aq[2];
#pragma unroll
    for (int kk = 0; kk < 2; ++kk) aq[kk] = lds_frag(lds + R_SQ + ((c0 + lr) * 72 + kk * 32 + 8 * lq) * 2);
#pragma unroll
    for (int mt = 0; mt < 8; ++mt) {
        f32x4 s = (f32x4){0.f, 0.f, 0.f, 0.f};
#pragma unroll
        for (int kk = 0; kk < 2; ++kk) {
            const bf16x8 bk = lds_frag(lds + R_SK + ((mt * 16 + lr) * 72 + kk * 32 + 8 * lq) * 2);
            s = __builtin_amdgcn_mfma_f32_16x16x32_bf16(aq[kk], bk, s, 0, 0, 0);
        }
        const int mm = mt * 16 + lr;
#pragma unroll
        for (int i = 0; i < 4; ++i) {
            const int c = c0 + lq * 4 + i, df = c - mm;
            const float pv = (df >= 0) ? s[i] * exp2f((float)df * lg) : 0.f;
            ((LAS bf16*)(lds + R_SP))[c * 136 + mm] = (bf16)(cvt_pk_bf16(pv, 0.f) & 0xffff);
        }
    }
    f32x4 acc[8];
#pragma unroll
    for (int et = 0; et < 8; ++et) {
        acc[et] = (f32x4){0.f, 0.f, 0.f, 0.f};
#pragma unroll
        for (int kk = 0; kk < 2; ++kk) {
            const bf16x8 bp = lds_frag(lds + R_SPT + ((et * 16 + lr) * 72 + kk * 32 + 8 * lq) * 2);
            acc[et] = __builtin_amdgcn_mfma_f32_16x16x32_bf16(aq[kk], bp, acc[et], 0, 0, 0);
        }
    }
    float xi[4];
#pragma unroll
    for (int i = 0; i < 4; ++i) xi[i] = exp2f((float)(lq * 4 + i + 1 + (c0 & 127)) * lg);
#pragma unroll
    for (int et = 0; et < 8; ++et)
#pragma unroll
        for (int i = 0; i < 4; ++i) acc[et][i] *= xi[i];
    asm volatile("s_waitcnt lgkmcnt(0)" ::: "memory");
#pragma unroll
    for (int kk = 0; kk < 4; ++kk) {
        const bf16x8 ap = lds_frag(lds + R_SP + ((c0 + lr) * 136 + kk * 32 + 8 * lq) * 2);
#pragma unroll
        for (int et = 0; et < 8; ++et) {
            const bf16x8 bv = lds_frag(lds + R_SVT + ((et * 16 + lr) * 136 + kk * 32 + 8 * lq) * 2);
            acc[et] = __builtin_amdgcn_mfma_f32_16x16x32_bf16(ap, bv, acc[et], 0, 0, 0);
        }
    }
#pragma unroll
    for (int i = 0; i < 4; ++i) {
        float q = 0.f;
#pragma unroll
        for (int et = 0; et < 8; ++et) q += acc[et][i] * acc[et][i];
        q += __shfl_xor(q, 1); q += __shfl_xor(q, 2); q += __shfl_xor(q, 4); q += __shfl_xor(q, 8);
        const float rs = rsqrtf(q * (1.0f / 128.0f) + EPS);
        bf16* rp = R + (size_t)(t0 + c0 + lq * 4 + i) * 512 + h * 128 + lr;
#pragma unroll
        for (int et = 0; et < 8; ++et) { const float z = bf2f(rp[et * 16]); rp[et * 16] = (bf16)(cvt_pk_bf16(acc[et][i] * rs * z, 0.f) & 0xffff); }
    }
    __syncthreads();
}

__device__ __forceinline__ void attn_post(unsigned char* ws, int b, int h, int qi, const bf16* otmp, int l, const float* lp, const float* subg) {
    int tid_ = threadIdx.x; asm volatile("" : "+v"(tid_));
    const int lane = tid_ & 63, wave = __builtin_amdgcn_readfirstlane(tid_ >> 6);
    const float e1 = wave_sum(lp[lane] * lp[64 + lane]), e2 = wave_sum(lp[128 + lane] * lp[192 + lane]);
    const float lam_init = 0.8f - 0.6f * expf(-0.3f * (float)l);
    const float lam = expf(e1) - expf(e2) + lam_init, oml = 1.0f - lam_init;
    asm volatile("s_waitcnt vmcnt(0)" ::: "memory");
    __syncthreads();
    __builtin_amdgcn_fence(__ATOMIC_ACQUIRE, "agent");
    bf16* A = (bf16*)(ws + WS_SZA);
    const float g0 = subg[2 * lane] * oml, g1 = subg[2 * lane + 1] * oml;
#pragma unroll 4
    for (int rr = 0; rr < 32; ++rr) {
        const int row = wave * 32 + rr;
        const unsigned o0 = *(const unsigned*)(otmp + row * 256 + 2 * lane), o1 = *(const unsigned*)(otmp + row * 256 + 128 + 2 * lane);
        unsigned* ap = (unsigned*)(A + (size_t)(b * SEQ + qi * 256 + row) * 512 + h * 128 + 2 * lane);
        const unsigned z = *ap;
        const float d0 = bflo(o0) - lam * bflo(o1), d1 = bfhi(o0) - lam * bfhi(o1);
        const float ss = wave_sum(d0 * d0 + d1 * d1);
        const float rs = rsqrtf(ss * (1.0f / 128.0f) + EPS);
        *ap = cvt_pk_bf16(d0 * rs * g0 * bflo(z), d1 * rs * g1 * bfhi(z));
    }
    asm volatile("s_waitcnt vmcnt(0)" ::: "memory");
    __syncthreads();
}
__device__ __forceinline__ void attn_phase(unsigned char* ws, char* lds, int vcu, int G, int bx, int l, const float* lp, const float* subg) {
    const attn_body::bf16* Qa = (const attn_body::bf16*)(ws + WS_QA); const attn_body::bf16* Ka = (const attn_body::bf16*)(ws + WS_KA); const attn_body::bf16* Va = (const attn_body::bf16*)(ws + WS_VA);
    bf16* otmp = (bf16*)(ws + WS_OTMP) + (size_t)bx * 65536;
    for (int v = vcu; v < 256; v += G) {
        const int bh = v >> 4, b = bh >> 2, h = bh & 3, s = v & 15;
        for (int u8 = 0; u8 < 8; ++u8) {
            const int qi = (u8 < 4) ? s : 31 - s, cv = u8 & 3, c = cv >> 1, vh = cv & 1;
            attn_body::attn_unit<8, 512, 512, 512, 256>(qi * 256, Qa + (size_t)(b * SEQ + qi * 256) * 512 + (h * 2 + c) * 64, Ka + (size_t)(b * SEQ) * 512 + (h * 2 + c) * 64,
                                                        Va + (size_t)(b * SEQ) * 512 + h * 128 + vh * 64, (attn_body::bf16*)otmp + cv * 64, lds);
            if (cv == 3) attn_post(ws, b, h, qi, otmp, l, lp, subg);
        }
    }
}

constexpr int PH_PER_LAYER = 7, N_PHASES = 1 + DEPTH * PH_PER_LAYER + 1;

__global__ void __launch_bounds__(NWAVES * 64, 2) trunk_fwd(Args args) {
    extern __shared__ __attribute__((aligned(16))) unsigned char lds_raw[];
    LAS unsigned char* lds = (LAS unsigned char*)lds_raw;
#define TIDS() int tid = threadIdx.x; asm volatile("" : "+v"(tid)); const int lane = tid & 63, wave = __builtin_amdgcn_readfirstlane(tid >> 6); (void)lane; (void)wave
#define WSO() unsigned char* ws = args.ws; asm volatile("" : "+s"(ws)); float* ssq = (float*)(ws + WS_SSQ); bf16* xb = (bf16*)(ws + WS_XB); (void)ssq; (void)xb
    const int G = gridDim.x, bx = blockIdx.x;
    const int vcu = (G % 8 == 0) ? (bx % 8) * (G / 8) + bx / 8 : bx;
    const int lo = args.ph_lo, hi = args.ph_hi;
#if MK_MULTI
#define SEAM() do {} while (0)
#else
    cg::grid_group grid = cg::this_grid();
#define SEAM() grid.sync()
#endif
#ifndef PHASE_MASK
#define PHASE_MASK 0x1ff
#endif
#define PH_ON(t) ((PHASE_MASK >> (t)) & 1)
#define IN(k) (lo <= (k) && (k) < hi)
#define BOTH(k) (IN(k) && IN((k) + 1))

    if (PH_ON(0) && IN(0)) { TIDS(); phase_prologue(args, lds, vcu, G, wave, lane); if (BOTH(0)) SEAM(); }

    for (int l = 0; l < DEPTH; ++l) {
        const int p0 = 1 + l * PH_PER_LAYER;
        if (PH_ON(1) && IN(p0)) {
            WSO(); const bf16* Win = (const bf16*)(ws + WS_WIN + l * WIN_L);
            pg8::Gemm g{xb, xb, xb, Win, 0, T, NPROJ, DM}; pg8::StaticOrder S; S.init(T, NPROJ, G, bx);
            EpiProj E{ws, ssq, (const float2*)(ws + WS_ROPEA), (const float2*)(ws + WS_ROPER)};
            pg8::gemm_phase<EpiProj, pg8::StaticOrder, true, true>(lds, g, S, E);
            if (BOTH(p0)) SEAM();
        }
        if (PH_ON(2) && IN(p0 + 1)) {
            WSO();
            TIDS();
            for (int it = vcu; it < 1024; it += G) retkv_item(ws, lds, it, tid, wave, lane);
            for (int it = vcu; it < T / 64; it += G) conv_item(ws, args.in[5] + (size_t)l * 3 * 512, it, tid);
            if (BOTH(p0 + 1)) SEAM();
        }
        if (PH_ON(3) && IN(p0 + 2)) { WSO(); TIDS(); scan_phase(ws, vcu, G, tid); if (BOTH(p0 + 2)) SEAM(); }
        if (PH_ON(4) && IN(p0 + 3)) {
            WSO();
            attn_phase(ws, (char*)lds_raw, vcu, G, bx, l, args.in[3] + (size_t)l * 4 * 64, args.in[4] + l * 128);
            TIDS();
            for (int it = vcu; it < 1024; it += G) retout_item(ws, lds, it, tid, wave, lane);
            if (BOTH(p0 + 3)) SEAM();
        }
        if (PH_ON(5) && IN(p0 + 4)) {
            WSO(); const bf16* Win = (const bf16*)(ws + WS_WIN + l * WIN_L);
            pg8::Gemm g{xb, xb, xb, Win + (size_t)NPROJ * DM, 0, T, NGATE, DM}; pg8::StaticOrder S; S.init(T, NGATE, G, bx);
            EpiGate E{(bf16*)(ws + WS_G), ssq};
            pg8::gemm_phase<EpiGate, pg8::StaticOrder, true, true>(lds, g, S, E);
            if (BOTH(p0 + 4)) SEAM();
        }
        if (PH_ON(6) && IN(p0 + 5)) {
            WSO();
            pg8::Gemm g{(const bf16*)(ws + WS_SZA), (const bf16*)(ws + WS_CB), (const bf16*)(ws + WS_SRZ), (const bf16*)(ws + WS_WBR + l * WBR_L), (size_t)DM * 512 * 2, T, DM, 512};
            ChainOrder S; S.S.init(T, DM, G, bx);
            EpiChain E{(const bf16*)(ws + WS_G), (bf16*)(ws + WS_MERGED)};
            pg8::gemm_phase<EpiChain, ChainOrder, true, true>(lds, g, S, E);
            if (BOTH(p0 + 5)) SEAM();
        }
        if (PH_ON(7) && IN(p0 + 6)) {
            WSO();
            const bf16* mg = (const bf16*)(ws + WS_MERGED);
            pg8::Gemm g{mg, mg, mg, (const bf16*)(ws + WS_WOUT + l * WOUT_L), 0, T, DM, DM}; pg8::StaticOrder S; S.init(T, DM, G, bx);
            EpiOut E{l == 0 ? args.in[0] : args.out, args.out, xb, ssq};
            pg8::gemm_phase<EpiOut, pg8::StaticOrder, true, true>(lds, g, S, E);
            if (BOTH(p0 + 6)) SEAM();
        }
    }
    if (PH_ON(8) && IN(N_PHASES - 1)) {
        WSO(); TIDS(); const float* gf = args.in[8]; float* out = args.out;
        const int gw = vcu * NWAVES + wave, NGW = G * NWAVES;
        f32x4 gv[4];
#pragma unroll
        for (int j = 0; j < 4; ++j) gv[j] = ((const f32x4*)gf)[lane + 64 * j];
        for (int m = gw; m < T; m += NGW) {
            float s = (lane < 16) ? ssq[(size_t)m * 16 + lane] : 0.f;
            s += __shfl_xor(s, 1); s += __shfl_xor(s, 2); s += __shfl_xor(s, 4); s += __shfl_xor(s, 8);
            s = __shfl(s, 0);
            const float rs = rsqrtf(s * (1.0f / DM) + EPS);
            f32x4* xr = (f32x4*)(out + (size_t)m * DM) + lane;
#pragma unroll
            for (int j = 0; j < 4; ++j) { f32x4 v = xr[64 * j]; v = v * rs * gv[j]; xr[64 * j] = v; }
        }
    }
#undef IN
#undef BOTH
#undef SEAM
}

extern "C" void kernel_launch(void* const* d_in, const int* in_sizes, int n_in, void* d_out, int out_size, void* d_ws, size_t ws_size, hipStream_t stream) {
    static int grid = 0;
    if (grid == 0) {
        if (n_in != 9 || in_sizes[0] != T * DM || out_size != T * DM || ws_size < WS_END) { fprintf(stderr, "kernel_launch: unexpected shapes / workspace (n_in %d, ws %zu)\n", n_in, ws_size); grid = -1; return; }
        int dev = 0, cus = 0, per_cu = 0;
        (void)hipGetDevice(&dev); (void)hipDeviceGetAttribute(&cus, hipDeviceAttributeMultiprocessorCount, dev);
        if (hipFuncSetAttribute((const void*)trunk_fwd, hipFuncAttributeMaxDynamicSharedMemorySize, LDS_BYTES) != hipSuccess) { fprintf(stderr, "kernel_launch: hipFuncSetAttribute failed\n"); grid = -1; return; }
        if (hipOccupancyMaxActiveBlocksPerMultiprocessor(&per_cu, (const void*)trunk_fwd, NWAVES * 64, LDS_BYTES) != hipSuccess || per_cu < 1) { fprintf(stderr, "kernel_launch: occupancy query gave %d\n", per_cu); per_cu = 1; }
        (void)hipGetLastError();
        grid = cus * per_cu;
    }
    if (grid < 0) return;
    Args a{};
    for (int i = 0; i < 9; ++i) a.in[i] = (const float*)d_in[i];
    a.out = (float*)d_out; a.ws = (unsigned char*)d_ws;
#if MK_MULTI
    for (int p = 0; p < N_PHASES; ++p) { a.ph_lo = p; a.ph_hi = p + 1; hipLaunchKernelGGL(trunk_fwd, dim3(grid), dim3(NWAVES * 64), LDS_BYTES, stream, a); }
#else
    a.ph_lo = 0; a.ph_hi = N_PHASES;
    void* kargs[] = {&a};
    hipError_t e = hipLaunchCooperativeKernel((const void*)trunk_fwd, dim3(grid), dim3(NWAVES * 64), kargs, LDS_BYTES, stream);
    if (e != hipSuccess) fprintf(stderr, "kernel_launch: cooperative launch failed: %s (grid %d)\n", hipGetErrorString(e), grid);
#endif
}
```

```cpp
#include <hip/hip_runtime.h>
#include <hip/hip_cooperative_groups.h>
#include <hip/hip_bf16.h>
#include <cstdio>
#include <cstdint>
#include <cmath>
namespace cg = cooperative_groups;
namespace pg8 {
#define PG8_LAS __attribute__((address_space(3)))
typedef unsigned short bf16_t;
typedef short bf16x8 __attribute__((ext_vector_type(8)));
typedef float f32x4 __attribute__((ext_vector_type(4)));
typedef unsigned u32x4 __attribute__((ext_vector_type(4)));
constexpr int BM = 256, BK = 64, HALF = 128, HTB = HALF * BK * 2  , STAGE_BYTES = 8 * HTB, NXCD = 8, WGM = 8;

__host__ __device__ __forceinline__ int lds_byte(int r, int c) { const int st = (r >> 4) * 2 + (c >> 5), rr = r & 15, cc = c & 31, ob = rr * 64 + cc * 2; return st * 1024 + (ob ^ (((ob >> 9) & 1) << 5)); }
__host__ __device__ __forceinline__ void stage_rc(int b, int& R, int& C) { const int st = b / 1024, sb = b % 1024, swz = sb ^ (((sb >> 9) & 1) << 5); R = (st >> 1) * 16 + swz / 64; C = (st & 1) * 32 + (swz % 64) / 2; }
__host__ __device__ __forceinline__ int perm32(int rho) { const int n = rho >> 4, i = rho & 15; return 8 * (i >> 2) + 4 * n + (i & 3); }

struct Unit { int pm, pn, seg; };
struct Gemm { const bf16_t* A0; const bf16_t* A1; const bf16_t* A2; const bf16_t* Bt; size_t bseg  ; int M, N, K; };
__device__ __forceinline__ const char* gemm_abase(const Gemm& g, int seg) { return (const char*)(seg == 0 ? g.A0 : (seg == 1 ? g.A1 : g.A2)); }

struct StaticOrder {
    int nM, nN, nwg, G, c;
    __host__ __device__ void init(int M, int N, int G_, int c_) { nM = M / BM; nN = N / BM; nwg = nM * nN; G = G_; c = c_; }
    __host__ __device__ bool next(int i, Unit& u) const {
        const long L = (long)i * G + c; if (L >= nwg) return false;
        int wgid = (int)L; { const int q = nwg / NXCD, r = nwg % NXCD, xcd = wgid % NXCD, off = wgid / NXCD; wgid = (xcd < r ? xcd * (q + 1) : r * (q + 1) + (xcd - r) * q) + off; }
        const int nig = WGM * nN, gid = wgid / nig, fm = gid * WGM, gsz = (nM - fm) < WGM ? (nM - fm) : WGM;
        u.pm = fm + ((wgid % nig) % gsz); u.pn = (wgid % nig) / gsz; u.seg = 0; return true;
    }
    __device__ __forceinline__ void a_ready(const Unit&) const {}
    __device__ __forceinline__ void done(const Unit&) const {}
};

__device__ __forceinline__ unsigned cvt_pk_bf16(float lo, float hi) { unsigned r; asm volatile("v_cvt_pk_bf16_f32 %0, %1, %2" : "=v"(r) : "v"(lo), "v"(hi)); return r; }
typedef float f32x2 __attribute__((ext_vector_type(2)));
template <class Epi, class Sched, bool ALIGN_EPI = false, bool SP2 = false>
__device__ __forceinline__ void gemm_phase(PG8_LAS unsigned char* lds, const Gemm g, const Sched& S, const Epi& E) {
    int tid = threadIdx.x; asm volatile("" : "+v"(tid));
    const int wid = __builtin_amdgcn_readfirstlane(tid >> 6), lane = tid & 63, wr = wid >> 2, wc = wid & 3, fr = lane & 15, fq = lane >> 4;
    const int K = g.K, nt = K / BK;
    unsigned voffA[2], voffB[2];
#pragma unroll
    for (int i = 0; i < 2; ++i) { int R, C; stage_rc(tid * 16 + i * 8192, R, C); const int Rb = Epi::PERM ? ((R & ~31) + perm32(R & 31)) : R;
        voffA[i] = (unsigned)(R * K + C) * 2u; voffB[i] = (unsigned)(Rb * K + C) * 2u; }
    const size_t kstep = (size_t)(BK * 2);
    const size_t hstep = (size_t)HALF * K * 2;
    const size_t tstep = 2 * hstep;
    const unsigned ldsw = (unsigned)wid * 1024u;
    const int aoff = lds_byte(wr * 64 + fr, fq * 8), boff = lds_byte(wc * 32 + fr, fq * 8);
#define PG8_SA(b, h) (((b) * 2 + (h)) * HTB)
#define PG8_SB(b, h) ((4 + (b) * 2 + (h)) * HTB)
#define PG8_STAGE(bufoff, gbase, voff) do { _Pragma("unroll") for (int _i = 0; _i < 2; ++_i) \
        __builtin_amdgcn_global_load_lds((const unsigned*)((const char*)(gbase) + (voff)[_i]), (PG8_LAS unsigned*)(lds + (bufoff) + ldsw + _i * 8192), 16, 0, 0); } while (0)
#define PG8_LDA(dst, b, h) do { _Pragma("unroll") for (int m = 0; m < 4; ++m) _Pragma("unroll") for (int k = 0; k < 2; ++k) dst[m][k] = *(const PG8_LAS bf16x8*)(lds + PG8_SA(b, h) + aoff + m * 2048 + k * 1024); } while (0)
#define PG8_LDB(dst, b, h) do { _Pragma("unroll") for (int n = 0; n < 2; ++n) _Pragma("unroll") for (int k = 0; k < 2; ++k) dst[n][k] = *(const PG8_LAS bf16x8*)(lds + PG8_SB(b, h) + boff + n * 2048 + k * 1024); } while (0)
#define PG8_MMA(ai, bj, At, Bt) do { __builtin_amdgcn_s_setprio(1); _Pragma("unroll") for (int m = 0; m < 4; ++m) _Pragma("unroll") for (int n = 0; n < 2; ++n) _Pragma("unroll") for (int k = 0; k < 2; ++k) \
        acc[ai][bj][m][n] = __builtin_amdgcn_mfma_f32_16x16x32_bf16(Bt[n][k], At[m][k], acc[ai][bj][m][n], 0, 0, 0); __builtin_amdgcn_s_setprio(0); } while (0)
#define PG8_WAIT_V(n) asm volatile("s_waitcnt vmcnt(" #n ")" ::: "memory")
#define PG8_WAIT_L(n) asm volatile("s_waitcnt lgkmcnt(" #n ")" ::: "memory")
#define PG8_BAR __builtin_amdgcn_s_barrier()
#define PG8_SCHED __builtin_amdgcn_sched_barrier(0)
    Unit cur, nxt; int ui = 0;
    if (!S.next(0, cur)) return;
    f32x4 acc[2][2][4][2];
#pragma unroll
    for (int a = 0; a < 2; ++a)
#pragma unroll
        for (int b = 0; b < 2; ++b)
#pragma unroll
            for (int m = 0; m < 4; ++m)
#pragma unroll
                for (int n = 0; n < 2; ++n) acc[a][b][m][n] = (f32x4){0.f, 0.f, 0.f, 0.f};
    bf16x8 At[4][2], B0[2][2], B1[2][2];
    const char* cA = gemm_abase(g, cur.seg) + (size_t)cur.pm * tstep; const char* cB = (const char*)g.Bt + (size_t)cur.seg * g.bseg + (size_t)cur.pn * tstep;
    S.a_ready(cur);
    if constexpr (SP2) {
        PG8_STAGE(PG8_SB(0, 0), cB, voffB); PG8_STAGE(PG8_SB(0, 1), cB + hstep, voffB); PG8_STAGE(PG8_SA(0, 0), cA, voffA); PG8_STAGE(PG8_SA(0, 1), cA + hstep, voffA);
        if (wr == 1) PG8_BAR;
        PG8_WAIT_V(2); PG8_BAR;
        PG8_STAGE(PG8_SB(1, 0), cB + kstep, voffB); PG8_STAGE(PG8_SA(1, 0), cA + kstep, voffA); PG8_STAGE(PG8_SB(1, 1), cB + hstep + kstep, voffB);
        PG8_WAIT_V(6); PG8_BAR;
    } else {
        PG8_STAGE(PG8_SB(0, 0), cB, voffB); PG8_STAGE(PG8_SA(0, 0), cA, voffA); PG8_STAGE(PG8_SB(0, 1), cB + hstep, voffB); PG8_STAGE(PG8_SA(0, 1), cA + hstep, voffA);
        if (wr == 1) PG8_BAR;
        PG8_WAIT_V(4); PG8_BAR;
        PG8_STAGE(PG8_SB(1, 0), cB + kstep, voffB); PG8_STAGE(PG8_SA(1, 0), cA + kstep, voffA); PG8_STAGE(PG8_SB(1, 1), cB + hstep + kstep, voffB);
        PG8_WAIT_V(6); PG8_BAR;
    }
    for (;;) {
        const bool has_next = S.next(ui + 1, nxt);
        const char* nA = has_next ? gemm_abase(g, nxt.seg) + (size_t)nxt.pm * tstep : cA; const char* nB = has_next ? (const char*)g.Bt + (size_t)nxt.seg * g.bseg + (size_t)nxt.pn * tstep : cB;
        for (int t = 0; t < nt; t += 2) {
            const bool last = (t == nt - 2);
            const char* a1 = cA + (size_t)(t + 1) * kstep;
            const char* a2 = last ? nA : cA + (size_t)(t + 2) * kstep; const char* b2 = last ? nB : cB + (size_t)(t + 2) * kstep;
            const char* a3 = a2 + kstep; const char* b3 = b2 + kstep;
            if (last && has_next) S.a_ready(nxt);
            if constexpr (SP2) {
            PG8_LDB(B0, 0, 0); PG8_LDB(B1, 0, 1); PG8_SCHED; PG8_LDA(At, 0, 0); PG8_STAGE(PG8_SA(1, 1), a1 + hstep, voffA);
            PG8_WAIT_V(8); PG8_WAIT_L(0); PG8_BAR; PG8_MMA(0, 0, At, B0); PG8_MMA(0, 1, At, B1); PG8_BAR; PG8_SCHED;
            PG8_LDA(At, 0, 1); PG8_STAGE(PG8_SB(0, 0), b2, voffB); PG8_STAGE(PG8_SB(0, 1), b2 + hstep, voffB); PG8_STAGE(PG8_SA(0, 0), a2, voffA);
            PG8_WAIT_V(8); PG8_WAIT_L(0); PG8_BAR; PG8_MMA(1, 0, At, B0); PG8_MMA(1, 1, At, B1); PG8_BAR; PG8_SCHED;
            PG8_LDB(B0, 1, 0); PG8_LDB(B1, 1, 1); PG8_SCHED; PG8_LDA(At, 1, 0); PG8_STAGE(PG8_SA(0, 1), a2 + hstep, voffA);
            PG8_WAIT_V(8); PG8_WAIT_L(0); PG8_BAR; PG8_MMA(0, 0, At, B0); PG8_MMA(0, 1, At, B1); PG8_BAR; PG8_SCHED;
            PG8_LDA(At, 1, 1); PG8_STAGE(PG8_SB(1, 0), b3, voffB); PG8_STAGE(PG8_SB(1, 1), b3 + hstep, voffB); PG8_STAGE(PG8_SA(1, 0), a3, voffA);
            PG8_WAIT_V(8); PG8_WAIT_L(0); PG8_BAR; PG8_MMA(1, 0, At, B0); PG8_MMA(1, 1, At, B1); PG8_BAR; PG8_SCHED;
            } else {
            PG8_LDB(B0, 0, 0); PG8_SCHED; PG8_LDA(At, 0, 0); PG8_STAGE(PG8_SA(1, 1), a1 + hstep, voffA);
            PG8_WAIT_L(8); PG8_BAR; PG8_WAIT_L(0); PG8_MMA(0, 0, At, B0); PG8_BAR; PG8_SCHED;
            PG8_LDB(B1, 0, 1); PG8_STAGE(PG8_SB(0, 0), b2, voffB);
            PG8_BAR; PG8_WAIT_L(0); PG8_MMA(0, 1, At, B1); PG8_BAR;
            PG8_LDA(At, 0, 1); PG8_STAGE(PG8_SA(0, 0), a2, voffA);
            PG8_BAR; PG8_WAIT_L(0); PG8_MMA(1, 0, At, B0); PG8_BAR; PG8_SCHED;
            PG8_STAGE(PG8_SB(0, 1), b2 + hstep, voffB);
            PG8_WAIT_V(6); PG8_BAR; PG8_MMA(1, 1, At, B1); PG8_BAR;
            PG8_LDB(B0, 1, 0); PG8_SCHED; PG8_LDA(At, 1, 0); PG8_STAGE(PG8_SA(0, 1), a2 + hstep, voffA);
            PG8_WAIT_L(8); PG8_BAR; PG8_WAIT_L(0); PG8_MMA(0, 0, At, B0); PG8_BAR; PG8_SCHED;
            PG8_LDB(B1, 1, 1); PG8_STAGE(PG8_SB(1, 0), b3, voffB);
            PG8_BAR; PG8_WAIT_L(0); PG8_MMA(0, 1, At, B1); PG8_BAR;
            PG8_LDA(At, 1, 1); PG8_STAGE(PG8_SA(1, 0), a3, voffA);
            PG8_BAR; PG8_WAIT_L(0); PG8_MMA(1, 0, At, B0); PG8_BAR; PG8_SCHED;
            PG8_STAGE(PG8_SB(1, 1), b3 + hstep, voffB);
            PG8_WAIT_V(6); PG8_BAR; PG8_MMA(1, 1, At, B1); PG8_BAR;
            }
        }
        if constexpr (ALIGN_EPI) { if (wr == 0) PG8_BAR; }
        if constexpr (!Epi::AFTER_DRAIN) { E(acc, cur, wr, wc, fr, fq); S.done(cur); }
        if (!has_next) break;
        if (!E.keep(cur)) {
#pragma unroll
        for (int a = 0; a < 2; ++a)
#pragma unroll
            for (int b = 0; b < 2; ++b)
#pragma unroll
                for (int m = 0; m < 4; ++m)
#pragma unroll
                    for (int n = 0; n < 2; ++n) acc[a][b][m][n] = (f32x4){0.f, 0.f, 0.f, 0.f};
        }
        cur = nxt; cA = nA; cB = nB; ++ui;
        if constexpr (ALIGN_EPI) { if (wr == 1) PG8_BAR; }
    }
    PG8_WAIT_V(0);
    if constexpr (!ALIGN_EPI) { if (wr == 0) PG8_BAR; }
    PG8_BAR;
    if constexpr (Epi::AFTER_DRAIN) { E.fused(acc, cur, wr, wc, fr, fq, lds, wid, lane); S.done(cur); }
#undef PG8_SA
#undef PG8_SB
#undef PG8_STAGE
#undef PG8_LDA
#undef PG8_LDB
#undef PG8_MMA
#undef PG8_WAIT_V
#undef PG8_WAIT_L
#undef PG8_BAR
#undef PG8_SCHED
}
}
namespace attn_body {
using bf16=__hip_bfloat16;
using bf16x8=__attribute__((ext_vector_type(8)))short;
using s16x4=__attribute__((ext_vector_type(4)))short;
using f32x16=__attribute__((ext_vector_type(16)))float;
using u32x4=__attribute__((ext_vector_type(4)))unsigned;
constexpr int SEQ=8192,D=64;
constexpr int NW=8,QBLK=32,QB=QBLK*NW,KVBLK=64,NQB=SEQ/QB;
constexpr int ATTN_UNIT_ROWS=QB;
__device__ __forceinline__ int crow(int r,int hi){return (r&3)+8*(r>>2)+4*hi;}
#define SBAR() __builtin_amdgcn_sched_barrier(0)
__device__ __forceinline__ void cmask(f32x16&p0,f32x16&p1,int jb,int qrel,int hi){
  const float NEG=-INFINITY; int kb=64*jb+4*hi;
  #pragma unroll
  for(int r=0;r<16;++r){int kv=kb+(r&3)+8*(r>>2); if(kv>qrel)p0[r]=NEG; if(kv+32>qrel)p1[r]=NEG;}
}

constexpr int NSLOT=3, SLOTB=8192;
constexpr int LDS_K=0, LDS_V=NSLOT*SLOTB, LDS_WS=2*NSLOT*SLOTB, LDS_OST=LDS_WS+NW*64*4, LDS_BYTES=LDS_OST+NW*4096;
constexpr float C2=0.125f*1.4426950408889634f;
__device__ __forceinline__ void glds16(const void*gsrc,unsigned lds_dst){unsigned keep;
  asm volatile("s_mov_b32 %0, m0\n\ts_mov_b32 m0, %2\n\ts_nop 0\n\tglobal_load_lds_dwordx4 %1, off\n\ts_mov_b32 m0, %0":"=&s"(keep):"v"(gsrc),"s"(lds_dst):"memory");}
__device__ __forceinline__ float max3f(float a,float b,float c){float r;asm("v_max3_f32 %0, %1, %2, %3":"=v"(r):"v"(a),"v"(b),"v"(c));return r;}
__device__ __forceinline__ float max2f(float a,float b){float r;asm("v_max_f32_e32 %0, %1, %2":"=v"(r):"v"(a),"v"(b));return r;}
__device__ __forceinline__ float fadd_s(float a,float b){float r;asm("v_add_f32_e32 %0, %1, %2":"=v"(r):"v"(a),"v"(b));return r;}
__device__ __forceinline__ float fsub_s(float a,float b){float r;asm("v_sub_f32_e32 %0, %1, %2":"=v"(r):"v"(a),"v"(b));return r;}
typedef float f32x2_t __attribute__((ext_vector_type(2))); typedef __bf16 bf16x2_t __attribute__((ext_vector_type(2)));
__device__ __forceinline__ unsigned cvtpk_s(float lo,float hi){f32x2_t v={lo,hi};bf16x2_t b=__builtin_convertvector(v,bf16x2_t);return __builtin_bit_cast(unsigned,b);}
#define WAIT_BAR(N) asm volatile("s_waitcnt vmcnt(" #N ") lgkmcnt(0)\n\ts_barrier":::"memory")

__device__ __forceinline__ void qkt(f32x16&p0,f32x16&p1,const char*Kslot,const bf16x8*qr,const f32x16&negm,int r32,int hi){
  const char*kb=Kslot+hi*1024+r32*16;
  #pragma unroll
  for(int d0=0;d0<4;++d0){
    const bf16x8 b0=*reinterpret_cast<const bf16x8*>(kb+d0*2048);
    const bf16x8 b1=*reinterpret_cast<const bf16x8*>(kb+d0*2048+512);
    if(d0==0){p0=__builtin_amdgcn_mfma_f32_32x32x16_bf16(b0,qr[0],negm,0,0,0);p1=__builtin_amdgcn_mfma_f32_32x32x16_bf16(b1,qr[0],negm,0,0,0);}
    else{p0=__builtin_amdgcn_mfma_f32_32x32x16_bf16(b0,qr[d0],p0,0,0,0);p1=__builtin_amdgcn_mfma_f32_32x32x16_bf16(b1,qr[d0],p1,0,0,0);}}
}
typedef __attribute__((address_space(3))) const char* lds_cptr;
typedef short v4i16_t __attribute__((ext_vector_type(4)));
__device__ __forceinline__ void kload8(bf16x8*kf,lds_cptr kp){
  kf[0]=*(const __attribute__((address_space(3))) bf16x8*)(kp);      kf[1]=*(const __attribute__((address_space(3))) bf16x8*)(kp+512);
  kf[2]=*(const __attribute__((address_space(3))) bf16x8*)(kp+2048); kf[3]=*(const __attribute__((address_space(3))) bf16x8*)(kp+2560);
  kf[4]=*(const __attribute__((address_space(3))) bf16x8*)(kp+4096); kf[5]=*(const __attribute__((address_space(3))) bf16x8*)(kp+4608);
  kf[6]=*(const __attribute__((address_space(3))) bf16x8*)(kp+6144); kf[7]=*(const __attribute__((address_space(3))) bf16x8*)(kp+6656);
}
__device__ __forceinline__ void kload2(bf16x8*kf,lds_cptr kp,int j){ kf[2*j]=*(const __attribute__((address_space(3))) bf16x8*)(kp+j*2048); kf[2*j+1]=*(const __attribute__((address_space(3))) bf16x8*)(kp+j*2048+512); }
__device__ __forceinline__ s16x4 vtr(lds_cptr p){ return __builtin_bit_cast(s16x4,__builtin_amdgcn_ds_read_tr16_b64_v4i16((__attribute__((address_space(3))) v4i16_t*)p)); }
__device__ __forceinline__ float rowmax(const f32x16&p0,const f32x16&p1){
  float a=max3f(p0[0],p0[1],p1[0]),b=max3f(p0[2],p0[3],p1[1]);a=max3f(a,p1[2],p1[3]);
  #pragma unroll
  for(int r=4;r<16;r+=4){a=max3f(a,p0[r],p0[r+1]);b=max3f(b,p0[r+2],p0[r+3]);a=max3f(a,p1[r],p1[r+1]);b=max3f(b,p1[r+2],p1[r+3]);}
  const float m=max2f(a,b);
  auto rr=__builtin_amdgcn_permlane32_swap(__float_as_uint(m),__float_as_uint(m),false,false);
  return max2f(__uint_as_float(rr[0]),__uint_as_float(rr[1]));
}
__device__ __forceinline__ void pv(f32x16*o,int vb,bf16x8 pa0,bf16x8 pa1,bf16x8 pa2,bf16x8 pa3){
  #pragma unroll
  for(int d0=0;d0<2;++d0){s16x4 lo[4],hi[4];
    #pragma unroll
    for(int ks=0;ks<4;++ks){
      asm volatile("ds_read_b64_tr_b16 %0,%1 offset:%c2":"=&v"(lo[ks]):"v"(vb),"i"(d0*4096+ks*1024):"memory");
      asm volatile("ds_read_b64_tr_b16 %0,%1 offset:%c2":"=&v"(hi[ks]):"v"(vb),"i"(d0*4096+ks*1024+512):"memory");}
    asm volatile("s_waitcnt lgkmcnt(0)":::"memory");SBAR();
    #define PK(k) (bf16x8){lo[k][0],lo[k][1],lo[k][2],lo[k][3],hi[k][0],hi[k][1],hi[k][2],hi[k][3]}
    o[d0]=__builtin_amdgcn_mfma_f32_32x32x16_bf16(pa0,PK(0),o[d0],0,0,0);
    o[d0]=__builtin_amdgcn_mfma_f32_32x32x16_bf16(pa1,PK(1),o[d0],0,0,0);
    o[d0]=__builtin_amdgcn_mfma_f32_32x32x16_bf16(pa2,PK(2),o[d0],0,0,0);
    o[d0]=__builtin_amdgcn_mfma_f32_32x32x16_bf16(pa3,PK(3),o[d0],0,0,0);
    #undef PK
  }
}

#ifndef ATTN_STORE16
#define ATTN_STORE16(p,v) (*(u32x4*)(p)=(v))
#endif
template<int THRL,int PQ,int PK,int PV,int PO> __device__ __forceinline__ void attn_unit(int q0,const bf16*Qu,const bf16*__restrict__ Kh,const bf16*__restrict__ Vh,bf16*Ou,char*shm){
  int tid=threadIdx.x; asm volatile("":"+v"(tid)); const int lane=tid&63,r32=lane&31,hi=lane>>5; const int wid=__builtin_amdgcn_readfirstlane(tid>>6);
  const bf16*Qw=Qu+(long)(wid*QBLK)*PQ;
  const unsigned lds0=(unsigned)(uintptr_t)shm;
  float*wsf=(float*)(shm+LDS_WS)+wid*64;
  const bf16*ksrc=Kh+(long)lane*PK+wid*8;
  const bf16*vsrc=Vh+(long)(16*(wid&3)+(lane>>2))*PV+(wid>>2)*32+(lane&3)*8;
  const unsigned kdst=lds0+LDS_K+wid*1024, vdst=lds0+LDS_V+wid*1024;
  #define DMA_K(t,slot) glds16(ksrc+(long)(t)*KVBLK*PK,(unsigned)__builtin_amdgcn_readfirstlane(kdst+(slot)))
  #define DMA_V(t,slot) glds16(vsrc+(long)(t)*KVBLK*PV,(unsigned)__builtin_amdgcn_readfirstlane(vdst+(slot)))
  const int vb0=(int)(lds0+LDS_V)+((lane>>4)&1)*32+(lane&3)*8+(4*hi+((lane&15)>>2))*64;
  const char*Kbase=shm+LDS_K; bf16x8 kf[8];
  const lds_cptr shm3=(lds_cptr)shm; const lds_cptr kp0=shm3+LDS_K+hi*1024+r32*16; const lds_cptr vp0=shm3+LDS_V+((lane>>4)&1)*32+(lane&3)*8+(4*hi+((lane&15)>>2))*64;
  const int NT=(q0+QB)/KVBLK;
  DMA_K(0,0);DMA_V(0,0);DMA_K(1,SLOTB);
  bf16x8 qr[4];
  #pragma unroll
  for(int d0=0;d0<4;++d0)qr[d0]=*reinterpret_cast<const bf16x8*>(&Qw[(long)r32*PQ+d0*16+hi*8]);
  float mhat=0.f,l_reg=0.f;f32x16 o[2];o[0]=f32x16{};o[1]=f32x16{};f32x16 negm=f32x16{};asm volatile("":"+v"(negm));
  const int qrel=wid*QBLK+r32;
  #define CMASK(P0,P1,t) do{int jb_=(t)-(NT-4); if(jb_>=0)cmask(P0,P1,jb_,qrel,hi);}while(0)
  bool resc=false;
  #define START(P0,P1) do{ const float rm=rowmax(P0,P1); resc=false; \
    { const float dl=rm; mhat=fadd_s(mhat,dl); \
      _Pragma("unroll") for(int r=0;r<16;++r){P0[r]=fsub_s(P0[r],dl);P1[r]=fsub_s(P1[r],dl);} \
      _Pragma("unroll") for(int r=0;r<16;++r)negm[r]=-mhat; asm volatile("":"+v"(negm)); } \
    _Pragma("unroll") for(int r=0;r<16;++r)P0[r]=__builtin_amdgcn_exp2f(P0[r]); }while(0)
  #define RESC() do{ if(resc){ asm volatile("s_waitcnt lgkmcnt(0)":::"memory"); \
      _Pragma("unroll") for(int d_=0;d_<2;++d_) _Pragma("unroll") for(int r=0;r<16;++r)o[d_][r]*=wsf[crow(r,hi)]; } }while(0)
  f32x16 pA0,pA1,pB0,pB1;
  int sl_prev=0,sl_cur=0,sl_next=SLOTB;
  #define ROT() do{sl_prev=sl_cur;sl_cur=sl_next;sl_next=(sl_next==(NSLOT-1)*SLOTB)?0:sl_next+SLOTB;}while(0)
  DMA_K(2,2*SLOTB);
  WAIT_BAR(3);
  qkt(pA0,pA1,Kbase,qr,negm,r32,hi);asm volatile("s_nop 15\n\ts_nop 7":"+v"(pA0),"+v"(pA1));CMASK(pA0,pA1,0);
  START(pA0,pA1);
  _Pragma("unroll") for(int r=0;r<16;++r)pA1[r]=__builtin_amdgcn_exp2f(pA1[r]);
  WAIT_BAR(0);
  DMA_K(3,0);DMA_V(1,SLOTB);
  ROT();
  kload8(kf,kp0+sl_cur);
  WAIT_BAR(2);
  s16x4 vlo[8],vhi[8]; u32x4 pw0,pw1,pw2,pw3;
  #define PKW(P,B) cvtpk_s(P[B],P[B+1])
  #define PAF(k) __builtin_bit_cast(bf16x8,pw##k)
  #define VFR(i) (bf16x8){vlo[i][0],vlo[i][1],vlo[i][2],vlo[i][3],vhi[i][0],vhi[i][1],vhi[i][2],vhi[i][3]}
  #define PIN(x) asm volatile("":"+v"(x))
  #define MX3(a,b,c) __builtin_fmaxf(__builtin_fmaxf((a),(b)),(c))
  #define GAPA(MF,A0,A1,A2,A3,W0,W1,PW) do{ MF; sacc+=A0; sacc+=A1; sacc+=A2; sacc+=A3; PIN(sacc); W0; W1; PIN(PW); SBAR(); }while(0)
  #define EX(v) __builtin_amdgcn_exp2f(v)
  #define GAPB(MF,X,B) do{ MF; X[B]=EX(X[B]); X[B+1]=EX(X[B+1]); X[B+2]=EX(X[B+2]); X[B+3]=EX(X[B+3]); PIN(X); SBAR(); }while(0)
  #define VRD(i) do{ vlo[i]=vtr(vp_+(((i)>>2)*4096+((i)&3)*1024)); vhi[i]=vtr(vp_+(((i)>>2)*4096+((i)&3)*1024+512)); }while(0)
  #define KRD(G,j) do{ if(G){ kload2(kf,kp0+sl_next,j); SBAR(); } }while(0)
  #define STEP(C0,C1,P0,P1,t,GK,GV,GL) do{ SBAR(); \
    const lds_cptr vp_=vp0+sl_prev; \
    VRD(0); SBAR(); float sacc=(P0[0]+P0[1]); \
    GAPA(C0=__builtin_amdgcn_mfma_f32_32x32x16_bf16(kf[0],qr[0],negm,0,0,0), P0[2],P0[3],P0[4],P0[5],     pw0[0]=PKW(P0,0), pw0[1]=PKW(P0,2), pw0); \
    VRD(4); SBAR(); GAPA(C1=__builtin_amdgcn_mfma_f32_32x32x16_bf16(kf[1],qr[0],negm,0,0,0), P0[6],P0[7],P0[8],P0[9],     pw0[2]=PKW(P0,4), pw0[3]=PKW(P0,6), pw0); \
    VRD(1); SBAR(); GAPA(C0=__builtin_amdgcn_mfma_f32_32x32x16_bf16(kf[2],qr[1],C0,0,0,0),   P0[10],P0[11],P0[12],P0[13], pw1[0]=PKW(P0,8), pw1[1]=PKW(P0,10), pw1); \
    VRD(5); SBAR(); GAPA(C1=__builtin_amdgcn_mfma_f32_32x32x16_bf16(kf[3],qr[1],C1,0,0,0),   P0[14],P0[15],P1[0],P1[1],   pw1[2]=PKW(P0,12),pw1[3]=PKW(P0,14), pw1); \
    VRD(2); SBAR(); GAPA(C0=__builtin_amdgcn_mfma_f32_32x32x16_bf16(kf[4],qr[2],C0,0,0,0),   P1[2],P1[3],P1[4],P1[5],     pw2[0]=PKW(P1,0), pw2[1]=PKW(P1,2), pw2); \
    VRD(6); SBAR(); GAPA(C1=__builtin_amdgcn_mfma_f32_32x32x16_bf16(kf[5],qr[2],C1,0,0,0),   P1[6],P1[7],P1[8],P1[9],     pw2[2]=PKW(P1,4), pw2[3]=PKW(P1,6), pw2); \
    VRD(3); SBAR(); GAPA(C0=__builtin_amdgcn_mfma_f32_32x32x16_bf16(kf[6],qr[3],C0,0,0,0),   P1[10],P1[11],P1[12],P1[13], pw3[0]=PKW(P1,8), pw3[1]=PKW(P1,10), pw3); \
    VRD(7); SBAR(); GAPA(C1=__builtin_amdgcn_mfma_f32_32x32x16_bf16(kf[7],qr[3],C1,0,0,0),   P1[14],P1[15],0.f,0.f,       pw3[2]=PKW(P1,12),pw3[3]=PKW(P1,14), pw3); \
    l_reg+=sacc; \
    if(GK){DMA_K((t)+3,sl_cur);} if(GV){DMA_V((t)+1,sl_next);} \
    CMASK(C0,C1,t); \
    { float a=MX3(C0[0],C0[1],C1[0]),b=MX3(C0[2],C0[3],C1[1]); a=MX3(a,C1[2],C1[3]); \
      _Pragma("unroll") for(int r=4;r<16;r+=4){a=MX3(a,C0[r],C0[r+1]);b=MX3(b,C0[r+2],C0[r+3]);a=MX3(a,C1[r],C1[r+1]);b=MX3(b,C1[r+2],C1[r+3]);} \
      float rm=__builtin_fmaxf(a,b); { auto rr=__builtin_amdgcn_permlane32_swap(__float_as_uint(rm),__float_as_uint(rm),false,false); rm=__builtin_fmaxf(__uint_as_float(rr[0]),__uint_as_float(rr[1])); } \
      resc=false; \
      if(__builtin_expect(__any(rm>(float)THRL),0)){ const float dl=__builtin_fmaxf(rm,0.f); mhat+=dl; \
        _Pragma("unroll") for(int r=0;r<16;++r){C0[r]-=dl;C1[r]-=dl;} \
        _Pragma("unroll") for(int r=0;r<16;++r)negm[r]=-mhat; asm volatile("":"+v"(negm)); \
        const float f=__builtin_amdgcn_exp2f(-dl); l_reg*=f; if(hi==0)wsf[r32]=f; resc=true; } } \
    SBAR(); \
    GAPB(o[0]=__builtin_amdgcn_mfma_f32_32x32x16_bf16(PAF(0),VFR(0),o[0],0,0,0), C0,0); \
    GAPB(o[1]=__builtin_amdgcn_mfma_f32_32x32x16_bf16(PAF(0),VFR(4),o[1],0,0,0), C0,4); \
    KRD(GL,0); GAPB(o[0]=__builtin_amdgcn_mfma_f32_32x32x16_bf16(PAF(1),VFR(1),o[0],0,0,0), C0,8); \
    KRD(GL,1); GAPB(o[1]=__builtin_amdgcn_mfma_f32_32x32x16_bf16(PAF(1),VFR(5),o[1],0,0,0), C0,12); \
    KRD(GL,2); GAPB(o[0]=__builtin_amdgcn_mfma_f32_32x32x16_bf16(PAF(2),VFR(2),o[0],0,0,0), C1,0); \
    KRD(GL,3); GAPB(o[1]=__builtin_amdgcn_mfma_f32_32x32x16_bf16(PAF(2),VFR(6),o[1],0,0,0), C1,4); \
    GAPB(o[0]=__builtin_amdgcn_mfma_f32_32x32x16_bf16(PAF(3),VFR(3),o[0],0,0,0), C1,8); \
    GAPB(o[1]=__builtin_amdgcn_mfma_f32_32x32x16_bf16(PAF(3),VFR(7),o[1],0,0,0), C1,12); \
    }while(0)
  int t=1;
  #undef CMASK
  #define CMASK(P0,P1,t) do{}while(0)
  for(;t+5<NT;t+=2){
    STEP(pB0,pB1,pA0,pA1,t,true,true,true);     WAIT_BAR(2); RESC(); ROT();
    STEP(pA0,pA1,pB0,pB1,t+1,true,true,true);   WAIT_BAR(2); RESC(); ROT();
  }
  #undef CMASK
  #define CMASK(P0,P1,t) do{int jb_=(t)-(NT-4); if(jb_>=0)cmask(P0,P1,jb_,qrel,hi);}while(0)
  #define ENDW(tt) do{ if((tt)+3<NT){WAIT_BAR(2);} else if((tt)+2<NT){WAIT_BAR(1);} else {WAIT_BAR(0);} }while(0)
  for(;t+1<NT;t+=2){
    STEP(pB0,pB1,pA0,pA1,t,(t+3<NT),(t+1<NT),(t+1<NT));       ENDW(t);   RESC(); ROT();
    STEP(pA0,pA1,pB0,pB1,t+1,(t+4<NT),(t+2<NT),(t+2<NT));     ENDW(t+1); RESC(); ROT();
  }
  STEP(pB0,pB1,pA0,pA1,NT-1,false,false,false); RESC();
  { float sacc=pB0[0]+pB0[1]; _Pragma("unroll") for(int r=2;r<16;++r)sacc+=pB0[r]; _Pragma("unroll") for(int r=0;r<16;++r)sacc+=pB1[r]; l_reg+=sacc;
    pw0=(u32x4){PKW(pB0,0),PKW(pB0,2),PKW(pB0,4),PKW(pB0,6)};pw1=(u32x4){PKW(pB0,8),PKW(pB0,10),PKW(pB0,12),PKW(pB0,14)};pw2=(u32x4){PKW(pB1,0),PKW(pB1,2),PKW(pB1,4),PKW(pB1,6)};pw3=(u32x4){PKW(pB1,8),PKW(pB1,10),PKW(pB1,12),PKW(pB1,14)};
    SBAR(); pv(o,vb0+sl_cur,PAF(0),PAF(1),PAF(2),PAF(3)); }
  #undef PKW
  #undef PAF
  #undef VFR
  #undef PIN
  #undef MX3
  #undef GAPA
  #undef GAPB
  #undef EX
  #undef VRD
  #undef KRD
  #undef STEP
  #undef ENDW
  {auto rr=__builtin_amdgcn_permlane32_swap(__float_as_uint(l_reg),__float_as_uint(l_reg),false,false);l_reg=__uint_as_float(rr[0])+__uint_as_float(rr[1]);}
  if(hi==0)wsf[32+r32]=l_reg;asm volatile("s_waitcnt lgkmcnt(0)":::"memory");
  float rli[16];
  #pragma unroll
  for(int r=0;r<16;++r)rli[r]=__builtin_amdgcn_rcpf(wsf[32+crow(r,hi)]);
  bf16*Ow=Ou+(long)(wid*QBLK)*PO;
  { bf16*stg=(bf16*)(shm+LDS_OST)+wid*2048;
    #pragma unroll
    for(int r=0;r<16;++r){const int orow=crow(r,hi);
      #pragma unroll
      for(int d0=0;d0<2;++d0)stg[orow*64+d0*32+r32]=__float2bfloat16(o[d0][r]*rli[r]);}
    asm volatile("s_waitcnt lgkmcnt(0)":::"memory");
    #pragma unroll
    for(int i=0;i<4;++i){const int row=i*8+(lane>>3),ch=lane&7; const u32x4 v=*(const u32x4*)(stg+row*64+ch*8); ATTN_STORE16(Ow+(long)row*PO+ch*8,v);} }
  asm volatile("s_waitcnt lgkmcnt(0)\n\ts_barrier":::"memory");
  #undef DMA_K
  #undef DMA_V
  #undef CMASK
  #undef START
  #undef RESC
  #undef ROT
}
constexpr int VSLOTB=16384;
constexpr int L2_K=0, L2_V=NSLOT*SLOTB, L2_WS=L2_V+NSLOT*VSLOTB, L2_OST=L2_WS+NW*64*4, L2_QS=L2_OST+NW*4096, L2_BYTES=L2_QS+NW*4096;
__device__ __forceinline__ void pv128(f32x16*o,int vb,bf16x8 pa0,bf16x8 pa1,bf16x8 pa2,bf16x8 pa3){
  #pragma unroll
  for(int d0=0;d0<4;++d0){s16x4 lo[4],hi[4];
    #pragma unroll
    for(int ks=0;ks<4;++ks){
      asm volatile("ds_read_b64_tr_b16 %0,%1 offset:%c2":"=&v"(lo[ks]):"v"(vb),"i"(d0*4096+ks*1024):"memory");
      asm volatile("ds_read_b64_tr_b16 %0,%1 offset:%c2":"=&v"(hi[ks]):"v"(vb),"i"(d0*4096+ks*1024+512):"memory");}
    asm volatile("s_waitcnt lgkmcnt(0)":::"memory");SBAR();
    #define PK(k) (bf16x8){lo[k][0],lo[k][1],lo[k][2],lo[k][3],hi[k][0],hi[k][1],hi[k][2],hi[k][3]}
    o[d0]=__builtin_amdgcn_mfma_f32_32x32x16_bf16(pa0,PK(0),o[d0],0,0,0);
    o[d0]=__builtin_amdgcn_mfma_f32_32x32x16_bf16(pa1,PK(1),o[d0],0,0,0);
    o[d0]=__builtin_amdgcn_mfma_f32_32x32x16_bf16(pa2,PK(2),o[d0],0,0,0);
    o[d0]=__builtin_amdgcn_mfma_f32_32x32x16_bf16(pa3,PK(3),o[d0],0,0,0);
    #undef PK
  }
}
template<int THRL,int PQ,int PK,int PV,int PO> __device__ __forceinline__ void attn_unit128(int q0,const bf16*Qu,const bf16*__restrict__ Kh,const bf16*__restrict__ Vh,bf16*Ou,char*shm){
  int tid=threadIdx.x; asm volatile("":"+v"(tid)); const int lane=tid&63,r32=lane&31,hi=lane>>5; const int wid=__builtin_amdgcn_readfirstlane(tid>>6);
  const bf16*Qw=Qu+(long)(wid*QBLK)*PQ;
  const unsigned lds0=(unsigned)(uintptr_t)shm;
  float*wsf=(float*)(shm+L2_WS)+wid*64;
  const bf16*ksrc=Kh+(long)lane*PK+wid*8;
  const bf16*vsrc=Vh+(long)(16*(wid&3)+(lane>>2))*PV+(wid>>2)*32+(lane&3)*8;
  const unsigned kdst=lds0+L2_K+wid*1024, vdst=lds0+L2_V+wid*1024;
  #define DMA_K(t,slot) glds16(ksrc+(long)(t)*KVBLK*PK,(unsigned)__builtin_amdgcn_readfirstlane(kdst+(slot)))
  #define DMA_V(t,slot) do{ glds16(vsrc+(long)(t)*KVBLK*PV,(unsigned)__builtin_amdgcn_readfirstlane(vdst+2*(slot))); glds16(vsrc+(long)(t)*KVBLK*PV+64,(unsigned)__builtin_amdgcn_readfirstlane(vdst+2*(slot)+8192)); }while(0)
  const int vb0=(int)(lds0+L2_V)+((lane>>4)&1)*32+(lane&3)*8+(4*hi+((lane&15)>>2))*64;
  const char*Kbase=shm+L2_K; bf16x8 kf[8];
  const lds_cptr shm3=(lds_cptr)shm; const lds_cptr kp0=shm3+L2_K+hi*1024+r32*16; const lds_cptr vp0=shm3+L2_V+((lane>>4)&1)*32+(lane&3)*8+(4*hi+((lane&15)>>2))*64;
  const int NT=(q0+QB)/KVBLK;
  DMA_K(0,0);DMA_V(0,0);DMA_K(1,SLOTB);
  bf16x8 qr[4];
  #pragma unroll
  for(int d0=0;d0<4;++d0)qr[d0]=*(const __attribute__((address_space(1))) bf16x8*)(&Qw[(long)r32*PQ+d0*16+hi*8]);
  typedef __attribute__((address_space(3))) bf16x8* lds_q_ptr; const lds_q_ptr qsp=(lds_q_ptr)((__attribute__((address_space(3))) char*)shm+L2_QS+wid*4096+lane*16);
  #pragma unroll
  for(int d0=0;d0<4;++d0)qsp[d0*64]=qr[d0];
  #define QL(d0) (qsp[(d0)*64])
  float mhat=0.f,l_reg=0.f;f32x16 o[4];o[0]=f32x16{};o[1]=f32x16{};o[2]=f32x16{};o[3]=f32x16{};f32x16 negm=f32x16{};asm volatile("":"+v"(negm));
  const int qrel=wid*QBLK+r32;
  #define CMASK(P0,P1,t) do{int jb_=(t)-(NT-4); if(jb_>=0)cmask(P0,P1,jb_,qrel,hi);}while(0)
  bool resc=false;
  #define START(P0,P1) do{ const float rm=rowmax(P0,P1); resc=false; \
    { const float dl=rm; mhat=fadd_s(mhat,dl); \
      _Pragma("unroll") for(int r=0;r<16;++r){P0[r]=fsub_s(P0[r],dl);P1[r]=fsub_s(P1[r],dl);} \
      _Pragma("unroll") for(int r=0;r<16;++r)negm[r]=-mhat; asm volatile("":"+v"(negm)); } \
    _Pragma("unroll") for(int r=0;r<16;++r)P0[r]=__builtin_amdgcn_exp2f(P0[r]); }while(0)
  #define RESC() do{ if(resc){ asm volatile("s_waitcnt lgkmcnt(0)":::"memory"); \
      _Pragma("unroll") for(int d_=0;d_<4;++d_) _Pragma("unroll") for(int r=0;r<16;++r)o[d_][r]*=wsf[crow(r,hi)]; } }while(0)
  f32x16 pA0,pA1,pB0,pB1;
  int sl_prev=0,sl_cur=0,sl_next=SLOTB;
  #define ROT() do{sl_prev=sl_cur;sl_cur=sl_next;sl_next=(sl_next==(NSLOT-1)*SLOTB)?0:sl_next+SLOTB;}while(0)
  DMA_K(2,2*SLOTB);
  WAIT_BAR(3);
  qkt(pA0,pA1,Kbase,qr,negm,r32,hi);asm volatile("s_nop 15\n\ts_nop 7":"+v"(pA0),"+v"(pA1));CMASK(pA0,pA1,0);
  START(pA0,pA1);
  _Pragma("unroll") for(int r=0;r<16;++r)pA1[r]=__builtin_amdgcn_exp2f(pA1[r]);
  WAIT_BAR(0);
  DMA_K(3,0);DMA_V(1,SLOTB);
  ROT();
  kload8(kf,kp0+sl_cur);
  bf16x8 qa=QL(0), qb=QL(1);
  WAIT_BAR(3);
  s16x4 val,vah,vbl,vbh,vcl,vch,vdl,vdh; u32x4 pw0,pw1,pw2,pw3;
  #define PKW(P,B) cvtpk_s(P[B],P[B+1])
  #define PAF(k) __builtin_bit_cast(bf16x8,pw##k)
  #define PIN(x) asm volatile("":"+v"(x))
  #define MX3(a,b,c) __builtin_fmaxf(__builtin_fmaxf((a),(b)),(c))
  #define GAPA(MF,A0,A1,A2,A3,W0,W1,PW) do{ MF; sacc+=A0; sacc+=A1; sacc+=A2; sacc+=A3; PIN(sacc); W0; W1; PIN(PW); SBAR(); }while(0)
  #define EX(v) __builtin_amdgcn_exp2f(v)
  #define GAPB(MF,X,B) do{ MF; X[B]=EX(X[B]); X[B+1]=EX(X[B+1]); PIN(X); SBAR(); }while(0)
  #define VADDR(n) ((((n)&3)*4096)+(((n)>>2)*1024))
  #define VLD(S,n) do{ S##l=vtr(vp_+VADDR(n)); S##h=vtr(vp_+VADDR(n)+512); SBAR(); }while(0)
  #define VFRS(S) (bf16x8){S##l[0],S##l[1],S##l[2],S##l[3],S##h[0],S##h[1],S##h[2],S##h[3]}
  #define MF32(A,B,C) __builtin_amdgcn_mfma_f32_32x32x16_bf16(A,B,C,0,0,0)
  #define KRD(G,j) do{ if(G){ kload2(kf,kp0+sl_next,j); SBAR(); } }while(0)
  #define STEP(C0,C1,P0,P1,t,GK,GV,GL) do{ SBAR(); \
    const lds_cptr vp_=vp0+2*sl_prev; \
    float sacc=(P0[0]+P0[1]); \
    GAPA(C0=MF32(kf[0],qa,negm), P0[2],P0[3],P0[4],P0[5],     pw0[0]=PKW(P0,0), pw0[1]=PKW(P0,2), pw0); \
    GAPA(C1=MF32(kf[1],qa,negm), P0[6],P0[7],P0[8],P0[9],     pw0[2]=PKW(P0,4), pw0[3]=PKW(P0,6), pw0); \
    qa=QL(2); SBAR(); GAPA(C0=MF32(kf[2],qb,C0),     P0[10],P0[11],P0[12],P0[13], pw1[0]=PKW(P0,8), pw1[1]=PKW(P0,10), pw1); \
    GAPA(C1=MF32(kf[3],qb,C1),     P0[14],P0[15],P1[0],P1[1],   pw1[2]=PKW(P0,12),pw1[3]=PKW(P0,14), pw1); \
    qb=QL(3); SBAR(); GAPA(C0=MF32(kf[4],qa,C0),     P1[2],P1[3],P1[4],P1[5],     pw2[0]=PKW(P1,0), pw2[1]=PKW(P1,2), pw2); \
    GAPA(C1=MF32(kf[5],qa,C1),     P1[6],P1[7],P1[8],P1[9],     pw2[2]=PKW(P1,4), pw2[3]=PKW(P1,6), pw2); \
    GAPA(C0=MF32(kf[6],qb,C0),     P1[10],P1[11],P1[12],P1[13], pw3[0]=PKW(P1,8), pw3[1]=PKW(P1,10), pw3); \
    GAPA(C1=MF32(kf[7],qb,C1),     P1[14],P1[15],0.f,0.f,       pw3[2]=PKW(P1,12),pw3[3]=PKW(P1,14), pw3); \
    l_reg+=sacc; \
    VLD(va,0); VLD(vb,1); VLD(vc,2); \
    if(GK){DMA_K((t)+3,sl_cur);} if(GV){DMA_V((t)+1,sl_next);} \
    CMASK(C0,C1,t); \
    { float a=MX3(C0[0],C0[1],C1[0]),b=MX3(C0[2],C0[3],C1[1]); a=MX3(a,C1[2],C1[3]); \
      _Pragma("unroll") for(int r=4;r<16;r+=4){a=MX3(a,C0[r],C0[r+1]);b=MX3(b,C0[r+2],C0[r+3]);a=MX3(a,C1[r],C1[r+1]);b=MX3(b,C1[r+2],C1[r+3]);} \
      float rm=__builtin_fmaxf(a,b); { auto rr=__builtin_amdgcn_permlane32_swap(__float_as_uint(rm),__float_as_uint(rm),false,false); rm=__builtin_fmaxf(__uint_as_float(rr[0]),__uint_as_float(rr[1])); } \
      resc=false; \
      if(__builtin_expect(__any(rm>(float)THRL),0)){ const float dl=__builtin_fmaxf(rm,0.f); mhat+=dl; \
        _Pragma("unroll") for(int r=0;r<16;++r){C0[r]-=dl;C1[r]-=dl;} \
        _Pragma("unroll") for(int r=0;r<16;++r)negm[r]=-mhat; asm volatile("":"+v"(negm)); \
        const float f=__builtin_amdgcn_exp2f(-dl); l_reg*=f; if(hi==0)wsf[r32]=f; resc=true; } } \
    SBAR(); \
    VLD(vd,3); GAPB(o[0]=MF32(PAF(0),VFRS(va),o[0]), C0,0); \
    VLD(va,4); GAPB(o[1]=MF32(PAF(0),VFRS(vb),o[1]), C0,2); \
    VLD(vb,5); GAPB(o[2]=MF32(PAF(0),VFRS(vc),o[2]), C0,4); \
    VLD(vc,6); GAPB(o[3]=MF32(PAF(0),VFRS(vd),o[3]), C0,6); \
    VLD(vd,7); KRD(GL,0); GAPB(o[0]=MF32(PAF(1),VFRS(va),o[0]), C0,8); \
    VLD(va,8); KRD(GL,1); GAPB(o[1]=MF32(PAF(1),VFRS(vb),o[1]), C0,10); \
    VLD(vb,9); KRD(GL,2); GAPB(o[2]=MF32(PAF(1),VFRS(vc),o[2]), C0,12); \
    VLD(vc,10); KRD(GL,3); GAPB(o[3]=MF32(PAF(1),VFRS(vd),o[3]), C0,14); \
    VLD(vd,11); GAPB(o[0]=MF32(PAF(2),VFRS(va),o[0]), C1,0); \
    VLD(va,12); GAPB(o[1]=MF32(PAF(2),VFRS(vb),o[1]), C1,2); \
    VLD(vb,13); GAPB(o[2]=MF32(PAF(2),VFRS(vc),o[2]), C1,4); \
    VLD(vc,14); GAPB(o[3]=MF32(PAF(2),VFRS(vd),o[3]), C1,6); \
    VLD(vd,15); GAPB(o[0]=MF32(PAF(3),VFRS(va),o[0]), C1,8); \
    GAPB(o[1]=MF32(PAF(3),VFRS(vb),o[1]), C1,10); \
    GAPB(o[2]=MF32(PAF(3),VFRS(vc),o[2]), C1,12); \
    GAPB(o[3]=MF32(PAF(3),VFRS(vd),o[3]), C1,14); \
    qa=QL(0); qb=QL(1);   \
    }while(0)
  int t=1;
  #undef CMASK
  #define CMASK(P0,P1,t) do{}while(0)
  for(;t+5<NT;t+=2){
    STEP(pB0,pB1,pA0,pA1,t,true,true,true);     WAIT_BAR(3); RESC(); ROT();
    STEP(pA0,pA1,pB0,pB1,t+1,true,true,true);   WAIT_BAR(3); RESC(); ROT();
  }
  #undef CMASK
  #define CMASK(P0,P1,t) do{int jb_=(t)-(NT-4); if(jb_>=0)cmask(P0,P1,jb_,qrel,hi);}while(0)
  #define ENDW(tt) do{ if((tt)+3<NT){WAIT_BAR(3);} else if((tt)+2<NT){WAIT_BAR(2);} else {WAIT_BAR(0);} }while(0)
  for(;t+1<NT;t+=2){
    STEP(pB0,pB1,pA0,pA1,t,(t+3<NT),(t+1<NT),(t+1<NT));       ENDW(t);   RESC(); ROT();
    STEP(pA0,pA1,pB0,pB1,t+1,(t+4<NT),(t+2<NT),(t+2<NT));     ENDW(t+1); RESC(); ROT();
  }
  STEP(pB0,pB1,pA0,pA1,NT-1,false,false,false); RESC();
  { float sacc=pB0[0]+pB0[1]; _Pragma("unroll") for(int r=2;r<16;++r)sacc+=pB0[r]; _Pragma("unroll") for(int r=0;r<16;++r)sacc+=pB1[r]; l_reg+=sacc;
    pw0=(u32x4){PKW(pB0,0),PKW(pB0,2),PKW(pB0,4),PKW(pB0,6)};pw1=(u32x4){PKW(pB0,8),PKW(pB0,10),PKW(pB0,12),PKW(pB0,14)};pw2=(u32x4){PKW(pB1,0),PKW(pB1,2),PKW(pB1,4),PKW(pB1,6)};pw3=(u32x4){PKW(pB1,8),PKW(pB1,10),PKW(pB1,12),PKW(pB1,14)};
    SBAR(); pv128(o,vb0+2*sl_cur,PAF(0),PAF(1),PAF(2),PAF(3)); }
  #undef PKW
  #undef PAF
  #undef QL
  #undef VADDR
  #undef VLD
  #undef VFRS
  #undef MF32
  #undef PIN
  #undef MX3
  #undef GAPA
  #undef GAPB
  #undef EX
  #undef KRD
  #undef STEP
  #undef ENDW
  {auto rr=__builtin_amdgcn_permlane32_swap(__float_as_uint(l_reg),__float_as_uint(l_reg),false,false);l_reg=__uint_as_float(rr[0])+__uint_as_float(rr[1]);}
  if(hi==0)wsf[32+r32]=l_reg;asm volatile("s_waitcnt lgkmcnt(0)":::"memory");
  float rli[16];
  #pragma unroll
  for(int r=0;r<16;++r)rli[r]=__builtin_amdgcn_rcpf(wsf[32+crow(r,hi)]);
  bf16*Ow=Ou+(long)(wid*QBLK)*PO;
  { bf16*stg=(bf16*)(shm+L2_OST)+wid*2048;
    #pragma unroll
    for(int hp=0;hp<2;++hp){
      #pragma unroll
      for(int r=0;r<16;++r){const int orow=crow(r,hi);
        #pragma unroll
        for(int d0=0;d0<2;++d0)stg[orow*64+d0*32+r32]=__float2bfloat16(o[hp*2+d0][r]*rli[r]);}
      asm volatile("s_waitcnt lgkmcnt(0)":::"memory");
      #pragma unroll
      for(int i=0;i<4;++i){const int row=i*8+(lane>>3),ch=lane&7; const u32x4 v=*(const u32x4*)(stg+row*64+ch*8); *(__attribute__((address_space(1))) u32x4*)(Ow+(long)row*PO+hp*64+ch*8)=v;}
      asm volatile("s_waitcnt lgkmcnt(0)":::"memory");
    } }
  asm volatile("s_waitcnt lgkmcnt(0)\n\ts_barrier":::"memory");
  #undef DMA_K
  #undef DMA_V
  #undef CMASK
  #undef START
  #undef RESC
  #undef ROT
}
constexpr int ATTN_LDS_BYTES=LDS_BYTES;
#undef SBAR
#undef WAIT_BAR
}

#ifndef MK_MULTI
#define MK_MULTI 0
#endif
#ifndef REP_GEMM
#define REP_GEMM 1
#endif
#ifndef REP_ATTN
#define REP_ATTN 1
#endif
#ifndef REP_LIGHT
#define REP_LIGHT 1
#endif
#define LAS __attribute__((address_space(3)))
typedef unsigned short bf16;
typedef float f32x4 __attribute__((ext_vector_type(4)));
typedef unsigned u32x4 __attribute__((ext_vector_type(4)));
typedef unsigned u32x2 __attribute__((ext_vector_type(2)));
typedef short bf16x8 __attribute__((ext_vector_type(8)));
using pg8::cvt_pk_bf16;

constexpr int DM = 1024, NB = 4, SEQ = 8192, T = NB * SEQ, DEPTH = 2;
constexpr int NIN = 8704, NPROJ = 5632, NGATE = 3072;
constexpr float EPS = 1e-6f;
constexpr float C2 = 0.18033688011112042f;
__device__ const float LG2[4] = {-0.04580368961312479f, -0.02272007650008353f, -0.011315313227834146f, -0.005646563141142063f};
__device__ const float INV_A[8] = {1.0f, 0.19392274474868576f, 0.03760603093086393f, 0.007292664737217109f, 0.001414213562373095f, 0.0002742481756762073f, 5.318295896944988e-05f, 1.031338537721246e-05f};
__device__ const float INV_R[32] = {1.0f, 0.7429639507594948f, 0.551995432128157f, 0.41011270705513014f, 0.30469895709035083f, 0.22638034095214482f, 0.16819243248808696f, 0.1249609141291987f,
    0.09284145445194744f, 0.06897785379387654f, 0.05124805876960934f, 0.038075460212223716f, 0.028288694346259694f, 0.021017480113324882f, 0.015615230060004972f, 0.011601553017399714f,
    0.008619535664753033f, 0.006404004271197283f, 0.004757944314009409f, 0.0035349811050301057f, 0.0026263635276533325f, 0.0019512934226359642f, 0.0014497406703726315f, 0.001077105056036769f,
    0.0008002502278161052f, 0.0005945570708544394f, 0.00044173447031400687f, 0.0003281927872511474f, 0.0002438354098268829f, 0.00018116091942004152f, 0.00013459603241553644f, 0.0001f};

constexpr size_t MiB = 1u << 20;
constexpr size_t WS_WIN = 2 * MiB;
constexpr size_t WIN_L = (size_t)NIN * DM * 2;
constexpr size_t WS_WBR = 36 * MiB;
constexpr size_t WBR_L = (size_t)3 * DM * 512 * 2;
constexpr size_t WS_WOUT = 42 * MiB;
constexpr size_t WOUT_L = (size_t)DM * DM * 2;
constexpr size_t WS_ROPEA = 46 * MiB;
constexpr size_t WS_ROPER = 46 * MiB + 512 * 1024;
constexpr size_t WS_SSQ = 49 * MiB;
constexpr size_t WS_RSTD = 51 * MiB;
constexpr size_t WS_XB = 52 * MiB;
constexpr size_t WS_PREVT = 116 * MiB;
constexpr size_t WS_ACT = 148 * MiB;
constexpr size_t SEG512 = (size_t)T * 512 * 2;
constexpr size_t WS_QA = WS_ACT, WS_KA = WS_QA + SEG512, WS_VA = WS_KA + SEG512, WS_CX = WS_VA + SEG512, WS_CC = WS_CX + SEG512, WS_SCZ = WS_CC + SEG512,
                 WS_SZA = WS_SCZ + SEG512, WS_CB = WS_SZA + SEG512, WS_RQ = WS_CB + SEG512, WS_RK = WS_RQ + SEG512 / 2, WS_RV = WS_RK + SEG512 / 2, WS_SRZ = WS_RV + SEG512,
                 WS_END = WS_SRZ + SEG512;
constexpr size_t WS_G = WS_QA;
constexpr size_t WS_MERGED = WS_RQ;
constexpr size_t WS_KV = WS_CC;
constexpr size_t WS_OTMP = WS_CX;
static_assert(WS_END == 500 * MiB, "ws map");
constexpr int LDS_BYTES = 147456;
constexpr int NWAVES = 8;

__device__ __forceinline__ int orig_col(int p) {
    if (p < 1024) { int d = p & 63; if (d < 16) { const int blk = d >> 3, half = (d >> 2) & 1, e = d & 3; d = half * 8 + blk * 4 + e; } return (p & ~63) | d; }
    if (p >= 2048 && p < 4096) { const int r = p & 255; return 2048 + 512 * (r >> 6) + 64 * ((p - 2048) >> 8) + (r & 63); }
    if (p >= 4096 && p < 4608) { const int d = p & 63, blk = d >> 3, half = (d >> 2) & 1, e = d & 3; return (p & ~63) | (half * 32 + blk * 4 + e); }
    return p;
}
__device__ __forceinline__ float wave_sum(float v) {
#pragma unroll
    for (int o = 1; o < 64; o <<= 1) v += __shfl_xor(v, o);
    return v;
}
__device__ __forceinline__ float bf2f(unsigned short b) { return __uint_as_float((unsigned)b << 16); }
__device__ __forceinline__ float bflo(unsigned w) { return __uint_as_float(w << 16); }
__device__ __forceinline__ float bfhi(unsigned w) { return __uint_as_float(w & 0xffff0000u); }
__device__ __forceinline__ float sigmoidf_(float x) { return __builtin_amdgcn_rcpf(1.0f + __builtin_amdgcn_exp2f(-1.4426950408889634f * x)); }
__device__ __forceinline__ float siluf_(float x) { return x * sigmoidf_(x); }

__device__ __forceinline__ void unpack8(const u32x4 a, float (&o)[8]) { o[0] = bflo(a.x); o[1] = bfhi(a.x); o[2] = bflo(a.y); o[3] = bfhi(a.y); o[4] = bflo(a.z); o[5] = bfhi(a.z); o[6] = bflo(a.w); o[7] = bfhi(a.w); }
#define GAS __attribute__((address_space(1)))
#define EPI_FENCE() asm volatile("" ::: "memory")
__device__ __forceinline__ float ssq_sum(const f32x4 s0, const f32x4 s1, const f32x4 s2, const f32x4 s3) {
    return ((s0[0] + s0[1]) + (s0[2] + s0[3])) + ((s1[0] + s1[1]) + (s1[2] + s1[3])) + ((s2[0] + s2[1]) + (s2[2] + s2[3])) + ((s3[0] + s3[1]) + (s3[2] + s3[3]));
}
struct EpiProj {
    static constexpr bool PERM = true, AFTER_DRAIN = false;
    unsigned char* ws; const float* rstd; const float2* ropeA; const float2* ropeR;
    __device__ __forceinline__ bool keep(const pg8::Unit&) const { return false; }
    __device__ __forceinline__ void operator()(f32x4 (&acc)[2][2][4][2], const pg8::Unit& u, int wr, int wc, int fr, int fq) const {
        const int pn = u.pn;
        const int row0 = u.pm * 256 + wr * 64 + fr;
        if (pn >= 8 && pn < 16) {
            const bool isu = wc < 2;
            bf16* dstc = (bf16*)(ws + (isu ? WS_CX : WS_CB)) + (pn - 8) * 64 + (wc & 1) * 32 + 8 * fq;
            float rsv[8];
#pragma unroll
            for (int it = 0; it < 8; ++it) rsv[it] = ((const GAS float*)rstd)[row0 + (it >> 2) * 128 + (it & 3) * 16];
            EPI_FENCE();
#pragma unroll
            for (int it = 0; it < 8; ++it) {
                const int ai = it >> 2, m = it & 3, row = row0 + ai * 128 + m * 16;
                const float rs = rsv[it];
                f32x4 a0 = acc[ai][0][m][0] * rs, a1 = acc[ai][0][m][1] * rs, b0 = acc[ai][1][m][0] * rs, b1 = acc[ai][1][m][1] * rs;
                if (!isu) {
#pragma unroll
                    for (int e = 0; e < 4; ++e) { b0[e] = siluf_(b0[e]); b1[e] = siluf_(b1[e]); }
                }
                a0 = a0 * b0; a1 = a1 * b1;
                u32x4 w; w.x = cvt_pk_bf16(a0[0], a0[1]); w.y = cvt_pk_bf16(a0[2], a0[3]); w.z = cvt_pk_bf16(a1[0], a1[1]); w.w = cvt_pk_bf16(a1[2], a1[3]);
                *(GAS u32x4*)(dstc + (size_t)row * 512) = w;
            }
            return;
        }
        int seg, lt;
        if (pn < 16) { seg = pn >> 1; lt = pn & 1; } else if (pn < 18) { seg = 8 + (pn - 16); lt = 0; } else { seg = 10 + ((pn - 18) >> 1); lt = (pn - 18) & 1; }
        size_t off; int pitch = 512;
        switch (seg) {
            case 0: off = WS_QA; break; case 1: off = WS_KA; break; case 2: off = WS_VA; break; case 3: off = WS_SZA; break;
            case 8: off = WS_RQ; pitch = 256; break; case 9: off = WS_RK; pitch = 256; break; case 10: off = WS_RV; break; default: off = WS_SRZ; break;
        }
        bf16* dst = (bf16*)(ws + off);
        const int lc0 = lt * 256 + wc * 32 + 8 * fq;
        const int ropemode = (seg <= 1) ? (((wc & 1) == 0 && fq < 2) ? 1 : 0) : ((seg == 8 || seg == 9) ? 2 : 0);
        const bool dosilu = (seg == 3 || seg == 11);
        const float scale = (seg == 0) ? C2 : ((seg == 9) ? 0.125f : 1.0f);
        const float* ropebase = (ropemode == 1) ? (const float*)(ropeA + 4 * fq) : (const float*)(ropeR + (4 * (wc & 1) + fq) * 4);
        const int ropepitch = (ropemode == 1) ? 16 : 64;
        f32x4 cr0 = (f32x4){0.f, 0.f, 0.f, 0.f}, cr1 = cr0;
        float rsv[8];
#pragma unroll
        for (int it = 0; it < 8; ++it) rsv[it] = ((const GAS float*)rstd)[row0 + (it >> 2) * 128 + (it & 3) * 16];
        { if (ropemode) { const GAS f32x4* rp = (const GAS f32x4*)(ropebase + (size_t)(row0 & (SEQ - 1)) * ropepitch); cr0 = rp[0]; cr1 = rp[1]; } }
#pragma unroll
        for (int it = 0; it < 8; ++it) {
            const int ai = it >> 2, m = it & 3, row = row0 + ai * 128 + m * 16;
            f32x4 nr0 = cr0, nr1 = cr1;
            if (it < 7) { const int rn = row0 + ((it + 1) >> 2) * 128 + ((it + 1) & 3) * 16;
                if (ropemode) { const GAS f32x4* rp = (const GAS f32x4*)(ropebase + (size_t)(rn & (SEQ - 1)) * ropepitch); nr0 = rp[0]; nr1 = rp[1]; } }
            EPI_FENCE();
            const float rs = rsv[it] * scale;
#pragma unroll
            for (int bj = 0; bj < 2; ++bj) {
                f32x4 v0 = acc[ai][bj][m][0] * rs, v1 = acc[ai][bj][m][1] * rs;
                if (ropemode) {
                    const float cs[8] = {cr0[0], cr0[1], cr0[2], cr0[3], cr1[0], cr1[1], cr1[2], cr1[3]};
#pragma unroll
                    for (int e = 0; e < 4; ++e) { const float c = cs[2 * e], s = cs[2 * e + 1], x1 = v0[e], x2 = v1[e]; v0[e] = x1 * c - x2 * s; v1[e] = x2 * c + x1 * s; }
                }
                if (dosilu) {
#pragma unroll
                    for (int e = 0; e < 4; ++e) { v0[e] = siluf_(v0[e]); v1[e] = siluf_(v1[e]); }
                }
                u32x4 w; w.x = cvt_pk_bf16(v0[0], v0[1]); w.y = cvt_pk_bf16(v0[2], v0[3]); w.z = cvt_pk_bf16(v1[0], v1[1]); w.w = cvt_pk_bf16(v1[2], v1[3]);
                *(GAS u32x4*)(dst + (size_t)row * pitch + lc0 + bj * 128) = w;
            }
            cr0 = nr0; cr1 = nr1;
        }
    }
};
struct EpiGate {
    static constexpr bool PERM = true, AFTER_DRAIN = false;
    bf16* G; const float* rstd;
    __device__ __forceinline__ bool keep(const pg8::Unit&) const { return false; }
    __device__ __forceinline__ void operator()(f32x4 (&acc)[2][2][4][2], const pg8::Unit& u, int wr, int wc, int fr, int fq) const {
        const int col0 = u.pn * 256 + wc * 32 + 8 * fq, row0 = u.pm * 256 + wr * 64 + fr;
        float rsv[8];
#pragma unroll
        for (int it = 0; it < 8; ++it) rsv[it] = ((const GAS float*)rstd)[row0 + (it >> 2) * 128 + (it & 3) * 16] * -1.4426950408889634f;
        EPI_FENCE();
#pragma unroll
        for (int it = 0; it < 8; ++it) {
            const int ai = it >> 2, m = it & 3, row = row0 + ai * 128 + m * 16;
            const float rs = rsv[it];
#pragma unroll
            for (int bj = 0; bj < 2; ++bj) {
                f32x4 v0 = acc[ai][bj][m][0] * rs, v1 = acc[ai][bj][m][1] * rs;
#pragma unroll
                for (int e = 0; e < 4; ++e) { v0[e] = fmaxf(__builtin_amdgcn_rcpf(1.0f + __builtin_amdgcn_exp2f(v0[e])), 1e-30f); v1[e] = fmaxf(__builtin_amdgcn_rcpf(1.0f + __builtin_amdgcn_exp2f(v1[e])), 1e-30f); }
                u32x4 w; w.x = cvt_pk_bf16(v0[0], v0[1]); w.y = cvt_pk_bf16(v0[2], v0[3]); w.z = cvt_pk_bf16(v1[0], v1[1]); w.w = cvt_pk_bf16(v1[2], v1[3]);
                *(GAS u32x4*)(G + (size_t)row * NGATE + col0 + bj * 128) = w;
            }
        }
    }
};
struct EpiChain {
    static constexpr bool PERM = true, AFTER_DRAIN = false;
    const bf16* G; bf16* out;
    __device__ __forceinline__ bool keep(const pg8::Unit& u) const { return u.seg != 2; }
    __device__ __forceinline__ void operator()(f32x4 (&acc)[2][2][4][2], const pg8::Unit& u, int wr, int wc, int fr, int fq) const {
        const int col0 = u.pn * 256 + wc * 32 + 8 * fq, row0 = u.pm * 256 + wr * 64 + fr;
        const int seg = u.seg;
        const bf16* gbase = G + seg * DM + col0;
        u32x4 ga[2], gb[2];
#pragma unroll
        for (int bj = 0; bj < 2; ++bj) { const bf16* gp = gbase + (size_t)row0 * NGATE + bj * 128; ga[bj] = *(const GAS u32x4*)gp; gb[bj] = ga[bj]; if (seg != 2) gb[bj] = *(const GAS u32x4*)(gp + DM); }
#pragma unroll
        for (int it = 0; it < 8; ++it) {
            const int ai = it >> 2, m = it & 3, row = row0 + ai * 128 + m * 16;
            u32x4 na[2] = {ga[0], ga[1]}, nb[2] = {gb[0], gb[1]};
            if (it < 7) { const int rn = row0 + ((it + 1) >> 2) * 128 + ((it + 1) & 3) * 16;
#pragma unroll
                for (int bj = 0; bj < 2; ++bj) { const bf16* gp = gbase + (size_t)rn * NGATE + bj * 128; na[bj] = *(const GAS u32x4*)gp; nb[bj] = na[bj]; if (seg != 2) nb[bj] = *(const GAS u32x4*)(gp + DM); } }
            EPI_FENCE();
#pragma unroll
            for (int bj = 0; bj < 2; ++bj) {
                float f[8]; unpack8(ga[bj], f);
                if (seg != 2) {
                    float h[8]; unpack8(gb[bj], h);
#pragma unroll
                    for (int e = 0; e < 8; ++e) f[e] = f[e] * __builtin_amdgcn_rcpf(h[e]);
                }
                f32x4 v0 = acc[ai][bj][m][0], v1 = acc[ai][bj][m][1];
#pragma unroll
                for (int e = 0; e < 4; ++e) { v0[e] *= f[e]; v1[e] *= f[4 + e]; }
                if (seg != 2) { acc[ai][bj][m][0] = v0; acc[ai][bj][m][1] = v1; }
                else {
                    u32x4 w; w.x = cvt_pk_bf16(v0[0], v0[1]); w.y = cvt_pk_bf16(v0[2], v0[3]); w.z = cvt_pk_bf16(v1[0], v1[1]); w.w = cvt_pk_bf16(v1[2], v1[3]);
                    *(GAS u32x4*)(out + (size_t)row * DM + col0 + bj * 128) = w;
                }
            }
            ga[0] = na[0]; ga[1] = na[1]; gb[0] = nb[0]; gb[1] = nb[1];
        }
    }
};
struct ChainOrder {
    pg8::StaticOrder S;
    __device__ bool next(int i, pg8::Unit& u) const { if (!S.next(i / 3, u)) return false; u.seg = i % 3; return true; }
    __device__ __forceinline__ void a_ready(const pg8::Unit&) const {}
    __device__ __forceinline__ void done(const pg8::Unit&) const {}
};
struct EpiOut {
    static constexpr bool PERM = true, AFTER_DRAIN = false;
    const float* xres; float* xout; bf16* xb; float* ssq;
    __device__ __forceinline__ bool keep(const pg8::Unit&) const { return false; }
    __device__ __forceinline__ void operator()(f32x4 (&acc)[2][2][4][2], const pg8::Unit& u, int wr, int wc, int fr, int fq) const {
        const int col0 = u.pn * 256 + wc * 32 + 8 * fq, row0 = u.pm * 256 + wr * 64 + fr;
        f32x4 r[4];
#pragma unroll
        for (int bj = 0; bj < 2; ++bj) { const float* p = xres + (size_t)row0 * DM + col0 + bj * 128; r[2 * bj] = *(const GAS f32x4*)p; r[2 * bj + 1] = *(const GAS f32x4*)(p + 4); }
#pragma unroll
        for (int it = 0; it < 8; ++it) {
            const int ai = it >> 2, m = it & 3, row = row0 + ai * 128 + m * 16;
            f32x4 nr[4] = {r[0], r[1], r[2], r[3]};
            if (it < 7) { const int rn = row0 + ((it + 1) >> 2) * 128 + ((it + 1) & 3) * 16;
#pragma unroll
                for (int bj = 0; bj < 2; ++bj) { const float* p = xres + (size_t)rn * DM + col0 + bj * 128; nr[2 * bj] = *(const GAS f32x4*)p; nr[2 * bj + 1] = *(const GAS f32x4*)(p + 4); } }
            EPI_FENCE();
            float q = 0.f;
#pragma unroll
            for (int bj = 0; bj < 2; ++bj) {
                const size_t o = (size_t)row * DM + col0 + bj * 128;
                const f32x4 v0 = acc[ai][bj][m][0] + r[2 * bj], v1 = acc[ai][bj][m][1] + r[2 * bj + 1];
                *(GAS f32x4*)(xout + o) = v0; *(GAS f32x4*)(xout + o + 4) = v1;
                q += ((v0[0] * v0[0] + v0[1] * v0[1]) + (v0[2] * v0[2] + v0[3] * v0[3])) + ((v1[0] * v1[0] + v1[1] * v1[1]) + (v1[2] * v1[2] + v1[3] * v1[3]));
                if (xb) { u32x4 w; w.x = cvt_pk_bf16(v0[0], v0[1]); w.y = cvt_pk_bf16(v0[2], v0[3]); w.z = cvt_pk_bf16(v1[0], v1[1]); w.w = cvt_pk_bf16(v1[2], v1[3]);
                    *(GAS u32x4*)(xb + o) = w; }
            }
            q += __shfl_xor(q, 16); q += __shfl_xor(q, 32);
            if (fq == 0) ((GAS float*)ssq)[(size_t)row * 16 + u.pn * 4 + wc] = q;
            r[0] = nr[0]; r[1] = nr[1]; r[2] = nr[2]; r[3] = nr[3];
        }
    }
};

template <bool PERMUTE>
__device__ __forceinline__ void p0_transpose_item(const float* W, int K, int N, bf16* WT, const float* gk, LAS float* scr, int item, int lane) {
    const int nblk = N / 32, kb = item / nblk, nb = item % nblk, k0 = 64 * kb, n0 = 32 * nb;
    const int kr = lane >> 3, c4 = lane & 7;
    const int nsrc = PERMUTE ? orig_col(n0 + 4 * c4) : (n0 + 4 * c4);
    f32x4 wv[8];
#pragma unroll
    for (int i = 0; i < 8; ++i) wv[i] = *(const GAS f32x4*)(W + (size_t)(k0 + 8 * i + kr) * N + nsrc);
#pragma unroll
    for (int i = 0; i < 8; ++i) { const int kk = 8 * i + kr; f32x4 v = wv[i]; if (gk) v = v * gk[k0 + kk];
        LAS float* d = scr + kk * 33 + 4 * c4; d[0] = v[0]; d[1] = v[1]; d[2] = v[2]; d[3] = v[3]; }
    asm volatile("s_waitcnt lgkmcnt(0)" ::: "memory");
    const int c = lane & 7;
#pragma unroll
    for (int j = 0; j < 4; ++j) { const int n = (lane >> 3) + 8 * j; const LAS float* s = scr + (8 * c) * 33 + n;
        u32x4 o; o.x = cvt_pk_bf16(s[0 * 33], s[1 * 33]); o.y = cvt_pk_bf16(s[2 * 33], s[3 * 33]); o.z = cvt_pk_bf16(s[4 * 33], s[5 * 33]); o.w = cvt_pk_bf16(s[6 * 33], s[7 * 33]);
        *(GAS u32x4*)(WT + (size_t)(n0 + n) * K + k0 + 8 * c) = o; }
    asm volatile("s_waitcnt lgkmcnt(0)" ::: "memory");
}

struct Args { const float* in[9]; float* out; unsigned char* ws; int ph_lo, ph_hi; };

__device__ __forceinline__ void phase_prologue(const Args& a, LAS unsigned char* lds, int vcu, int G, int wave, int lane) {
    unsigned char* ws = a.ws;
    LAS float* scr = (LAS float*)(lds + wave * 16384);
    const int gw = vcu * NWAVES + wave, NGW = G * NWAVES;
    constexpr int I_IN = (DM / 64) * (NIN / 32), I_BR = (512 / 64) * (DM / 32), I_OUT = (DM / 64) * (DM / 32), I_L = I_IN + 3 * I_BR + I_OUT;
    for (int it = gw; it < DEPTH * I_L; it += NGW) {
        const int l = it / I_L; int r = it % I_L;
        if (r < I_IN) { p0_transpose_item<true>(a.in[2] + (size_t)l * DM * NIN, DM, NIN, (bf16*)(ws + WS_WIN + l * WIN_L), a.in[1] + l * DM, scr, r, lane); continue; } r -= I_IN;
        if (r < 3 * I_BR) { const int i = r / I_BR; p0_transpose_item<false>(a.in[6] + ((size_t)l * 3 + i) * 512 * DM, 512, DM, (bf16*)(ws + WS_WBR + l * WBR_L) + (size_t)i * DM * 512, nullptr, scr, r % I_BR, lane); continue; } r -= 3 * I_BR;
        p0_transpose_item<false>(a.in[7] + (size_t)l * DM * DM, DM, DM, (bf16*)(ws + WS_WOUT + l * WOUT_L), nullptr, scr, r, lane);
    }
    const float* x = a.in[0]; bf16* xb = (bf16*)(ws + WS_XB); float* ssq = (float*)(ws + WS_SSQ);
    for (int m0 = gw * 4; m0 < T; m0 += NGW * 4) {
        f32x4 v[4][4];
#pragma unroll
        for (int r = 0; r < 4; ++r) { const GAS f32x4* xr = (const GAS f32x4*)(x + (size_t)(m0 + r) * DM) + lane;
#pragma unroll
            for (int j = 0; j < 4; ++j) v[r][j] = xr[64 * j]; }
#pragma unroll
        for (int r = 0; r < 4; ++r) {
            float s = 0.f;
#pragma unroll
            for (int j = 0; j < 4; ++j) s += (v[r][j][0] * v[r][j][0] + v[r][j][1] * v[r][j][1]) + (v[r][j][2] * v[r][j][2] + v[r][j][3] * v[r][j][3]);
            s = wave_sum(s);
            GAS u32x2* o8 = (GAS u32x2*)(xb + (size_t)(m0 + r) * DM) + lane;
#pragma unroll
            for (int j = 0; j < 4; ++j) { u32x2 w; w.x = cvt_pk_bf16(v[r][j][0], v[r][j][1]); w.y = cvt_pk_bf16(v[r][j][2], v[r][j][3]); o8[64 * j] = w; }
            if (lane == 0) ((GAS float*)(ws + WS_RSTD))[m0 + r] = __builtin_amdgcn_rsqf(s * (1.0f / DM) + EPS);
        }
    }
    float2* ropeA = (float2*)(ws + WS_ROPEA); float2* ropeR = (float2*)(ws + WS_ROPER);
    const int gt = gw * 64 + lane, NT_ = NGW * 64;
    for (int i = gt; i < SEQ * 40; i += NT_) {
        float inv; float2* dst;
        if (i < SEQ * 8) { inv = INV_A[i & 7]; dst = ropeA + i; } else { const int k = i - SEQ * 8; inv = INV_R[k & 31]; dst = ropeR + k; }
        const int pos = (i < SEQ * 8) ? (i >> 3) : ((i - SEQ * 8) >> 5);
        const float ang = (float)pos * inv;
        double rev = (double)ang * 0.15915494309189533577; rev -= __builtin_rint(rev);
        const float rf = (float)rev;
        { typedef float f32x2v __attribute__((ext_vector_type(2))); *(GAS f32x2v*)dst = (f32x2v){__builtin_amdgcn_cosf(rf), __builtin_amdgcn_sinf(rf)}; }
    }
}

__device__ __forceinline__ void conv_item(unsigned char* ws, const float* cw, int item, int tid) {
    const bf16* U = (const bf16*)(ws + WS_CX); bf16* GB = (bf16*)(ws + WS_CB);
    const int ch = (tid & 63) * 8, t0 = item * 64 + (tid >> 6) * 8;
    float w0[8], w1[8], w2[8];
#pragma unroll
    for (int e = 0; e < 8; ++e) { w0[e] = cw[ch + e]; w1[e] = cw[512 + ch + e]; w2[e] = cw[1024 + ch + e]; }
    float um2[8], um1[8];
#pragma unroll
    for (int e = 0; e < 8; ++e) { um2[e] = 0.f; um1[e] = 0.f; }
    if ((t0 & (SEQ - 1)) >= 2) { unpack8(*(const GAS u32x4*)(U + (size_t)(t0 - 2) * 512 + ch), um2); unpack8(*(const GAS u32x4*)(U + (size_t)(t0 - 1) * 512 + ch), um1); }
    u32x4 ua[8], ga[8];
#pragma unroll
    for (int i = 0; i < 8; ++i) { const size_t o = (size_t)(t0 + i) * 512 + ch; ua[i] = *(const GAS u32x4*)(U + o); ga[i] = *(const GAS u32x4*)(GB + o); }
#pragma unroll
    for (int i = 0; i < 8; ++i) {
        float u[8], gb[8], y[8]; unpack8(ua[i], u); unpack8(ga[i], gb);
#pragma unroll
        for (int e = 0; e < 8; ++e) { y[e] = gb[e] * (w0[e] * um2[e] + w1[e] * um1[e] + w2[e] * u[e]); um2[e] = um1[e]; um1[e] = u[e]; }
        u32x4 w; w.x = cvt_pk_bf16(y[0], y[1]); w.y = cvt_pk_bf16(y[2], y[3]); w.z = cvt_pk_bf16(y[4], y[5]); w.w = cvt_pk_bf16(y[6], y[7]);
        *(GAS u32x4*)(GB + (size_t)(t0 + i) * 512 + ch) = w;
    }
}

constexpr int R_SQ = 0, R_SK = 18432, R_SVT = 36864, R_SPT = 71680, R_SP = 90112;
__device__ __forceinline__ bf16x8 lds_frag(LAS const unsigned char* p) { return *(LAS const bf16x8*)p; }

struct RetV { u32x4 v[4]; };
__device__ __forceinline__ void load_v(RetV& r, const bf16* Rv, int t0, int h, int tid) {
#pragma unroll
    for (int i = 0; i < 4; ++i) { const int id = tid + i * 512, m = id & 127, chn = id >> 7; r.v[i] = *(const GAS u32x4*)(Rv + (size_t)(t0 + m) * 512 + h * 128 + chn * 8); }
}
__device__ __forceinline__ void stage_vT(LAS unsigned char* lds, const RetV& r, int tid) {
#pragma unroll
    for (int i = 0; i < 4; ++i) {
        const int id = tid + i * 512, m = id & 127, chn = id >> 7; const u32x4 v = r.v[i];
        LAS bf16* d = (LAS bf16*)(lds + R_SVT) + (chn * 8) * 136 + m;
        d[0 * 136] = (bf16)(v.x & 0xffff); d[1 * 136] = (bf16)(v.x >> 16); d[2 * 136] = (bf16)(v.y & 0xffff); d[3 * 136] = (bf16)(v.y >> 16);
        d[4 * 136] = (bf16)(v.z & 0xffff); d[5 * 136] = (bf16)(v.z >> 16); d[6 * 136] = (bf16)(v.w & 0xffff); d[7 * 136] = (bf16)(v.w >> 16);
    }
}
struct RetK { u32x4 k[2]; };
__device__ __forceinline__ void retkv_load(unsigned char* ws, int item, int tid, RetV& rv, RetK& rk) {
    const int bh = item >> 6, n = item & 63, b = bh >> 2, h = bh & 3, t0 = b * SEQ + n * 128;
    load_v(rv, (const bf16*)(ws + WS_RV), t0, h, tid);
    const bf16* Rk = (const bf16*)(ws + WS_RK);
#pragma unroll
    for (int i = 0; i < 2; ++i) { const int id = tid + i * 512, m = id & 127, chn = id >> 7; rk.k[i] = *(const GAS u32x4*)(Rk + (size_t)(t0 + m) * 256 + h * 64 + chn * 8); }
}
__device__ __forceinline__ void retkv_items(unsigned char* ws, LAS unsigned char* lds, int first, int stride, int tid, int wave, int lane) {
    RetV rv; RetK rk;
    if (first < 1024) retkv_load(ws, first, tid, rv, rk);
    for (int item = first; item < 1024; item += stride) {
        const int h = (item >> 6) & 3;
        float* KV = (float*)(ws + WS_KV) + (size_t)item * 8192;
        const float lg = LG2[h];
        stage_vT(lds, rv, tid);
#pragma unroll
        for (int i = 0; i < 2; ++i) {
            const int id = tid + i * 512, m = id & 127, chn = id >> 7; const u32x4 v = rk.k[i];
            const float z = exp2f((float)(127 - m) * lg);
            LAS bf16* d = (LAS bf16*)(lds + R_SQ) + (chn * 8) * 136 + m;
            const unsigned p0 = cvt_pk_bf16(bflo(v.x) * z, bfhi(v.x) * z), p1 = cvt_pk_bf16(bflo(v.y) * z, bfhi(v.y) * z), p2 = cvt_pk_bf16(bflo(v.z) * z, bfhi(v.z) * z), p3 = cvt_pk_bf16(bflo(v.w) * z, bfhi(v.w) * z);
            d[0 * 136] = (bf16)(p0 & 0xffff); d[1 * 136] = (bf16)(p0 >> 16); d[2 * 136] = (bf16)(p1 & 0xffff); d[3 * 136] = (bf16)(p1 >> 16);
            d[4 * 136] = (bf16)(p2 & 0xffff); d[5 * 136] = (bf16)(p2 >> 16); d[6 * 136] = (bf16)(p3 & 0xffff); d[7 * 136] = (bf16)(p3 >> 16);
        }
        if (item + stride < 1024) retkv_load(ws, item + stride, tid, rv, rk);
        __syncthreads();
        const int dt = wave & 3, eg = wave >> 2, lr = lane & 15, lq = lane >> 4;
        f32x4 acc[4];
#pragma unroll
        for (int j = 0; j < 4; ++j) acc[j] = (f32x4){0.f, 0.f, 0.f, 0.f};
#pragma unroll
        for (int kk = 0; kk < 4; ++kk) {
            const bf16x8 af = lds_frag(lds + R_SQ + ((dt * 16 + lr) * 136 + kk * 32 + 8 * lq) * 2);
#pragma unroll
            for (int j = 0; j < 4; ++j) {
                const bf16x8 bfr = lds_frag(lds + R_SVT + (((eg * 4 + j) * 16 + lr) * 136 + kk * 32 + 8 * lq) * 2);
                acc[j] = __builtin_amdgcn_mfma_f32_16x16x32_bf16(af, bfr, acc[j], 0, 0, 0);
            }
        }
#pragma unroll
        for (int j = 0; j < 4; ++j) *(GAS f32x4*)(KV + (size_t)((eg * 4 + j) * 16 + lr) * 64 + dt * 16 + lq * 4) = acc[j];
        __syncthreads();
    }
}
__device__ __forceinline__ void scan_phase(unsigned char* ws, int vcu, int G, int tid, size_t dst_off = WS_PREVT) {
    const float* KV = (const float*)(ws + WS_KV); bf16* DST = (bf16*)(ws + dst_off);
    for (int gid = vcu * 512 + tid; gid < 16 * 8192; gid += G * 512) {
        const int bh = gid >> 13, rem = gid & 8191, h = bh & 3;
        const float decay = exp2f(128.0f * LG2[h]);
        const GAS float* p = (const GAS float*)(KV + ((size_t)bh * 64) * 8192 + rem); GAS bf16* pd = (GAS bf16*)(DST + ((size_t)bh * 64) * 8192 + rem);
        float st = 0.f;
#pragma unroll
        for (int n0 = 0; n0 < 64; n0 += 16) {
            float kv[16];
#pragma unroll
            for (int j = 0; j < 16; ++j) kv[j] = p[(size_t)(n0 + j) * 8192];
#pragma unroll
            for (int j = 0; j < 16; ++j) { pd[(size_t)(n0 + j) * 8192] = (bf16)(cvt_pk_bf16(st, 0.f) & 0xffff); st = decay * st + kv[j]; }
        }
    }
}
struct RetQKP { u32x4 q[2], k[2]; };
__device__ __forceinline__ void retout_load(unsigned char* ws, int item, int tid, RetV& rv) {
    const int bh = item >> 6, n = item & 63, b = bh >> 2, h = bh & 3, t0 = b * SEQ + n * 128;
    load_v(rv, (const bf16*)(ws + WS_RV), t0, h, tid);
}
__device__ __forceinline__ void retout_load_qk(unsigned char* ws, int item, int tid, RetQKP& r) {
    const int bh = item >> 6, n = item & 63, b = bh >> 2, h = bh & 3, t0 = b * SEQ + n * 128;
    const bf16* Rq = (const bf16*)(ws + WS_RQ); const bf16* Rk = (const bf16*)(ws + WS_RK);
#pragma unroll
    for (int i = 0; i < 2; ++i) {
        const int id = tid + i * 512, row = id >> 3, chn = id & 7;
        r.q[i] = *(const GAS u32x4*)(Rq + (size_t)(t0 + row) * 256 + h * 64 + chn * 8);
        r.k[i] = *(const GAS u32x4*)(Rk + (size_t)(t0 + row) * 256 + h * 64 + chn * 8);
    }
}
__device__ __forceinline__ void retout_item(unsigned char* ws, LAS unsigned char* lds, int item, int next_item, RetV& rv, int tid, int wave, int lane, size_t dst_off = WS_SRZ) {
    const int bh = item >> 6, n = item & 63, b = bh >> 2, h = bh & 3, t0 = b * SEQ + n * 128;
    const bf16* Z = (const bf16*)(ws + WS_SRZ); bf16* R = (bf16*)(ws + dst_off); const bf16* PT = (const bf16*)(ws + WS_PREVT) + (size_t)item * 8192;
    const float lg = LG2[h];
    retout_load(ws, item, tid, rv);
    RetQKP rq; retout_load_qk(ws, item, tid, rq);
    u32x4 pt[2];
#pragma unroll
    for (int i = 0; i < 2; ++i) pt[i] = *(const GAS u32x4*)(PT + (size_t)(tid + i * 512) * 8);
    stage_vT(lds, rv, tid);
#pragma unroll
    for (int i = 0; i < 2; ++i) {
        const int id = tid + i * 512, row = id >> 3, chn = id & 7;
        *(LAS u32x4*)(lds + R_SQ + row * 144 + chn * 16) = rq.q[i];
        *(LAS u32x4*)(lds + R_SK + row * 144 + chn * 16) = rq.k[i];
    }
#pragma unroll
    for (int i = 0; i < 2; ++i) { const int id = tid + i * 512, e = id >> 3, chn = id & 7; *(LAS u32x4*)(lds + R_SPT + e * 144 + chn * 16) = pt[i]; }
    __syncthreads();
    const int lr = lane & 15, lq = lane >> 4, c0 = wave * 16;
    bf16x8 aq[2];
#pragma unroll
    for (int kk = 0; kk < 2; ++kk) aq[kk] = lds_frag(lds + R_SQ + ((c0 + lr) * 72 + kk * 32 + 8 * lq) * 2);
#pragma unroll
    for (int mt = 0; mt < 8; ++mt) {
        f32x4 s = (f32x4){0.f, 0.f, 0.f, 0.f};
#pragma unroll
        for (int kk = 0; kk < 2; ++kk) {
            const bf16x8 bk = lds_frag(lds + R_SK + ((mt * 16 + lr) * 72 + kk * 32 + 8 * lq) * 2);
            s = __builtin_amdgcn_mfma_f32_16x16x32_bf16(aq[kk], bk, s, 0, 0, 0);
        }
        const int mm = mt * 16 + lr;
#pragma unroll
        for (int i = 0; i < 4; ++i) {
            const int c = c0 + lq * 4 + i, df = c - mm;
            const float pv = (df >= 0) ? s[i] * exp2f((float)df * lg) : 0.f;
            ((LAS bf16*)(lds + R_SP))[c * 136 + mm] = (bf16)(cvt_pk_bf16(pv, 0.f) & 0xffff);
        }
    }
    f32x4 acc[8];
#pragma unroll
    for (int et = 0; et < 8; ++et) {
        acc[et] = (f32x4){0.f, 0.f, 0.f, 0.f};
#pragma unroll
        for (int kk = 0; kk < 2; ++kk) {
            const bf16x8 bp = lds_frag(lds + R_SPT + ((et * 16 + lr) * 72 + kk * 32 + 8 * lq) * 2);
            acc[et] = __builtin_amdgcn_mfma_f32_16x16x32_bf16(aq[kk], bp, acc[et], 0, 0, 0);
        }
    }
    float xi[4];
#pragma unroll
    for (int i = 0; i < 4; ++i) xi[i] = exp2f((float)(lq * 4 + i + 1 + (c0 & 127)) * lg);
#pragma unroll
    for (int et = 0; et < 8; ++et)
#pragma unroll
        for (int i = 0; i < 4; ++i) acc[et][i] *= xi[i];
    asm volatile("s_waitcnt lgkmcnt(0)" ::: "memory");
#pragma unroll
    for (int kk = 0; kk < 4; ++kk) {
        const bf16x8 ap = lds_frag(lds + R_SP + ((c0 + lr) * 136 + kk * 32 + 8 * lq) * 2);
#pragma unroll
        for (int et = 0; et < 8; ++et) {
            const bf16x8 bv = lds_frag(lds + R_SVT + ((et * 16 + lr) * 136 + kk * 32 + 8 * lq) * 2);
            acc[et] = __builtin_amdgcn_mfma_f32_16x16x32_bf16(ap, bv, acc[et], 0, 0, 0);
        }
    }
    asm volatile("s_waitcnt lgkmcnt(0)" ::: "memory");
#pragma unroll
    for (int i = 0; i < 4; ++i) {
        float q = 0.f;
#pragma unroll
        for (int et = 0; et < 8; ++et) q += acc[et][i] * acc[et][i];
        q += __shfl_xor(q, 1); q += __shfl_xor(q, 2); q += __shfl_xor(q, 4); q += __shfl_xor(q, 8);
        const float rs = __builtin_amdgcn_rsqf(q * (1.0f / 128.0f) + EPS);
        LAS bf16* sp = (LAS bf16*)(lds + R_SP) + (c0 + lq * 4 + i) * 136 + lr;
#pragma unroll
        for (int et = 0; et < 8; ++et) sp[et * 16] = (bf16)(cvt_pk_bf16(acc[et][i] * rs, 0.f) & 0xffff);
    }
    asm volatile("s_waitcnt lgkmcnt(0)" ::: "memory");
#pragma unroll
    for (int i = 0; i < 4; ++i) {
        const int r = i * 4 + lq;
        const u32x4 o = *(LAS const u32x4*)(lds + R_SP + ((c0 + r) * 136 + 8 * lr) * 2);
        GAS u32x4* rp = (GAS u32x4*)(R + (size_t)(t0 + c0 + r) * 512 + h * 128 + 8 * lr);
        const u32x4 z = *(const GAS u32x4*)(Z + (size_t)(t0 + c0 + r) * 512 + h * 128 + 8 * lr);
        u32x4 w;
        w.x = cvt_pk_bf16(bflo(o.x) * bflo(z.x), bfhi(o.x) * bfhi(z.x)); w.y = cvt_pk_bf16(bflo(o.y) * bflo(z.y), bfhi(o.y) * bfhi(z.y));
        w.z = cvt_pk_bf16(bflo(o.z) * bflo(z.z), bfhi(o.z) * bfhi(z.z)); w.w = cvt_pk_bf16(bflo(o.w) * bflo(z.w), bfhi(o.w) * bfhi(z.w));
        *rp = w;
    }
    __syncthreads();
}

__device__ __forceinline__ void attn_post(unsigned char* ws, int b, int h, int qi, const bf16* otmp, int l, const float* lp, const float* subg, size_t dst_off = WS_SZA) {
    int tid_ = threadIdx.x; asm volatile("" : "+v"(tid_));
    const int lane = tid_ & 63, wave = __builtin_amdgcn_readfirstlane(tid_ >> 6);
    const float e1 = wave_sum(lp[lane] * lp[64 + lane]), e2 = wave_sum(lp[128 + lane] * lp[192 + lane]);
    const float lam_init = 0.8f - 0.6f * expf(-0.3f * (float)l);
    const float lam = expf(e1) - expf(e2) + lam_init, oml = 1.0f - lam_init;
    asm volatile("s_waitcnt vmcnt(0)" ::: "memory");
    __syncthreads();
    __builtin_amdgcn_fence(__ATOMIC_ACQUIRE, "agent");
    bf16* A = (bf16*)(ws + dst_off); const bf16* ZA = (const bf16*)(ws + WS_SZA);
    const int lr = lane & 15, lq = lane >> 4;
    float gg[8];
#pragma unroll
    for (int e = 0; e < 8; ++e) gg[e] = subg[8 * lr + e] * oml;
#pragma unroll 4
    for (int it = 0; it < 8; ++it) {
        const int row = wave * 32 + it * 4 + lq;
        const u32x4 o0 = *(const GAS u32x4*)(otmp + row * 256 + 8 * lr), o1 = *(const GAS u32x4*)(otmp + row * 256 + 128 + 8 * lr);
        GAS u32x4* ap = (GAS u32x4*)(A + (size_t)(b * SEQ + qi * 256 + row) * 512 + h * 128 + 8 * lr);
        const u32x4 z = *(const GAS u32x4*)(ZA + (size_t)(b * SEQ + qi * 256 + row) * 512 + h * 128 + 8 * lr);
        float d[8] = {bflo(o0.x) - lam * bflo(o1.x), bfhi(o0.x) - lam * bfhi(o1.x), bflo(o0.y) - lam * bflo(o1.y), bfhi(o0.y) - lam * bfhi(o1.y),
                      bflo(o0.z) - lam * bflo(o1.z), bfhi(o0.z) - lam * bfhi(o1.z), bflo(o0.w) - lam * bflo(o1.w), bfhi(o0.w) - lam * bfhi(o1.w)};
        float ss = ((d[0] * d[0] + d[1] * d[1]) + (d[2] * d[2] + d[3] * d[3])) + ((d[4] * d[4] + d[5] * d[5]) + (d[6] * d[6] + d[7] * d[7]));
        ss += __shfl_xor(ss, 1); ss += __shfl_xor(ss, 2); ss += __shfl_xor(ss, 4); ss += __shfl_xor(ss, 8);
        const float rs = __builtin_amdgcn_rsqf(ss * (1.0f / 128.0f) + EPS);
        const float zz[8] = {bflo(z.x), bfhi(z.x), bflo(z.y), bfhi(z.y), bflo(z.z), bfhi(z.z), bflo(z.w), bfhi(z.w)};
#pragma unroll
        for (int e = 0; e < 8; ++e) d[e] = d[e] * rs * gg[e] * zz[e];
        u32x4 w; w.x = cvt_pk_bf16(d[0], d[1]); w.y = cvt_pk_bf16(d[2], d[3]); w.z = cvt_pk_bf16(d[4], d[5]); w.w = cvt_pk_bf16(d[6], d[7]);
        *ap = w;
    }
    asm volatile("s_waitcnt vmcnt(0)" ::: "memory");
    __syncthreads();
}
__device__ __forceinline__ void attn_phase(unsigned char* ws, char* lds, int vcu, int G, int bx, int l, const float* lp, const float* subg) {
    const attn_body::bf16* Qa = (const attn_body::bf16*)(ws + WS_QA); const attn_body::bf16* Ka = (const attn_body::bf16*)(ws + WS_KA); const attn_body::bf16* Va = (const attn_body::bf16*)(ws + WS_VA);
    bf16* otmp = (bf16*)(ws + WS_OTMP) + (size_t)bx * 65536;
    for (int v = vcu; v < 256; v += G) {
        const int xg = v >> 5, j = v & 31;
        for (int u4 = 0; u4 < 4; ++u4) {
            const int bh = 2 * xg + (u4 >> 1), b = bh >> 2, h = bh & 3;
            const int qi = (u4 < 2) ? j : 31 - j, c = u4 & 1;
            for (int rp = 0; rp < REP_ATTN; ++rp) attn_body::attn_unit128<8, 512, 512, 512, 256>(qi * 256, Qa + (size_t)(b * SEQ + qi * 256) * 512 + (h * 2 + c) * 64, Ka + (size_t)(b * SEQ) * 512 + (h * 2 + c) * 64,
                                                        Va + (size_t)(b * SEQ) * 512 + h * 128, (attn_body::bf16*)otmp + c * 128, lds);
            if (c == 1) {
#ifdef PROBE_LIGHT
                attn_post(ws, b, h, qi, otmp, l, lp, subg, WS_SCZ);
#endif
                attn_post(ws, b, h, qi, otmp, l, lp, subg);
            }
        }
    }
}

#define GAS __attribute__((address_space(1)))
#define RLX_AGENT __ATOMIC_RELAXED, __HIP_MEMORY_SCOPE_AGENT
#define LDS_WAIT() asm volatile("s_waitcnt lgkmcnt(0)" ::: "memory")
#define VM_WAIT() asm volatile("s_waitcnt vmcnt(0)" ::: "memory")
__device__ __forceinline__ unsigned long long rt() { return __builtin_amdgcn_s_memrealtime(); }
#define XB_TMO      128
#define XB_XCNT(j)  (256  + 64 * (j))
#define XB_XSUB(j)  (1280 + 64 * (j))
#define XB_XGEN(j)  (2304 + 64 * (j))
#define XB_TOP      3328
#define XB_TOPGEN   3392
#define XCD_BAR_WORDS 3456
#define XB_SPIN_CAP (1u << 18)

__device__ __forceinline__ unsigned xb_ld(unsigned* p)              { return __hip_atomic_load(p, __ATOMIC_RELAXED, __HIP_MEMORY_SCOPE_AGENT); }
__device__ __forceinline__ unsigned xb_add(unsigned* p, unsigned v) { return __hip_atomic_fetch_add(p, v, __ATOMIC_RELAXED, __HIP_MEMORY_SCOPE_AGENT); }
__device__ __forceinline__ unsigned xb_xcc_id() { return (unsigned)__builtin_amdgcn_s_getreg((3 << 11) | 20) & 0xFu; }
#define XB_SPIN(cond, bar) do { unsigned _sp = 0; while (cond) { __builtin_amdgcn_s_sleep(1); \
    if ((++_sp & 255u) == 0u) { if (xb_ld(&(bar)[XB_TMO])) break; if (_sp > XB_SPIN_CAP) { atomicAdd(&(bar)[XB_TMO], 1u); break; } } } } while (0)

struct XcdBarrier {
    unsigned* bar; unsigned x;
    volatile LAS unsigned* st;
};

__device__ __forceinline__ XcdBarrier xcd_barrier_post(unsigned* bar, volatile LAS unsigned* st) {
    XcdBarrier b; b.bar = bar; b.x = xb_xcc_id(); b.st = st;
    if (threadIdx.x == 0) (void)xb_add(&bar[XB_XCNT(b.x)], 1u);
    return b;
}
__device__ __forceinline__ void xcd_barrier_complete(unsigned* bar, unsigned x, unsigned& nloc, unsigned& nx) {
    const unsigned G = gridDim.x * gridDim.y * gridDim.z;
    unsigned sum, cnt, mine, sp = 0u;
    for (;;) {
        sum = 0u; cnt = 0u; mine = 0u;
#pragma unroll
        for (unsigned j = 0; j < 16; ++j) { const unsigned c = xb_ld(&bar[XB_XCNT(j)]); sum += c; cnt += (c > 0u) ? 1u : 0u; mine = (j == x) ? c : mine; }
        if (sum == G) break;
        __builtin_amdgcn_s_sleep(1);
        if ((++sp & 255u) == 0u) { if (xb_ld(&bar[XB_TMO])) break; if (sp > XB_SPIN_CAP) { atomicAdd(&bar[XB_TMO], 1u); break; } }
    }
    nloc = mine > 0u ? mine : 1u; nx = cnt > 0u ? cnt : 1u;
}

__device__ __forceinline__ void xcd_barrier(const XcdBarrier& b) {
    asm volatile("s_waitcnt vmcnt(0)" ::: "memory");
    __syncthreads();
    if (threadIdx.x == 0) {
        unsigned* bar = b.bar;
        __builtin_amdgcn_s_waitcnt(0);
        unsigned nloc = b.st[0], nx = b.st[1];
        if (nloc == 0u) { xcd_barrier_complete(bar, b.x, nloc, nx); b.st[0] = nloc; b.st[1] = nx; }
        const unsigned old = xb_add(&bar[XB_XSUB(b.x)], 1u);
        const unsigned gen = old / nloc;
        if (old + 1u == (gen + 1u) * nloc) {
            __builtin_amdgcn_fence(__ATOMIC_RELEASE, "agent");
            asm volatile("s_waitcnt vmcnt(0)" ::: "memory");
            const unsigned og = xb_add(&bar[XB_TOP], 1u);
            const unsigned tg = og / nx;
            if (og + 1u == (tg + 1u) * nx) xb_add(&bar[XB_TOPGEN], 1u);
            else XB_SPIN(xb_ld(&bar[XB_TOPGEN]) == tg, bar);
            __builtin_amdgcn_fence(__ATOMIC_ACQUIRE, "agent");
            xb_add(&bar[XB_XGEN(b.x)], 1u);
            asm volatile("s_waitcnt vmcnt(0)" ::: "memory");
        } else {
            XB_SPIN(xb_ld(&bar[XB_XGEN(b.x)]) == gen, bar);
            __builtin_amdgcn_fence(__ATOMIC_ACQUIRE, "agent");
            asm volatile("s_waitcnt vmcnt(0)" ::: "memory");
        }
    }
    __syncthreads();
}

constexpr int PH_PER_LAYER = 6, N_PHASES = 1 + DEPTH * PH_PER_LAYER + 1;

__global__ void __launch_bounds__(NWAVES * 64, 2) trunk_fwd(Args args) {
    extern __shared__ __attribute__((aligned(16))) unsigned char lds_raw[];
    LAS unsigned char* lds = (LAS unsigned char*)lds_raw;
#define TIDS() int tid = threadIdx.x; asm volatile("" : "+v"(tid)); const int lane = tid & 63, wave = __builtin_amdgcn_readfirstlane(tid >> 6); (void)lane; (void)wave
#define WSO() unsigned char* ws = args.ws; asm volatile("" : "+s"(ws)); float* ssq = (float*)(ws + WS_SSQ); bf16* xb = (bf16*)(ws + WS_XB); (void)ssq; (void)xb
    const int G = gridDim.x, bx = blockIdx.x;
    const int vcu = (G % 8 == 0) ? (bx % 8) * (G / 8) + bx / 8 : bx;
    const int lo = args.ph_lo, hi = args.ph_hi;
#if MK_MULTI
#define SEAM() do {} while (0)
#else
    cg::grid_group grid = cg::this_grid();
    volatile LAS unsigned* bst = (volatile LAS unsigned*)(lds + LDS_BYTES - 16);
    if (threadIdx.x < 2) bst[threadIdx.x] = 0u;
    __syncthreads();
    XcdBarrier bar = xcd_barrier_post((unsigned*)args.ws, bst);
#define SEAM() xcd_barrier(bar)
#endif
#ifndef PHASE_MASK
#define PHASE_MASK 0x1ff
#endif
#define PH_ON(t) ((PHASE_MASK >> (t)) & 1)
#define IN(k) (lo <= (k) && (k) < hi)
#define BOTH(k) (IN(k) && IN((k) + 1))

    if (PH_ON(0) && IN(0)) { TIDS();
#if defined(PROBE_LIGHT) || defined(PROBE_PRO)
        phase_prologue(args, lds, vcu, G, wave, lane);
#endif
        phase_prologue(args, lds, vcu, G, wave, lane); if (BOTH(0)) {
#if MK_MULTI
        SEAM();
#else
        grid.sync();
#endif
    } }

    for (int l = 0; l < DEPTH; ++l) {
        const int p0 = 1 + l * PH_PER_LAYER;
        if (PH_ON(1) && IN(p0)) {
            WSO(); const bf16* Win = (const bf16*)(ws + WS_WIN + l * WIN_L);
            pg8::Gemm g{xb, xb, xb, Win, 0, T, NPROJ, DM}; pg8::StaticOrder S; S.init(T, NPROJ, G, bx);
            float* rstd = (float*)(ws + WS_RSTD) + (size_t)l * T;
            if (l > 0) {
                TIDS(); int lastpm = -1; pg8::Unit uu;
                for (int i = 0; S.next(i, uu); ++i) if (uu.pm != lastpm) { lastpm = uu.pm;
                    const int row = uu.pm * 256 + (tid >> 1); const GAS f32x4* sp = (const GAS f32x4*)(ssq + (size_t)row * 16 + (tid & 1) * 8);
                    const f32x4 a0 = sp[0], a1 = sp[1]; float s = ((a0[0] + a0[1]) + (a0[2] + a0[3])) + ((a1[0] + a1[1]) + (a1[2] + a1[3])); s += __shfl_xor(s, 1);
                    if ((tid & 1) == 0) ((GAS float*)rstd)[row] = __builtin_amdgcn_rsqf(s * (1.0f / DM) + EPS); }
                asm volatile("s_waitcnt vmcnt(0)" ::: "memory"); __syncthreads();
            }
            EpiProj E{ws, rstd, (const float2*)(ws + WS_ROPEA), (const float2*)(ws + WS_ROPER)};
            for (int rp = 0; rp < REP_GEMM; ++rp) pg8::gemm_phase<EpiProj, pg8::StaticOrder, true, true>(lds, g, S, E);
            if (BOTH(p0)) SEAM();
        }
        if (PH_ON(2) && IN(p0 + 1)) {
            WSO();
            TIDS();
            for (int rp = 0; rp < REP_LIGHT; ++rp) retkv_items(ws, lds, vcu, G, tid, wave, lane);
            for (int it = vcu; it < T / 64; it += G) conv_item(ws, args.in[5] + (size_t)l * 3 * 512, it, tid);
            if (BOTH(p0 + 1)) SEAM();
        }
        if (PH_ON(4) && IN(p0 + 2)) {
            WSO();
            { TIDS();
#ifdef PROBE_LIGHT
              scan_phase(ws, vcu, G, tid, WS_SCZ);
#endif
              scan_phase(ws, vcu, G, tid); }
            attn_phase(ws, (char*)lds_raw, vcu, G, bx, l, args.in[3] + (size_t)l * 4 * 64, args.in[4] + l * 128);
            if (BOTH(p0 + 2)) SEAM();
        }
        if (PH_ON(5) && IN(p0 + 3)) {
            WSO();
            const bf16* Win = (const bf16*)(ws + WS_WIN + l * WIN_L);
            pg8::Gemm g{xb, xb, xb, Win + (size_t)NPROJ * DM, 0, T, NGATE, DM}; pg8::StaticOrder S; S.init(T, NGATE, G, bx);
            EpiGate E{(bf16*)(ws + WS_G), (const float*)(ws + WS_RSTD) + (size_t)l * T};
            const int nb = bx & 3;
            for (int st = 0; st < 3; ++st) {
                if (st == 1) { for (int rp = 0; rp < REP_GEMM; ++rp) pg8::gemm_phase<EpiGate, pg8::StaticOrder, true, true>(lds, g, S, E); }
                else { TIDS(); RetV rv;
                    const int k0 = (st == 0) ? 0 : nb, k1 = (st == 0) ? nb : 4;
                    for (int k = k0; k < k1; ++k) { const int it = vcu + k * G; if (it < 1024) retout_item(ws, lds, it, it + G, rv, tid, wave, lane); }
                }
            }
            if (BOTH(p0 + 3)) SEAM();
        }
        if (PH_ON(6) && IN(p0 + 4)) {
            WSO();
            pg8::Gemm g{(const bf16*)(ws + WS_SZA), (const bf16*)(ws + WS_CB), (const bf16*)(ws + WS_SRZ), (const bf16*)(ws + WS_WBR + l * WBR_L), (size_t)DM * 512 * 2, T, DM, 512};
            ChainOrder S; S.S.init(T, DM, G, bx);
            EpiChain E{(const bf16*)(ws + WS_G), (bf16*)(ws + WS_MERGED)};
            for (int rp = 0; rp < REP_GEMM; ++rp) pg8::gemm_phase<EpiChain, ChainOrder, true, true>(lds, g, S, E);
            if (BOTH(p0 + 4)) SEAM();
        }
        if (PH_ON(7) && IN(p0 + 5)) {
            WSO();
            const bf16* mg = (const bf16*)(ws + WS_MERGED);
            pg8::Gemm g{mg, mg, mg, (const bf16*)(ws + WS_WOUT + l * WOUT_L), 0, T, DM, DM}; pg8::StaticOrder S; S.init(T, DM, G, bx);
            EpiOut E{l == 0 ? args.in[0] : args.out, args.out, (l + 1 < DEPTH) ? xb : (bf16*)nullptr, ssq};
            pg8::gemm_phase<EpiOut, pg8::StaticOrder, true, true>(lds, g, S, E);
            if (BOTH(p0 + 5)) SEAM();
        }
    }
    if (PH_ON(8) && IN(N_PHASES - 1)) {
        WSO(); TIDS(); const float* gf = args.in[8]; float* out = args.out;
        const int gw = vcu * NWAVES + wave, NGW = G * NWAVES;
        f32x4 gv[4];
#pragma unroll
        for (int j = 0; j < 4; ++j) gv[j] = ((const f32x4*)gf)[lane + 64 * j];
        for (int m0 = gw * 4; m0 < T; m0 += NGW * 4) {
            f32x4 v[4][4]; float sv[4];
#pragma unroll
            for (int r = 0; r < 4; ++r) { const GAS f32x4* xr = (const GAS f32x4*)(out + (size_t)(m0 + r) * DM) + lane; sv[r] = (lane < 16) ? ((const GAS float*)ssq)[(size_t)(m0 + r) * 16 + lane] : 0.f;
#pragma unroll
                for (int j = 0; j < 4; ++j) v[r][j] = xr[64 * j]; }
#pragma unroll
            for (int r = 0; r < 4; ++r) {
                float s = sv[r];
                s += __shfl_xor(s, 1); s += __shfl_xor(s, 2); s += __shfl_xor(s, 4); s += __shfl_xor(s, 8);
                s = __shfl(s, 0);
                const float rs = __builtin_amdgcn_rsqf(s * (1.0f / DM) + EPS);
                GAS f32x4* xw = (GAS f32x4*)(out + (size_t)(m0 + r) * DM) + lane;
#pragma unroll
                for (int j = 0; j < 4; ++j) xw[64 * j] = v[r][j] * rs * gv[j];
            }
        }
    }
#undef IN
#undef BOTH
#undef SEAM
}

extern "C" void kernel_launch(void* const* d_in, const int* in_sizes, int n_in, void* d_out, int out_size, void* d_ws, size_t ws_size, hipStream_t stream) {
    static int grid = 0;
    if (grid == 0) {
        if (n_in != 9 || in_sizes[0] != T * DM || out_size != T * DM || ws_size < WS_END) { fprintf(stderr, "kernel_launch: unexpected shapes / workspace (n_in %d, ws %zu)\n", n_in, ws_size); grid = -1; return; }
        int dev = 0, cus = 0, per_cu = 0;
        (void)hipGetDevice(&dev); (void)hipDeviceGetAttribute(&cus, hipDeviceAttributeMultiprocessorCount, dev);
        if (hipFuncSetAttribute((const void*)trunk_fwd, hipFuncAttributeMaxDynamicSharedMemorySize, LDS_BYTES) != hipSuccess) { fprintf(stderr, "kernel_launch: hipFuncSetAttribute failed\n"); grid = -1; return; }
        if (hipOccupancyMaxActiveBlocksPerMultiprocessor(&per_cu, (const void*)trunk_fwd, NWAVES * 64, LDS_BYTES) != hipSuccess || per_cu < 1) { fprintf(stderr, "kernel_launch: occupancy query gave %d\n", per_cu); per_cu = 1; }
        (void)hipGetLastError();
        grid = cus * per_cu;
    }
    if (grid < 0) return;
    Args a{};
    for (int i = 0; i < 9; ++i) a.in[i] = (const float*)d_in[i];
    a.out = (float*)d_out; a.ws = (unsigned char*)d_ws;
#if MK_MULTI
    for (int p = 0; p < N_PHASES; ++p) { a.ph_lo = p; a.ph_hi = p + 1; hipLaunchKernelGGL(trunk_fwd, dim3(grid), dim3(NWAVES * 64), LDS_BYTES, stream, a); }
#else
    a.ph_lo = 0; a.ph_hi = N_PHASES;
    if (hipMemsetAsync(d_ws, 0, 16384, stream) != hipSuccess) { fprintf(stderr, "kernel_launch: memset of the barrier words failed\n"); return; }
    void* kargs[] = {&a};
    hipError_t e = hipLaunchCooperativeKernel((const void*)trunk_fwd, dim3(grid), dim3(NWAVES * 64), kargs, LDS_BYTES, stream);
    if (e != hipSuccess) fprintf(stderr, "kernel_launch: cooperative launch failed: %s (grid %d)\n", hipGetErrorString(e), grid);
#endif
}
```

```cpp
#include <hip/hip_runtime.h>
#include <hip/hip_cooperative_groups.h>
#include <hip/hip_bf16.h>
#include <cstdio>
#include <cstdint>
#include <cmath>
namespace cg = cooperative_groups;
namespace pg8 {
#define PG8_LAS __attribute__((address_space(3)))
typedef unsigned short bf16_t;
typedef short bf16x8 __attribute__((ext_vector_type(8)));
typedef float f32x4 __attribute__((ext_vector_type(4)));
typedef unsigned u32x4 __attribute__((ext_vector_type(4)));
constexpr int BM = 256, BK = 64, HALF = 128, HTB = HALF * BK * 2  , STAGE_BYTES = 8 * HTB, NXCD = 8, WGM = 8;

__host__ __device__ __forceinline__ int lds_byte(int r, int c) { const int st = (r >> 4) * 2 + (c >> 5), rr = r & 15, cc = c & 31, ob = rr * 64 + cc * 2; return st * 1024 + (ob ^ (((ob >> 9) & 1) << 5)); }
__host__ __device__ __forceinline__ void stage_rc(int b, int& R, int& C) { const int st = b / 1024, sb = b % 1024, swz = sb ^ (((sb >> 9) & 1) << 5); R = (st >> 1) * 16 + swz / 64; C = (st & 1) * 32 + (swz % 64) / 2; }
__host__ __device__ __forceinline__ int perm32(int rho) { const int n = rho >> 4, i = rho & 15; return 8 * (i >> 2) + 4 * n + (i & 3); }

struct Unit { int pm, pn, seg; };
struct Gemm { const bf16_t* A0; const bf16_t* A1; const bf16_t* A2; const bf16_t* Bt; size_t bseg  ; int M, N, K; };
__device__ __forceinline__ const char* gemm_abase(const Gemm& g, int seg) { return (const char*)(seg == 0 ? g.A0 : (seg == 1 ? g.A1 : g.A2)); }

struct StaticOrder {
    int nM, nN, nwg, G, c;
    __host__ __device__ void init(int M, int N, int G_, int c_) { nM = M / BM; nN = N / BM; nwg = nM * nN; G = G_; c = c_; }
    __host__ __device__ bool next(int i, Unit& u) const {
        const long L = (long)i * G + c; if (L >= nwg) return false;
        int wgid = (int)L; { const int q = nwg / NXCD, r = nwg % NXCD, xcd = wgid % NXCD, off = wgid / NXCD; wgid = (xcd < r ? xcd * (q + 1) : r * (q + 1) + (xcd - r) * q) + off; }
        const int nig = WGM * nN, gid = wgid / nig, fm = gid * WGM, gsz = (nM - fm) < WGM ? (nM - fm) : WGM;
        u.pm = fm + ((wgid % nig) % gsz); u.pn = (wgid % nig) / gsz; u.seg = 0; return true;
    }
    __device__ __forceinline__ void a_ready(const Unit&) const {}
    __device__ __forceinline__ void done(const Unit&) const {}
};

__device__ __forceinline__ unsigned cvt_pk_bf16(float lo, float hi) { unsigned r; asm volatile("v_cvt_pk_bf16_f32 %0, %1, %2" : "=v"(r) : "v"(lo), "v"(hi)); return r; }
typedef float f32x2 __attribute__((ext_vector_type(2)));
template <class Epi, class Sched, bool ALIGN_EPI = false, bool SP2 = false>
__device__ __forceinline__ void gemm_phase(PG8_LAS unsigned char* lds, const Gemm g, const Sched& S, const Epi& E) {
    int tid = threadIdx.x; asm volatile("" : "+v"(tid));
    const int wid = __builtin_amdgcn_readfirstlane(tid >> 6), lane = tid & 63, wr = wid >> 2, wc = wid & 3, fr = lane & 15, fq = lane >> 4;
    const int K = g.K, nt = K / BK;
    unsigned voffA[2], voffB[2];
#pragma unroll
    for (int i = 0; i < 2; ++i) { int R, C; stage_rc(tid * 16 + i * 8192, R, C); const int Rb = Epi::PERM ? ((R & ~31) + perm32(R & 31)) : R;
        voffA[i] = (unsigned)(R * K + C) * 2u; voffB[i] = (unsigned)(Rb * K + C) * 2u; }
    const size_t kstep = (size_t)(BK * 2);
    const size_t hstep = (size_t)HALF * K * 2;
    const size_t tstep = 2 * hstep;
    const unsigned ldsw = (unsigned)wid * 1024u;
    const int aoff = lds_byte(wr * 64 + fr, fq * 8), boff = lds_byte(wc * 32 + fr, fq * 8);
#define PG8_SA(b, h) (((b) * 2 + (h)) * HTB)
#define PG8_SB(b, h) ((4 + (b) * 2 + (h)) * HTB)
#define PG8_STAGE(bufoff, gbase, voff) do { _Pragma("unroll") for (int _i = 0; _i < 2; ++_i) \
        __builtin_amdgcn_global_load_lds((const unsigned*)((const char*)(gbase) + (voff)[_i]), (PG8_LAS unsigned*)(lds + (bufoff) + ldsw + _i * 8192), 16, 0, 0); } while (0)
#define PG8_LDA(dst, b, h) do { _Pragma("unroll") for (int m = 0; m < 4; ++m) _Pragma("unroll") for (int k = 0; k < 2; ++k) dst[m][k] = *(const PG8_LAS bf16x8*)(lds + PG8_SA(b, h) + aoff + m * 2048 + k * 1024); } while (0)
#define PG8_LDB(dst, b, h) do { _Pragma("unroll") for (int n = 0; n < 2; ++n) _Pragma("unroll") for (int k = 0; k < 2; ++k) dst[n][k] = *(const PG8_LAS bf16x8*)(lds + PG8_SB(b, h) + boff + n * 2048 + k * 1024); } while (0)
#define PG8_MMA(ai, bj, At, Bt) do { __builtin_amdgcn_s_setprio(1); _Pragma("unroll") for (int m = 0; m < 4; ++m) _Pragma("unroll") for (int n = 0; n < 2; ++n) _Pragma("unroll") for (int k = 0; k < 2; ++k) \
        acc[ai][bj][m][n] = __builtin_amdgcn_mfma_f32_16x16x32_bf16(Bt[n][k], At[m][k], acc[ai][bj][m][n], 0, 0, 0); __builtin_amdgcn_s_setprio(0); } while (0)
#define PG8_WAIT_V(n) asm volatile("s_waitcnt vmcnt(" #n ")" ::: "memory")
#define PG8_WAIT_L(n) asm volatile("s_waitcnt lgkmcnt(" #n ")" ::: "memory")
#define PG8_BAR __builtin_amdgcn_s_barrier()
#define PG8_SCHED __builtin_amdgcn_sched_barrier(0)
    Unit cur, nxt; int ui = 0;
    if (!S.next(0, cur)) return;
    f32x4 acc[2][2][4][2];
#pragma unroll
    for (int a = 0; a < 2; ++a)
#pragma unroll
        for (int b = 0; b < 2; ++b)
#pragma unroll
            for (int m = 0; m < 4; ++m)
#pragma unroll
                for (int n = 0; n < 2; ++n) acc[a][b][m][n] = (f32x4){0.f, 0.f, 0.f, 0.f};
    bf16x8 At[4][2], B0[2][2], B1[2][2];
    const char* cA = gemm_abase(g, cur.seg) + (size_t)cur.pm * tstep; const char* cB = (const char*)g.Bt + (size_t)cur.seg * g.bseg + (size_t)cur.pn * tstep;
    S.a_ready(cur);
    if constexpr (SP2) {
        PG8_STAGE(PG8_SB(0, 0), cB, voffB); PG8_STAGE(PG8_SB(0, 1), cB + hstep, voffB); PG8_STAGE(PG8_SA(0, 0), cA, voffA); PG8_STAGE(PG8_SA(0, 1), cA + hstep, voffA);
        if (wr == 1) PG8_BAR;
        PG8_WAIT_V(2); PG8_BAR;
        PG8_STAGE(PG8_SB(1, 0), cB + kstep, voffB); PG8_STAGE(PG8_SA(1, 0), cA + kstep, voffA); PG8_STAGE(PG8_SB(1, 1), cB + hstep + kstep, voffB);
        PG8_WAIT_V(6); PG8_BAR;
    } else {
        PG8_STAGE(PG8_SB(0, 0), cB, voffB); PG8_STAGE(PG8_SA(0, 0), cA, voffA); PG8_STAGE(PG8_SB(0, 1), cB + hstep, voffB); PG8_STAGE(PG8_SA(0, 1), cA + hstep, voffA);
        if (wr == 1) PG8_BAR;
        PG8_WAIT_V(4); PG8_BAR;
        PG8_STAGE(PG8_SB(1, 0), cB + kstep, voffB); PG8_STAGE(PG8_SA(1, 0), cA + kstep, voffA); PG8_STAGE(PG8_SB(1, 1), cB + hstep + kstep, voffB);
        PG8_WAIT_V(6); PG8_BAR;
    }
    for (;;) {
        const bool has_next = S.next(ui + 1, nxt);
        const char* nA = has_next ? gemm_abase(g, nxt.seg) + (size_t)nxt.pm * tstep : cA; const char* nB = has_next ? (const char*)g.Bt + (size_t)nxt.seg * g.bseg + (size_t)nxt.pn * tstep : cB;
        for (int t = 0; t < nt; t += 2) {
            const bool last = (t == nt - 2);
            const char* a1 = cA + (size_t)(t + 1) * kstep;
            const char* a2 = last ? nA : cA + (size_t)(t + 2) * kstep; const char* b2 = last ? nB : cB + (size_t)(t + 2) * kstep;
            const char* a3 = a2 + kstep; const char* b3 = b2 + kstep;
            if (last && has_next) S.a_ready(nxt);
            if constexpr (SP2) {
            PG8_LDB(B0, 0, 0); PG8_LDB(B1, 0, 1); PG8_SCHED; PG8_LDA(At, 0, 0); PG8_STAGE(PG8_SA(1, 1), a1 + hstep, voffA);
            PG8_WAIT_V(8); PG8_WAIT_L(0); PG8_BAR; PG8_MMA(0, 0, At, B0); PG8_MMA(0, 1, At, B1); PG8_BAR; PG8_SCHED;
            PG8_LDA(At, 0, 1); PG8_STAGE(PG8_SB(0, 0), b2, voffB); PG8_STAGE(PG8_SB(0, 1), b2 + hstep, voffB); PG8_STAGE(PG8_SA(0, 0), a2, voffA);
            PG8_WAIT_V(8); PG8_WAIT_L(0); PG8_BAR; PG8_MMA(1, 0, At, B0); PG8_MMA(1, 1, At, B1); PG8_BAR; PG8_SCHED;
            PG8_LDB(B0, 1, 0); PG8_LDB(B1, 1, 1); PG8_SCHED; PG8_LDA(At, 1, 0); PG8_STAGE(PG8_SA(0, 1), a2 + hstep, voffA);
            PG8_WAIT_V(8); PG8_WAIT_L(0); PG8_BAR; PG8_MMA(0, 0, At, B0); PG8_MMA(0, 1, At, B1); PG8_BAR; PG8_SCHED;
            PG8_LDA(At, 1, 1); PG8_STAGE(PG8_SB(1, 0), b3, voffB); PG8_STAGE(PG8_SB(1, 1), b3 + hstep, voffB); PG8_STAGE(PG8_SA(1, 0), a3, voffA);
            PG8_WAIT_V(8); PG8_WAIT_L(0); PG8_BAR; PG8_MMA(1, 0, At, B0); PG8_MMA(1, 1, At, B1); PG8_BAR; PG8_SCHED;
            } else {
            PG8_LDB(B0, 0, 0); PG8_SCHED; PG8_LDA(At, 0, 0); PG8_STAGE(PG8_SA(1, 1), a1 + hstep, voffA);
            PG8_WAIT_L(8); PG8_BAR; PG8_WAIT_L(0); PG8_MMA(0, 0, At, B0); PG8_BAR; PG8_SCHED;
            PG8_LDB(B1, 0, 1); PG8_STAGE(PG8_SB(0, 0), b2, voffB);
            PG8_BAR; PG8_WAIT_L(0); PG8_MMA(0, 1, At, B1); PG8_BAR;
            PG8_LDA(At, 0, 1); PG8_STAGE(PG8_SA(0, 0), a2, voffA);
            PG8_BAR; PG8_WAIT_L(0); PG8_MMA(1, 0, At, B0); PG8_BAR; PG8_SCHED;
            PG8_STAGE(PG8_SB(0, 1), b2 + hstep, voffB);
            PG8_WAIT_V(6); PG8_BAR; PG8_MMA(1, 1, At, B1); PG8_BAR;
            PG8_LDB(B0, 1, 0); PG8_SCHED; PG8_LDA(At, 1, 0); PG8_STAGE(PG8_SA(0, 1), a2 + hstep, voffA);
            PG8_WAIT_L(8); PG8_BAR; PG8_WAIT_L(0); PG8_MMA(0, 0, At, B0); PG8_BAR; PG8_SCHED;
            PG8_LDB(B1, 1, 1); PG8_STAGE(PG8_SB(1, 0), b3, voffB);
            PG8_BAR; PG8_WAIT_L(0); PG8_MMA(0, 1, At, B1); PG8_BAR;
            PG8_LDA(At, 1, 1); PG8_STAGE(PG8_SA(1, 0), a3, voffA);
            PG8_BAR; PG8_WAIT_L(0); PG8_MMA(1, 0, At, B0); PG8_BAR; PG8_SCHED;
            PG8_STAGE(PG8_SB(1, 1), b3 + hstep, voffB);
            PG8_WAIT_V(6); PG8_BAR; PG8_MMA(1, 1, At, B1); PG8_BAR;
            }
        }
        if constexpr (ALIGN_EPI) { if (wr == 0) PG8_BAR; }
        if constexpr (!Epi::AFTER_DRAIN) { E(acc, cur, wr, wc, fr, fq); S.done(cur); }
        if (!has_next) break;
        if (!E.keep(cur)) {
#pragma unroll
        for (int a = 0; a < 2; ++a)
#pragma unroll
            for (int b = 0; b < 2; ++b)
#pragma unroll
                for (int m = 0; m < 4; ++m)
#pragma unroll
                    for (int n = 0; n < 2; ++n) acc[a][b][m][n] = (f32x4){0.f, 0.f, 0.f, 0.f};
        }
        cur = nxt; cA = nA; cB = nB; ++ui;
        if constexpr (ALIGN_EPI) { if (wr == 1) PG8_BAR; }
    }
    PG8_WAIT_V(0);
    if constexpr (!ALIGN_EPI) { if (wr == 0) PG8_BAR; }
    PG8_BAR;
    if constexpr (Epi::AFTER_DRAIN) { E.fused(acc, cur, wr, wc, fr, fq, lds, wid, lane); S.done(cur); }
#undef PG8_SA
#undef PG8_SB
#undef PG8_STAGE
#undef PG8_LDA
#undef PG8_LDB
#undef PG8_MMA
#undef PG8_WAIT_V
#undef PG8_WAIT_L
#undef PG8_BAR
#undef PG8_SCHED
}
}
namespace attn_body {
using bf16=__hip_bfloat16;
using bf16x8=__attribute__((ext_vector_type(8)))short;
using s16x4=__attribute__((ext_vector_type(4)))short;
using f32x16=__attribute__((ext_vector_type(16)))float;
using u32x4=__attribute__((ext_vector_type(4)))unsigned;
constexpr int SEQ=8192,D=64;
constexpr int NW=8,QBLK=32,QB=QBLK*NW,KVBLK=64,NQB=SEQ/QB;
constexpr int ATTN_UNIT_ROWS=QB;
__device__ __forceinline__ int crow(int r,int hi){return (r&3)+8*(r>>2)+4*hi;}
#define SBAR() __builtin_amdgcn_sched_barrier(0)
__device__ __forceinline__ void cmask(f32x16&p0,f32x16&p1,int jb,int qrel,int hi){
  const float NEG=-INFINITY; int kb=64*jb+4*hi;
  #pragma unroll
  for(int r=0;r<16;++r){int kv=kb+(r&3)+8*(r>>2); if(kv>qrel)p0[r]=NEG; if(kv+32>qrel)p1[r]=NEG;}
}

constexpr int NSLOT=3, SLOTB=8192;
constexpr int LDS_K=0, LDS_V=NSLOT*SLOTB, LDS_WS=2*NSLOT*SLOTB, LDS_OST=LDS_WS+NW*64*4, LDS_BYTES=LDS_OST+NW*4096;
constexpr float C2=0.125f*1.4426950408889634f;
__device__ __forceinline__ void glds16(const void*gsrc,unsigned lds_dst){unsigned keep;
  asm volatile("s_mov_b32 %0, m0\n\ts_mov_b32 m0, %2\n\ts_nop 0\n\tglobal_load_lds_dwordx4 %1, off\n\ts_mov_b32 m0, %0":"=&s"(keep):"v"(gsrc),"s"(lds_dst):"memory");}
__device__ __forceinline__ float max3f(float a,float b,float c){float r;asm("v_max3_f32 %0, %1, %2, %3":"=v"(r):"v"(a),"v"(b),"v"(c));return r;}
__device__ __forceinline__ float max2f(float a,float b){float r;asm("v_max_f32_e32 %0, %1, %2":"=v"(r):"v"(a),"v"(b));return r;}
__device__ __forceinline__ float fadd_s(float a,float b){float r;asm("v_add_f32_e32 %0, %1, %2":"=v"(r):"v"(a),"v"(b));return r;}
__device__ __forceinline__ float fsub_s(float a,float b){float r;asm("v_sub_f32_e32 %0, %1, %2":"=v"(r):"v"(a),"v"(b));return r;}
typedef float f32x2_t __attribute__((ext_vector_type(2))); typedef __bf16 bf16x2_t __attribute__((ext_vector_type(2)));
__device__ __forceinline__ unsigned cvtpk_s(float lo,float hi){f32x2_t v={lo,hi};bf16x2_t b=__builtin_convertvector(v,bf16x2_t);return __builtin_bit_cast(unsigned,b);}
#define WAIT_BAR(N) asm volatile("s_waitcnt vmcnt(" #N ") lgkmcnt(0)\n\ts_barrier":::"memory")

__device__ __forceinline__ void qkt(f32x16&p0,f32x16&p1,const char*Kslot,const bf16x8*qr,const f32x16&negm,int r32,int hi){
  const char*kb=Kslot+hi*1024+r32*16;
  #pragma unroll
  for(int d0=0;d0<4;++d0){
    const bf16x8 b0=*reinterpret_cast<const bf16x8*>(kb+d0*2048);
    const bf16x8 b1=*reinterpret_cast<const bf16x8*>(kb+d0*2048+512);
    if(d0==0){p0=__builtin_amdgcn_mfma_f32_32x32x16_bf16(b0,qr[0],negm,0,0,0);p1=__builtin_amdgcn_mfma_f32_32x32x16_bf16(b1,qr[0],negm,0,0,0);}
    else{p0=__builtin_amdgcn_mfma_f32_32x32x16_bf16(b0,qr[d0],p0,0,0,0);p1=__builtin_amdgcn_mfma_f32_32x32x16_bf16(b1,qr[d0],p1,0,0,0);}}
}
typedef __attribute__((address_space(3))) const char* lds_cptr;
typedef short v4i16_t __attribute__((ext_vector_type(4)));
__device__ __forceinline__ void kload8(bf16x8*kf,lds_cptr kp){
  kf[0]=*(const __attribute__((address_space(3))) bf16x8*)(kp);      kf[1]=*(const __attribute__((address_space(3))) bf16x8*)(kp+512);
  kf[2]=*(const __attribute__((address_space(3))) bf16x8*)(kp+2048); kf[3]=*(const __attribute__((address_space(3))) bf16x8*)(kp+2560);
  kf[4]=*(const __attribute__((address_space(3))) bf16x8*)(kp+4096); kf[5]=*(const __attribute__((address_space(3))) bf16x8*)(kp+4608);
  kf[6]=*(const __attribute__((address_space(3))) bf16x8*)(kp+6144); kf[7]=*(const __attribute__((address_space(3))) bf16x8*)(kp+6656);
}
__device__ __forceinline__ void kload2(bf16x8*kf,lds_cptr kp,int j){ kf[2*j]=*(const __attribute__((address_space(3))) bf16x8*)(kp+j*2048); kf[2*j+1]=*(const __attribute__((address_space(3))) bf16x8*)(kp+j*2048+512); }
__device__ __forceinline__ s16x4 vtr(lds_cptr p){ return __builtin_bit_cast(s16x4,__builtin_amdgcn_ds_read_tr16_b64_v4i16((__attribute__((address_space(3))) v4i16_t*)p)); }
__device__ __forceinline__ float rowmax(const f32x16&p0,const f32x16&p1){
  float a=max3f(p0[0],p0[1],p1[0]),b=max3f(p0[2],p0[3],p1[1]);a=max3f(a,p1[2],p1[3]);
  #pragma unroll
  for(int r=4;r<16;r+=4){a=max3f(a,p0[r],p0[r+1]);b=max3f(b,p0[r+2],p0[r+3]);a=max3f(a,p1[r],p1[r+1]);b=max3f(b,p1[r+2],p1[r+3]);}
  const float m=max2f(a,b);
  auto rr=__builtin_amdgcn_permlane32_swap(__float_as_uint(m),__float_as_uint(m),false,false);
  return max2f(__uint_as_float(rr[0]),__uint_as_float(rr[1]));
}
__device__ __forceinline__ void pv(f32x16*o,int vb,bf16x8 pa0,bf16x8 pa1,bf16x8 pa2,bf16x8 pa3){
  #pragma unroll
  for(int d0=0;d0<2;++d0){s16x4 lo[4],hi[4];
    #pragma unroll
    for(int ks=0;ks<4;++ks){
      asm volatile("ds_read_b64_tr_b16 %0,%1 offset:%c2":"=&v"(lo[ks]):"v"(vb),"i"(d0*4096+ks*1024):"memory");
      asm volatile("ds_read_b64_tr_b16 %0,%1 offset:%c2":"=&v"(hi[ks]):"v"(vb),"i"(d0*4096+ks*1024+512):"memory");}
    asm volatile("s_waitcnt lgkmcnt(0)":::"memory");SBAR();
    #define PK(k) (bf16x8){lo[k][0],lo[k][1],lo[k][2],lo[k][3],hi[k][0],hi[k][1],hi[k][2],hi[k][3]}
    o[d0]=__builtin_amdgcn_mfma_f32_32x32x16_bf16(pa0,PK(0),o[d0],0,0,0);
    o[d0]=__builtin_amdgcn_mfma_f32_32x32x16_bf16(pa1,PK(1),o[d0],0,0,0);
    o[d0]=__builtin_amdgcn_mfma_f32_32x32x16_bf16(pa2,PK(2),o[d0],0,0,0);
    o[d0]=__builtin_amdgcn_mfma_f32_32x32x16_bf16(pa3,PK(3),o[d0],0,0,0);
    #undef PK
  }
}

#ifndef ATTN_STORE16
#define ATTN_STORE16(p,v) (*(u32x4*)(p)=(v))
#endif
template<int THRL,int PQ,int PK,int PV,int PO> __device__ __forceinline__ void attn_unit(int q0,const bf16*Qu,const bf16*__restrict__ Kh,const bf16*__restrict__ Vh,bf16*Ou,char*shm){
  int tid=threadIdx.x; asm volatile("":"+v"(tid)); const int lane=tid&63,r32=lane&31,hi=lane>>5; const int wid=__builtin_amdgcn_readfirstlane(tid>>6);
  const bf16*Qw=Qu+(long)(wid*QBLK)*PQ;
  const unsigned lds0=(unsigned)(uintptr_t)shm;
  float*wsf=(float*)(shm+LDS_WS)+wid*64;
  const bf16*ksrc=Kh+(long)lane*PK+wid*8;
  const bf16*vsrc=Vh+(long)(16*(wid&3)+(lane>>2))*PV+(wid>>2)*32+(lane&3)*8;
  const unsigned kdst=lds0+LDS_K+wid*1024, vdst=lds0+LDS_V+wid*1024;
  #define DMA_K(t,slot) glds16(ksrc+(long)(t)*KVBLK*PK,(unsigned)__builtin_amdgcn_readfirstlane(kdst+(slot)))
  #define DMA_V(t,slot) glds16(vsrc+(long)(t)*KVBLK*PV,(unsigned)__builtin_amdgcn_readfirstlane(vdst+(slot)))
  const int vb0=(int)(lds0+LDS_V)+((lane>>4)&1)*32+(lane&3)*8+(4*hi+((lane&15)>>2))*64;
  const char*Kbase=shm+LDS_K; bf16x8 kf[8];
  const lds_cptr shm3=(lds_cptr)shm; const lds_cptr kp0=shm3+LDS_K+hi*1024+r32*16; const lds_cptr vp0=shm3+LDS_V+((lane>>4)&1)*32+(lane&3)*8+(4*hi+((lane&15)>>2))*64;
  const int NT=(q0+QB)/KVBLK;
  DMA_K(0,0);DMA_V(0,0);DMA_K(1,SLOTB);
  bf16x8 qr[4];
  #pragma unroll
  for(int d0=0;d0<4;++d0)qr[d0]=*reinterpret_cast<const bf16x8*>(&Qw[(long)r32*PQ+d0*16+hi*8]);
  float mhat=0.f,l_reg=0.f;f32x16 o[2];o[0]=f32x16{};o[1]=f32x16{};f32x16 negm=f32x16{};asm volatile("":"+v"(negm));
  const int qrel=wid*QBLK+r32;
  #define CMASK(P0,P1,t) do{int jb_=(t)-(NT-4); if(jb_>=0)cmask(P0,P1,jb_,qrel,hi);}while(0)
  bool resc=false;
  #define START(P0,P1) do{ const float rm=rowmax(P0,P1); resc=false; \
    { const float dl=rm; mhat=fadd_s(mhat,dl); \
      _Pragma("unroll") for(int r=0;r<16;++r){P0[r]=fsub_s(P0[r],dl);P1[r]=fsub_s(P1[r],dl);} \
      _Pragma("unroll") for(int r=0;r<16;++r)negm[r]=-mhat; asm volatile("":"+v"(negm)); } \
    _Pragma("unroll") for(int r=0;r<16;++r)P0[r]=__builtin_amdgcn_exp2f(P0[r]); }while(0)
  #define RESC() do{ if(resc){ asm volatile("s_waitcnt lgkmcnt(0)":::"memory"); \
      _Pragma("unroll") for(int d_=0;d_<2;++d_) _Pragma("unroll") for(int r=0;r<16;++r)o[d_][r]*=wsf[crow(r,hi)]; } }while(0)
  f32x16 pA0,pA1,pB0,pB1;
  int sl_prev=0,sl_cur=0,sl_next=SLOTB;
  #define ROT() do{sl_prev=sl_cur;sl_cur=sl_next;sl_next=(sl_next==(NSLOT-1)*SLOTB)?0:sl_next+SLOTB;}while(0)
  DMA_K(2,2*SLOTB);
  WAIT_BAR(3);
  qkt(pA0,pA1,Kbase,qr,negm,r32,hi);asm volatile("s_nop 15\n\ts_nop 7":"+v"(pA0),"+v"(pA1));CMASK(pA0,pA1,0);
  START(pA0,pA1);
  _Pragma("unroll") for(int r=0;r<16;++r)pA1[r]=__builtin_amdgcn_exp2f(pA1[r]);
  WAIT_BAR(0);
  DMA_K(3,0);DMA_V(1,SLOTB);
  ROT();
  kload8(kf,kp0+sl_cur);
  WAIT_BAR(2);
  s16x4 vlo[8],vhi[8]; u32x4 pw0,pw1,pw2,pw3;
  #define PKW(P,B) cvtpk_s(P[B],P[B+1])
  #define PAF(k) __builtin_bit_cast(bf16x8,pw##k)
  #define VFR(i) (bf16x8){vlo[i][0],vlo[i][1],vlo[i][2],vlo[i][3],vhi[i][0],vhi[i][1],vhi[i][2],vhi[i][3]}
  #define PIN(x) asm volatile("":"+v"(x))
  #define MX3(a,b,c) __builtin_fmaxf(__builtin_fmaxf((a),(b)),(c))
  #define GAPA(MF,A0,A1,A2,A3,W0,W1,PW) do{ MF; sacc+=A0; sacc+=A1; sacc+=A2; sacc+=A3; PIN(sacc); W0; W1; PIN(PW); SBAR(); }while(0)
  #define EX(v) __builtin_amdgcn_exp2f(v)
  #define GAPB(MF,X,B) do{ MF; X[B]=EX(X[B]); X[B+1]=EX(X[B+1]); X[B+2]=EX(X[B+2]); X[B+3]=EX(X[B+3]); PIN(X); SBAR(); }while(0)
  #define VRD(i) do{ vlo[i]=vtr(vp_+(((i)>>2)*4096+((i)&3)*1024)); vhi[i]=vtr(vp_+(((i)>>2)*4096+((i)&3)*1024+512)); }while(0)
  #define KRD(G,j) do{ if(G){ kload2(kf,kp0+sl_next,j); SBAR(); } }while(0)
  #define STEP(C0,C1,P0,P1,t,GK,GV,GL) do{ SBAR(); \
    const lds_cptr vp_=vp0+sl_prev; \
    VRD(0); SBAR(); float sacc=(P0[0]+P0[1]); \
    GAPA(C0=__builtin_amdgcn_mfma_f32_32x32x16_bf16(kf[0],qr[0],negm,0,0,0), P0[2],P0[3],P0[4],P0[5],     pw0[0]=PKW(P0,0), pw0[1]=PKW(P0,2), pw0); \
    VRD(4); SBAR(); GAPA(C1=__builtin_amdgcn_mfma_f32_32x32x16_bf16(kf[1],qr[0],negm,0,0,0), P0[6],P0[7],P0[8],P0[9],     pw0[2]=PKW(P0,4), pw0[3]=PKW(P0,6), pw0); \
    VRD(1); SBAR(); GAPA(C0=__builtin_amdgcn_mfma_f32_32x32x16_bf16(kf[2],qr[1],C0,0,0,0),   P0[10],P0[11],P0[12],P0[13], pw1[0]=PKW(P0,8), pw1[1]=PKW(P0,10), pw1); \
    VRD(5); SBAR(); GAPA(C1=__builtin_amdgcn_mfma_f32_32x32x16_bf16(kf[3],qr[1],C1,0,0,0),   P0[14],P0[15],P1[0],P1[1],   pw1[2]=PKW(P0,12),pw1[3]=PKW(P0,14), pw1); \
    VRD(2); SBAR(); GAPA(C0=__builtin_amdgcn_mfma_f32_32x32x16_bf16(kf[4],qr[2],C0,0,0,0),   P1[2],P1[3],P1[4],P1[5],     pw2[0]=PKW(P1,0), pw2[1]=PKW(P1,2), pw2); \
    VRD(6); SBAR(); GAPA(C1=__builtin_amdgcn_mfma_f32_32x32x16_bf16(kf[5],qr[2],C1,0,0,0),   P1[6],P1[7],P1[8],P1[9],     pw2[2]=PKW(P1,4), pw2[3]=PKW(P1,6), pw2); \
    VRD(3); SBAR(); GAPA(C0=__builtin_amdgcn_mfma_f32_32x32x16_bf16(kf[6],qr[3],C0,0,0,0),   P1[10],P1[11],P1[12],P1[13], pw3[0]=PKW(P1,8), pw3[1]=PKW(P1,10), pw3); \
    VRD(7); SBAR(); GAPA(C1=__builtin_amdgcn_mfma_f32_32x32x16_bf16(kf[7],qr[3],C1,0,0,0),   P1[14],P1[15],0.f,0.f,       pw3[2]=PKW(P1,12),pw3[3]=PKW(P1,14), pw3); \
    l_reg+=sacc; \
    if(GK){DMA_K((t)+3,sl_cur);} if(GV){DMA_V((t)+1,sl_next);} \
    CMASK(C0,C1,t); \
    { float a=MX3(C0[0],C0[1],C1[0]),b=MX3(C0[2],C0[3],C1[1]); a=MX3(a,C1[2],C1[3]); \
      _Pragma("unroll") for(int r=4;r<16;r+=4){a=MX3(a,C0[r],C0[r+1]);b=MX3(b,C0[r+2],C0[r+3]);a=MX3(a,C1[r],C1[r+1]);b=MX3(b,C1[r+2],C1[r+3]);} \
      float rm=__builtin_fmaxf(a,b); { auto rr=__builtin_amdgcn_permlane32_swap(__float_as_uint(rm),__float_as_uint(rm),false,false); rm=__builtin_fmaxf(__uint_as_float(rr[0]),__uint_as_float(rr[1])); } \
      resc=false; \
      if(__builtin_expect(__any(rm>(float)THRL),0)){ const float dl=__builtin_fmaxf(rm,0.f); mhat+=dl; \
        _Pragma("unroll") for(int r=0;r<16;++r){C0[r]-=dl;C1[r]-=dl;} \
        _Pragma("unroll") for(int r=0;r<16;++r)negm[r]=-mhat; asm volatile("":"+v"(negm)); \
        const float f=__builtin_amdgcn_exp2f(-dl); l_reg*=f; if(hi==0)wsf[r32]=f; resc=true; } } \
    SBAR(); \
    GAPB(o[0]=__builtin_amdgcn_mfma_f32_32x32x16_bf16(PAF(0),VFR(0),o[0],0,0,0), C0,0); \
    GAPB(o[1]=__builtin_amdgcn_mfma_f32_32x32x16_bf16(PAF(0),VFR(4),o[1],0,0,0), C0,4); \
    KRD(GL,0); GAPB(o[0]=__builtin_amdgcn_mfma_f32_32x32x16_bf16(PAF(1),VFR(1),o[0],0,0,0), C0,8); \
    KRD(GL,1); GAPB(o[1]=__builtin_amdgcn_mfma_f32_32x32x16_bf16(PAF(1),VFR(5),o[1],0,0,0), C0,12); \
    KRD(GL,2); GAPB(o[0]=__builtin_amdgcn_mfma_f32_32x32x16_bf16(PAF(2),VFR(2),o[0],0,0,0), C1,0); \
    KRD(GL,3); GAPB(o[1]=__builtin_amdgcn_mfma_f32_32x32x16_bf16(PAF(2),VFR(6),o[1],0,0,0), C1,4); \
    GAPB(o[0]=__builtin_amdgcn_mfma_f32_32x32x16_bf16(PAF(3),VFR(3),o[0],0,0,0), C1,8); \
    GAPB(o[1]=__builtin_amdgcn_mfma_f32_32x32x16_bf16(PAF(3),VFR(7),o[1],0,0,0), C1,12); \
    }while(0)
  int t=1;
  #undef CMASK
  #define CMASK(P0,P1,t) do{}while(0)
  for(;t+5<NT;t+=2){
    STEP(pB0,pB1,pA0,pA1,t,true,true,true);     WAIT_BAR(2); RESC(); ROT();
    STEP(pA0,pA1,pB0,pB1,t+1,true,true,true);   WAIT_BAR(2); RESC(); ROT();
  }
  #undef CMASK
  #define CMASK(P0,P1,t) do{int jb_=(t)-(NT-4); if(jb_>=0)cmask(P0,P1,jb_,qrel,hi);}while(0)
  #define ENDW(tt) do{ if((tt)+3<NT){WAIT_BAR(2);} else if((tt)+2<NT){WAIT_BAR(1);} else {WAIT_BAR(0);} }while(0)
  for(;t+1<NT;t+=2){
    STEP(pB0,pB1,pA0,pA1,t,(t+3<NT),(t+1<NT),(t+1<NT));       ENDW(t);   RESC(); ROT();
    STEP(pA0,pA1,pB0,pB1,t+1,(t+4<NT),(t+2<NT),(t+2<NT));     ENDW(t+1); RESC(); ROT();
  }
  STEP(pB0,pB1,pA0,pA1,NT-1,false,false,false); RESC();
  { float sacc=pB0[0]+pB0[1]; _Pragma("unroll") for(int r=2;r<16;++r)sacc+=pB0[r]; _Pragma("unroll") for(int r=0;r<16;++r)sacc+=pB1[r]; l_reg+=sacc;
    pw0=(u32x4){PKW(pB0,0),PKW(pB0,2),PKW(pB0,4),PKW(pB0,6)};pw1=(u32x4){PKW(pB0,8),PKW(pB0,10),PKW(pB0,12),PKW(pB0,14)};pw2=(u32x4){PKW(pB1,0),PKW(pB1,2),PKW(pB1,4),PKW(pB1,6)};pw3=(u32x4){PKW(pB1,8),PKW(pB1,10),PKW(pB1,12),PKW(pB1,14)};
    SBAR(); pv(o,vb0+sl_cur,PAF(0),PAF(1),PAF(2),PAF(3)); }
  #undef PKW
  #undef PAF
  #undef VFR
  #undef PIN
  #undef MX3
  #undef GAPA
  #undef GAPB
  #undef EX
  #undef VRD
  #undef KRD
  #undef STEP
  #undef ENDW
  {auto rr=__builtin_amdgcn_permlane32_swap(__float_as_uint(l_reg),__float_as_uint(l_reg),false,false);l_reg=__uint_as_float(rr[0])+__uint_as_float(rr[1]);}
  if(hi==0)wsf[32+r32]=l_reg;asm volatile("s_waitcnt lgkmcnt(0)":::"memory");
  float rli[16];
  #pragma unroll
  for(int r=0;r<16;++r)rli[r]=__builtin_amdgcn_rcpf(wsf[32+crow(r,hi)]);
  bf16*Ow=Ou+(long)(wid*QBLK)*PO;
  { bf16*stg=(bf16*)(shm+LDS_OST)+wid*2048;
    #pragma unroll
    for(int r=0;r<16;++r){const int orow=crow(r,hi);
      #pragma unroll
      for(int d0=0;d0<2;++d0)stg[orow*64+d0*32+r32]=__float2bfloat16(o[d0][r]*rli[r]);}
    asm volatile("s_waitcnt lgkmcnt(0)":::"memory");
    #pragma unroll
    for(int i=0;i<4;++i){const int row=i*8+(lane>>3),ch=lane&7; const u32x4 v=*(const u32x4*)(stg+row*64+ch*8); ATTN_STORE16(Ow+(long)row*PO+ch*8,v);} }
  asm volatile("s_waitcnt lgkmcnt(0)\n\ts_barrier":::"memory");
  #undef DMA_K
  #undef DMA_V
  #undef CMASK
  #undef START
  #undef RESC
  #undef ROT
}
constexpr int VSLOTB=16384;
constexpr int L2_K=0, L2_V=NSLOT*SLOTB, L2_WS=L2_V+NSLOT*VSLOTB, L2_OST=L2_WS+NW*64*4, L2_QS=L2_OST+NW*4096, L2_BYTES=L2_QS+NW*4096;
__device__ __forceinline__ void pv128(f32x16*o,int vb,bf16x8 pa0,bf16x8 pa1,bf16x8 pa2,bf16x8 pa3){
  #pragma unroll
  for(int d0=0;d0<4;++d0){s16x4 lo[4],hi[4];
    #pragma unroll
    for(int ks=0;ks<4;++ks){
      asm volatile("ds_read_b64_tr_b16 %0,%1 offset:%c2":"=&v"(lo[ks]):"v"(vb),"i"(d0*4096+ks*1024):"memory");
      asm volatile("ds_read_b64_tr_b16 %0,%1 offset:%c2":"=&v"(hi[ks]):"v"(vb),"i"(d0*4096+ks*1024+512):"memory");}
    asm volatile("s_waitcnt lgkmcnt(0)":::"memory");SBAR();
    #define PK(k) (bf16x8){lo[k][0],lo[k][1],lo[k][2],lo[k][3],hi[k][0],hi[k][1],hi[k][2],hi[k][3]}
    o[d0]=__builtin_amdgcn_mfma_f32_32x32x16_bf16(pa0,PK(0),o[d0],0,0,0);
    o[d0]=__builtin_amdgcn_mfma_f32_32x32x16_bf16(pa1,PK(1),o[d0],0,0,0);
    o[d0]=__builtin_amdgcn_mfma_f32_32x32x16_bf16(pa2,PK(2),o[d0],0,0,0);
    o[d0]=__builtin_amdgcn_mfma_f32_32x32x16_bf16(pa3,PK(3),o[d0],0,0,0);
    #undef PK
  }
}
template<int THRL,int PQ,int PK,int PV,int PO> __device__ __forceinline__ void attn_unit128(int q0,const bf16*Qu,const bf16*__restrict__ Kh,const bf16*__restrict__ Vh,bf16*Ou,char*shm){
  int tid=threadIdx.x; asm volatile("":"+v"(tid)); const int lane=tid&63,r32=lane&31,hi=lane>>5; const int wid=__builtin_amdgcn_readfirstlane(tid>>6);
  const bf16*Qw=Qu+(long)(wid*QBLK)*PQ;
  const unsigned lds0=(unsigned)(uintptr_t)shm;
  float*wsf=(float*)(shm+L2_WS)+wid*64;
  const bf16*ksrc=Kh+(long)lane*PK+wid*8;
  const bf16*vsrc=Vh+(long)(16*(wid&3)+(lane>>2))*PV+(wid>>2)*32+(lane&3)*8;
  const unsigned kdst=lds0+L2_K+wid*1024, vdst=lds0+L2_V+wid*1024;
  #define DMA_K(t,slot) glds16(ksrc+(long)(t)*KVBLK*PK,(unsigned)__builtin_amdgcn_readfirstlane(kdst+(slot)))
  #define DMA_V(t,slot) do{ glds16(vsrc+(long)(t)*KVBLK*PV,(unsigned)__builtin_amdgcn_readfirstlane(vdst+2*(slot))); glds16(vsrc+(long)(t)*KVBLK*PV+64,(unsigned)__builtin_amdgcn_readfirstlane(vdst+2*(slot)+8192)); }while(0)
  const int vb0=(int)(lds0+L2_V)+((lane>>4)&1)*32+(lane&3)*8+(4*hi+((lane&15)>>2))*64;
  const char*Kbase=shm+L2_K; bf16x8 kf[8];
  const lds_cptr shm3=(lds_cptr)shm; const lds_cptr kp0=shm3+L2_K+hi*1024+r32*16; const lds_cptr vp0=shm3+L2_V+((lane>>4)&1)*32+(lane&3)*8+(4*hi+((lane&15)>>2))*64;
  const int NT=(q0+QB)/KVBLK;
  DMA_K(0,0);DMA_V(0,0);DMA_K(1,SLOTB);
  bf16x8 qr[4];
  #pragma unroll
  for(int d0=0;d0<4;++d0)qr[d0]=*(const __attribute__((address_space(1))) bf16x8*)(&Qw[(long)r32*PQ+d0*16+hi*8]);
  typedef __attribute__((address_space(3))) bf16x8* lds_q_ptr; const lds_q_ptr qsp=(lds_q_ptr)((__attribute__((address_space(3))) char*)shm+L2_QS+wid*4096+lane*16);
  #pragma unroll
  for(int d0=0;d0<4;++d0)qsp[d0*64]=qr[d0];
  #define QL(d0) (qsp[(d0)*64])
  float mhat=0.f,l_reg=0.f;f32x16 o[4];o[0]=f32x16{};o[1]=f32x16{};o[2]=f32x16{};o[3]=f32x16{};f32x16 negm=f32x16{};asm volatile("":"+v"(negm));
  const int qrel=wid*QBLK+r32;
  #define CMASK(P0,P1,t) do{int jb_=(t)-(NT-4); if(jb_>=0)cmask(P0,P1,jb_,qrel,hi);}while(0)
  bool resc=false;
  #define START(P0,P1) do{ const float rm=rowmax(P0,P1); resc=false; \
    { const float dl=rm; mhat=fadd_s(mhat,dl); \
      _Pragma("unroll") for(int r=0;r<16;++r){P0[r]=fsub_s(P0[r],dl);P1[r]=fsub_s(P1[r],dl);} \
      _Pragma("unroll") for(int r=0;r<16;++r)negm[r]=-mhat; asm volatile("":"+v"(negm)); } \
    _Pragma("unroll") for(int r=0;r<16;++r)P0[r]=__builtin_amdgcn_exp2f(P0[r]); }while(0)
  #define RESC() do{ if(resc){ asm volatile("s_waitcnt lgkmcnt(0)":::"memory"); \
      _Pragma("unroll") for(int d_=0;d_<4;++d_) _Pragma("unroll") for(int r=0;r<16;++r)o[d_][r]*=wsf[crow(r,hi)]; } }while(0)
  f32x16 pA0,pA1,pB0,pB1;
  int sl_prev=0,sl_cur=0,sl_next=SLOTB;
  #define ROT() do{sl_prev=sl_cur;sl_cur=sl_next;sl_next=(sl_next==(NSLOT-1)*SLOTB)?0:sl_next+SLOTB;}while(0)
  DMA_K(2,2*SLOTB);
  WAIT_BAR(3);
  qkt(pA0,pA1,Kbase,qr,negm,r32,hi);asm volatile("s_nop 15\n\ts_nop 7":"+v"(pA0),"+v"(pA1));CMASK(pA0,pA1,0);
  START(pA0,pA1);
  _Pragma("unroll") for(int r=0;r<16;++r)pA1[r]=__builtin_amdgcn_exp2f(pA1[r]);
  WAIT_BAR(0);
  DMA_K(3,0);DMA_V(1,SLOTB);
  ROT();
  kload8(kf,kp0+sl_cur);
  bf16x8 qa=QL(0), qb=QL(1);
  WAIT_BAR(3);
  s16x4 val,vah,vbl,vbh,vcl,vch,vdl,vdh; u32x4 pw0,pw1,pw2,pw3;
  #define PKW(P,B) cvtpk_s(P[B],P[B+1])
  #define PAF(k) __builtin_bit_cast(bf16x8,pw##k)
  #define PIN(x) asm volatile("":"+v"(x))
  #define MX3(a,b,c) __builtin_fmaxf(__builtin_fmaxf((a),(b)),(c))
  #define GAPA(MF,A0,A1,A2,A3,W0,W1,PW) do{ MF; sacc+=A0; sacc+=A1; sacc+=A2; sacc+=A3; PIN(sacc); W0; W1; PIN(PW); SBAR(); }while(0)
  #define EX(v) __builtin_amdgcn_exp2f(v)
  #define GAPB(MF,X,B) do{ MF; X[B]=EX(X[B]); X[B+1]=EX(X[B+1]); PIN(X); SBAR(); }while(0)
  #define VADDR(n) ((((n)&3)*4096)+(((n)>>2)*1024))
  #define VLD(S,n) do{ S##l=vtr(vp_+VADDR(n)); S##h=vtr(vp_+VADDR(n)+512); SBAR(); }while(0)
  #define VFRS(S) (bf16x8){S##l[0],S##l[1],S##l[2],S##l[3],S##h[0],S##h[1],S##h[2],S##h[3]}
  #define MF32(A,B,C) __builtin_amdgcn_mfma_f32_32x32x16_bf16(A,B,C,0,0,0)
  #define KRD(G,j) do{ if(G){ kload2(kf,kp0+sl_next,j); SBAR(); } }while(0)
  #define STEP(C0,C1,P0,P1,t,GK,GV,GL) do{ SBAR(); \
    const lds_cptr vp_=vp0+2*sl_prev; \
    float sacc=(P0[0]+P0[1]); \
    GAPA(C0=MF32(kf[0],qa,negm), P0[2],P0[3],P0[4],P0[5],     pw0[0]=PKW(P0,0), pw0[1]=PKW(P0,2), pw0); \
    GAPA(C1=MF32(kf[1],qa,negm), P0[6],P0[7],P0[8],P0[9],     pw0[2]=PKW(P0,4), pw0[3]=PKW(P0,6), pw0); \
    qa=QL(2); SBAR(); GAPA(C0=MF32(kf[2],qb,C0),     P0[10],P0[11],P0[12],P0[13], pw1[0]=PKW(P0,8), pw1[1]=PKW(P0,10), pw1); \
    GAPA(C1=MF32(kf[3],qb,C1),     P0[14],P0[15],P1[0],P1[1],   pw1[2]=PKW(P0,12),pw1[3]=PKW(P0,14), pw1); \
    qb=QL(3); SBAR(); GAPA(C0=MF32(kf[4],qa,C0),     P1[2],P1[3],P1[4],P1[5],     pw2[0]=PKW(P1,0), pw2[1]=PKW(P1,2), pw2); \
    GAPA(C1=MF32(kf[5],qa,C1),     P1[6],P1[7],P1[8],P1[9],     pw2[2]=PKW(P1,4), pw2[3]=PKW(P1,6), pw2); \
    GAPA(C0=MF32(kf[6],qb,C0),     P1[10],P1[11],P1[12],P1[13], pw3[0]=PKW(P1,8), pw3[1]=PKW(P1,10), pw3); \
    GAPA(C1=MF32(kf[7],qb,C1),     P1[14],P1[15],0.f,0.f,       pw3[2]=PKW(P1,12),pw3[3]=PKW(P1,14), pw3); \
    l_reg+=sacc; \
    VLD(va,0); VLD(vb,1); VLD(vc,2); \
    if(GK){DMA_K((t)+3,sl_cur);} if(GV){DMA_V((t)+1,sl_next);} \
    CMASK(C0,C1,t); \
    { float a=MX3(C0[0],C0[1],C1[0]),b=MX3(C0[2],C0[3],C1[1]); a=MX3(a,C1[2],C1[3]); \
      _Pragma("unroll") for(int r=4;r<16;r+=4){a=MX3(a,C0[r],C0[r+1]);b=MX3(b,C0[r+2],C0[r+3]);a=MX3(a,C1[r],C1[r+1]);b=MX3(b,C1[r+2],C1[r+3]);} \
      float rm=__builtin_fmaxf(a,b); { auto rr=__builtin_amdgcn_permlane32_swap(__float_as_uint(rm),__float_as_uint(rm),false,false); rm=__builtin_fmaxf(__uint_as_float(rr[0]),__uint_as_float(rr[1])); } \
      resc=false; \
      if(__builtin_expect(__any(rm>(float)THRL),0)){ const float dl=__builtin_fmaxf(rm,0.f); mhat+=dl; \
        _Pragma("unroll") for(int r=0;r<16;++r){C0[r]-=dl;C1[r]-=dl;} \
        _Pragma("unroll") for(int r=0;r<16;++r)negm[r]=-mhat; asm volatile("":"+v"(negm)); \
        const float f=__builtin_amdgcn_exp2f(-dl); l_reg*=f; if(hi==0)wsf[r32]=f; resc=true; } } \
    SBAR(); \
    VLD(vd,3); GAPB(o[0]=MF32(PAF(0),VFRS(va),o[0]), C0,0); \
    VLD(va,4); GAPB(o[1]=MF32(PAF(0),VFRS(vb),o[1]), C0,2); \
    VLD(vb,5); GAPB(o[2]=MF32(PAF(0),VFRS(vc),o[2]), C0,4); \
    VLD(vc,6); GAPB(o[3]=MF32(PAF(0),VFRS(vd),o[3]), C0,6); \
    VLD(vd,7); KRD(GL,0); GAPB(o[0]=MF32(PAF(1),VFRS(va),o[0]), C0,8); \
    VLD(va,8); KRD(GL,1); GAPB(o[1]=MF32(PAF(1),VFRS(vb),o[1]), C0,10); \
    VLD(vb,9); KRD(GL,2); GAPB(o[2]=MF32(PAF(1),VFRS(vc),o[2]), C0,12); \
    VLD(vc,10); KRD(GL,3); GAPB(o[3]=MF32(PAF(1),VFRS(vd),o[3]), C0,14); \
    VLD(vd,11); GAPB(o[0]=MF32(PAF(2),VFRS(va),o[0]), C1,0); \
    VLD(va,12); GAPB(o[1]=MF32(PAF(2),VFRS(vb),o[1]), C1,2); \
    VLD(vb,13); GAPB(o[2]=MF32(PAF(2),VFRS(vc),o[2]), C1,4); \
    VLD(vc,14); GAPB(o[3]=MF32(PAF(2),VFRS(vd),o[3]), C1,6); \
    VLD(vd,15); GAPB(o[0]=MF32(PAF(3),VFRS(va),o[0]), C1,8); \
    GAPB(o[1]=MF32(PAF(3),VFRS(vb),o[1]), C1,10); \
    GAPB(o[2]=MF32(PAF(3),VFRS(vc),o[2]), C1,12); \
    GAPB(o[3]=MF32(PAF(3),VFRS(vd),o[3]), C1,14); \
    qa=QL(0); qb=QL(1);   \
    }while(0)
  int t=1;
  #undef CMASK
  #define CMASK(P0,P1,t) do{}while(0)
  for(;t+5<NT;t+=2){
    STEP(pB0,pB1,pA0,pA1,t,true,true,true);     WAIT_BAR(3); RESC(); ROT();
    STEP(pA0,pA1,pB0,pB1,t+1,true,true,true);   WAIT_BAR(3); RESC(); ROT();
  }
  #undef CMASK
  #define CMASK(P0,P1,t) do{int jb_=(t)-(NT-4); if(jb_>=0)cmask(P0,P1,jb_,qrel,hi);}while(0)
  #define ENDW(tt) do{ if((tt)+3<NT){WAIT_BAR(3);} else if((tt)+2<NT){WAIT_BAR(2);} else {WAIT_BAR(0);} }while(0)
  for(;t+1<NT;t+=2){
    STEP(pB0,pB1,pA0,pA1,t,(t+3<NT),(t+1<NT),(t+1<NT));       ENDW(t);   RESC(); ROT();
    STEP(pA0,pA1,pB0,pB1,t+1,(t+4<NT),(t+2<NT),(t+2<NT));     ENDW(t+1); RESC(); ROT();
  }
  STEP(pB0,pB1,pA0,pA1,NT-1,false,false,false); RESC();
  { float sacc=pB0[0]+pB0[1]; _Pragma("unroll") for(int r=2;r<16;++r)sacc+=pB0[r]; _Pragma("unroll") for(int r=0;r<16;++r)sacc+=pB1[r]; l_reg+=sacc;
    pw0=(u32x4){PKW(pB0,0),PKW(pB0,2),PKW(pB0,4),PKW(pB0,6)};pw1=(u32x4){PKW(pB0,8),PKW(pB0,10),PKW(pB0,12),PKW(pB0,14)};pw2=(u32x4){PKW(pB1,0),PKW(pB1,2),PKW(pB1,4),PKW(pB1,6)};pw3=(u32x4){PKW(pB1,8),PKW(pB1,10),PKW(pB1,12),PKW(pB1,14)};
    SBAR(); pv128(o,vb0+2*sl_cur,PAF(0),PAF(1),PAF(2),PAF(3)); }
  #undef PKW
  #undef PAF
  #undef QL
  #undef VADDR
  #undef VLD
  #undef VFRS
  #undef MF32
  #undef PIN
  #undef MX3
  #undef GAPA
  #undef GAPB
  #undef EX
  #undef KRD
  #undef STEP
  #undef ENDW
  {auto rr=__builtin_amdgcn_permlane32_swap(__float_as_uint(l_reg),__float_as_uint(l_reg),false,false);l_reg=__uint_as_float(rr[0])+__uint_as_float(rr[1]);}
  if(hi==0)wsf[32+r32]=l_reg;asm volatile("s_waitcnt lgkmcnt(0)":::"memory");
  float rli[16];
  #pragma unroll
  for(int r=0;r<16;++r)rli[r]=__builtin_amdgcn_rcpf(wsf[32+crow(r,hi)]);
  bf16*Ow=Ou+(long)(wid*QBLK)*PO;
  { bf16*stg=(bf16*)(shm+L2_OST)+wid*2048;
    #pragma unroll
    for(int hp=0;hp<2;++hp){
      #pragma unroll
      for(int r=0;r<16;++r){const int orow=crow(r,hi);
        #pragma unroll
        for(int d0=0;d0<2;++d0)stg[orow*64+d0*32+r32]=__float2bfloat16(o[hp*2+d0][r]*rli[r]);}
      asm volatile("s_waitcnt lgkmcnt(0)":::"memory");
      #pragma unroll
      for(int i=0;i<4;++i){const int row=i*8+(lane>>3),ch=lane&7; const u32x4 v=*(const u32x4*)(stg+row*64+ch*8); *(__attribute__((address_space(1))) u32x4*)(Ow+(long)row*PO+hp*64+ch*8)=v;}
      asm volatile("s_waitcnt lgkmcnt(0)":::"memory");
    } }
  asm volatile("s_waitcnt lgkmcnt(0)\n\ts_barrier":::"memory");
  #undef DMA_K
  #undef DMA_V
  #undef CMASK
  #undef START
  #undef RESC
  #undef ROT
}
constexpr int ATTN_LDS_BYTES=LDS_BYTES;
#undef SBAR
#undef WAIT_BAR
}

#ifndef MK_MULTI
#define MK_MULTI 0
#endif
#ifndef REP_GEMM
#define REP_GEMM 1
#endif
#ifndef REP_ATTN
#define REP_ATTN 1
#endif
#ifndef REP_LIGHT
#define REP_LIGHT 1
#endif
#define LAS __attribute__((address_space(3)))
typedef unsigned short bf16;
typedef float f32x4 __attribute__((ext_vector_type(4)));
typedef unsigned u32x4 __attribute__((ext_vector_type(4)));
typedef unsigned u32x2 __attribute__((ext_vector_type(2)));
typedef short bf16x8 __attribute__((ext_vector_type(8)));
using pg8::cvt_pk_bf16;

constexpr int DM = 1024, NB = 4, SEQ = 8192, T = NB * SEQ, DEPTH = 2;
constexpr int NIN = 8704, NPROJ = 5632, NGATE = 3072;
constexpr float EPS = 1e-6f;
constexpr float C2 = 0.18033688011112042f;
__device__ const float LG2[4] = {-0.04580368961312479f, -0.02272007650008353f, -0.011315313227834146f, -0.005646563141142063f};
__device__ const float INV_A[8] = {1.0f, 0.19392274474868576f, 0.03760603093086393f, 0.007292664737217109f, 0.001414213562373095f, 0.0002742481756762073f, 5.318295896944988e-05f, 1.031338537721246e-05f};
__device__ const float INV_R[32] = {1.0f, 0.7429639507594948f, 0.551995432128157f, 0.41011270705513014f, 0.30469895709035083f, 0.22638034095214482f, 0.16819243248808696f, 0.1249609141291987f,
    0.09284145445194744f, 0.06897785379387654f, 0.05124805876960934f, 0.038075460212223716f, 0.028288694346259694f, 0.021017480113324882f, 0.015615230060004972f, 0.011601553017399714f,
    0.008619535664753033f, 0.006404004271197283f, 0.004757944314009409f, 0.0035349811050301057f, 0.0026263635276533325f, 0.0019512934226359642f, 0.0014497406703726315f, 0.001077105056036769f,
    0.0008002502278161052f, 0.0005945570708544394f, 0.00044173447031400687f, 0.0003281927872511474f, 0.0002438354098268829f, 0.00018116091942004152f, 0.00013459603241553644f, 0.0001f};

constexpr size_t MiB = 1u << 20;
constexpr size_t WS_WIN = 2 * MiB;
constexpr size_t WIN_L = (size_t)NIN * DM * 2;
constexpr size_t WS_WBR = 36 * MiB;
constexpr size_t WBR_L = (size_t)3 * DM * 512 * 2;
constexpr size_t WS_WOUT = 42 * MiB;
constexpr size_t WOUT_L = (size_t)DM * DM * 2;
constexpr size_t WS_ROPEA = 46 * MiB;
constexpr size_t WS_ROPER = 46 * MiB + 512 * 1024;
constexpr size_t WS_SSQ = 49 * MiB;
constexpr size_t WS_RSTD = 51 * MiB;
constexpr size_t WS_XB = 52 * MiB;
constexpr size_t WS_PREVT = 116 * MiB;
constexpr size_t WS_ACT = 148 * MiB;
constexpr size_t SEG512 = (size_t)T * 512 * 2;
constexpr size_t WS_QA = WS_ACT, WS_KA = WS_QA + SEG512, WS_VA = WS_KA + SEG512, WS_CX = WS_VA + SEG512, WS_CC = WS_CX + SEG512, WS_SCZ = WS_CC + SEG512,
                 WS_SZA = WS_SCZ + SEG512, WS_CB = WS_SZA + SEG512, WS_RQ = WS_CB + SEG512, WS_RK = WS_RQ + SEG512 / 2, WS_RV = WS_RK + SEG512 / 2, WS_SRZ = WS_RV + SEG512,
                 WS_END = WS_SRZ + SEG512;
constexpr size_t WS_G = WS_QA;
constexpr size_t WS_MERGED = WS_RQ;
constexpr size_t WS_KV = WS_CC;
constexpr size_t WS_OTMP = WS_CX;
static_assert(WS_END == 500 * MiB, "ws map");
constexpr int LDS_BYTES = 147456;
constexpr int NWAVES = 8;

__device__ __forceinline__ int orig_col(int p) {
    if (p < 1024) { int d = p & 63; if (d < 16) { const int blk = d >> 3, half = (d >> 2) & 1, e = d & 3; d = half * 8 + blk * 4 + e; } return (p & ~63) | d; }
    if (p >= 2048 && p < 4096) { const int r = p & 255; return 2048 + 512 * (r >> 6) + 64 * ((p - 2048) >> 8) + (r & 63); }
    if (p >= 4096 && p < 4608) { const int d = p & 63, blk = d >> 3, half = (d >> 2) & 1, e = d & 3; return (p & ~63) | (half * 32 + blk * 4 + e); }
    return p;
}
__device__ __forceinline__ float wave_sum(float v) {
#pragma unroll
    for (int o = 1; o < 64; o <<= 1) v += __shfl_xor(v, o);
    return v;
}
__device__ __forceinline__ float bf2f(unsigned short b) { return __uint_as_float((unsigned)b << 16); }
__device__ __forceinline__ float bflo(unsigned w) { return __uint_as_float(w << 16); }
__device__ __forceinline__ float bfhi(unsigned w) { return __uint_as_float(w & 0xffff0000u); }
__device__ __forceinline__ float sigmoidf_(float x) { return __builtin_amdgcn_rcpf(1.0f + __builtin_amdgcn_exp2f(-1.4426950408889634f * x)); }
__device__ __forceinline__ float siluf_(float x) { return x * sigmoidf_(x); }

__device__ __forceinline__ void unpack8(const u32x4 a, float (&o)[8]) { o[0] = bflo(a.x); o[1] = bfhi(a.x); o[2] = bflo(a.y); o[3] = bfhi(a.y); o[4] = bflo(a.z); o[5] = bfhi(a.z); o[6] = bflo(a.w); o[7] = bfhi(a.w); }
#define GAS __attribute__((address_space(1)))
#define EPI_FENCE() asm volatile("" ::: "memory")
__device__ __forceinline__ float ssq_sum(const f32x4 s0, const f32x4 s1, const f32x4 s2, const f32x4 s3) {
    return ((s0[0] + s0[1]) + (s0[2] + s0[3])) + ((s1[0] + s1[1]) + (s1[2] + s1[3])) + ((s2[0] + s2[1]) + (s2[2] + s2[3])) + ((s3[0] + s3[1]) + (s3[2] + s3[3]));
}
struct EpiProj {
    static constexpr bool PERM = true, AFTER_DRAIN = false;
    unsigned char* ws; const float* rstd; const float2* ropeA; const float2* ropeR;
    __device__ __forceinline__ bool keep(const pg8::Unit&) const { return false; }
    __device__ __forceinline__ void operator()(f32x4 (&acc)[2][2][4][2], const pg8::Unit& u, int wr, int wc, int fr, int fq) const {
        const int pn = u.pn;
        const int row0 = u.pm * 256 + wr * 64 + fr;
        if (pn >= 8 && pn < 16) {
            const bool isu = wc < 2;
            bf16* dstc = (bf16*)(ws + (isu ? WS_CX : WS_CB)) + (pn - 8) * 64 + (wc & 1) * 32 + 8 * fq;
            float rsv[8];
#pragma unroll
            for (int it = 0; it < 8; ++it) rsv[it] = ((const GAS float*)rstd)[row0 + (it >> 2) * 128 + (it & 3) * 16];
            EPI_FENCE();
#pragma unroll
            for (int it = 0; it < 8; ++it) {
                const int ai = it >> 2, m = it & 3, row = row0 + ai * 128 + m * 16;
                const float rs = rsv[it];
                f32x4 a0 = acc[ai][0][m][0] * rs, a1 = acc[ai][0][m][1] * rs, b0 = acc[ai][1][m][0] * rs, b1 = acc[ai][1][m][1] * rs;
                if (!isu) {
#pragma unroll
                    for (int e = 0; e < 4; ++e) { b0[e] = siluf_(b0[e]); b1[e] = siluf_(b1[e]); }
                }
                a0 = a0 * b0; a1 = a1 * b1;
                u32x4 w; w.x = cvt_pk_bf16(a0[0], a0[1]); w.y = cvt_pk_bf16(a0[2], a0[3]); w.z = cvt_pk_bf16(a1[0], a1[1]); w.w = cvt_pk_bf16(a1[2], a1[3]);
                *(GAS u32x4*)(dstc + (size_t)row * 512) = w;
            }
            return;
        }
        int seg, lt;
        if (pn < 16) { seg = pn >> 1; lt = pn & 1; } else if (pn < 18) { seg = 8 + (pn - 16); lt = 0; } else { seg = 10 + ((pn - 18) >> 1); lt = (pn - 18) & 1; }
        size_t off; int pitch = 512;
        switch (seg) {
            case 0: off = WS_QA; break; case 1: off = WS_KA; break; case 2: off = WS_VA; break; case 3: off = WS_SZA; break;
            case 8: off = WS_RQ; pitch = 256; break; case 9: off = WS_RK; pitch = 256; break; case 10: off = WS_RV; break; default: off = WS_SRZ; break;
        }
        bf16* dst = (bf16*)(ws + off);
        const int lc0 = lt * 256 + wc * 32 + 8 * fq;
        const int ropemode = (seg <= 1) ? (((wc & 1) == 0 && fq < 2) ? 1 : 0) : ((seg == 8 || seg == 9) ? 2 : 0);
        const bool dosilu = (seg == 3 || seg == 11);
        const float scale = (seg == 0) ? C2 : ((seg == 9) ? 0.125f : 1.0f);
        const float* ropebase = (ropemode == 1) ? (const float*)(ropeA + 4 * fq) : (const float*)(ropeR + (4 * (wc & 1) + fq) * 4);
        const int ropepitch = (ropemode == 1) ? 16 : 64;
        f32x4 cr0 = (f32x4){0.f, 0.f, 0.f, 0.f}, cr1 = cr0;
        float rsv[8];
#pragma unroll
        for (int it = 0; it < 8; ++it) rsv[it] = ((const GAS float*)rstd)[row0 + (it >> 2) * 128 + (it & 3) * 16];
        { if (ropemode) { const GAS f32x4* rp = (const GAS f32x4*)(ropebase + (size_t)(row0 & (SEQ - 1)) * ropepitch); cr0 = rp[0]; cr1 = rp[1]; } }
#pragma unroll
        for (int it = 0; it < 8; ++it) {
            const int ai = it >> 2, m = it & 3, row = row0 + ai * 128 + m * 16;
            f32x4 nr0 = cr0, nr1 = cr1;
            if (it < 7) { const int rn = row0 + ((it + 1) >> 2) * 128 + ((it + 1) & 3) * 16;
                if (ropemode) { const GAS f32x4* rp = (const GAS f32x4*)(ropebase + (size_t)(rn & (SEQ - 1)) * ropepitch); nr0 = rp[0]; nr1 = rp[1]; } }
            EPI_FENCE();
            const float rs = rsv[it] * scale;
#pragma unroll
            for (int bj = 0; bj < 2; ++bj) {
                f32x4 v0 = acc[ai][bj][m][0] * rs, v1 = acc[ai][bj][m][1] * rs;
                if (ropemode) {
                    const float cs[8] = {cr0[0], cr0[1], cr0[2], cr0[3], cr1[0], cr1[1], cr1[2], cr1[3]};
#pragma unroll
                    for (int e = 0; e < 4; ++e) { const float c = cs[2 * e], s = cs[2 * e + 1], x1 = v0[e], x2 = v1[e]; v0[e] = x1 * c - x2 * s; v1[e] = x2 * c + x1 * s; }
                }
                if (dosilu) {
#pragma unroll
                    for (int e = 0; e < 4; ++e) { v0[e] = siluf_(v0[e]); v1[e] = siluf_(v1[e]); }
                }
                u32x4 w; w.x = cvt_pk_bf16(v0[0], v0[1]); w.y = cvt_pk_bf16(v0[2], v0[3]); w.z = cvt_pk_bf16(v1[0], v1[1]); w.w = cvt_pk_bf16(v1[2], v1[3]);
                *(GAS u32x4*)(dst + (size_t)row * pitch + lc0 + bj * 128) = w;
            }
            cr0 = nr0; cr1 = nr1;
        }
    }
};
struct EpiGate {
    static constexpr bool PERM = true, AFTER_DRAIN = false;
    bf16* G; const float* rstd;
    __device__ __forceinline__ bool keep(const pg8::Unit&) const { return false; }
    __device__ __forceinline__ void operator()(f32x4 (&acc)[2][2][4][2], const pg8::Unit& u, int wr, int wc, int fr, int fq) const {
        const int col0 = u.pn * 256 + wc * 32 + 8 * fq, row0 = u.pm * 256 + wr * 64 + fr;
        float rsv[8];
#pragma unroll
        for (int it = 0; it < 8; ++it) rsv[it] = ((const GAS float*)rstd)[row0 + (it >> 2) * 128 + (it & 3) * 16] * -1.4426950408889634f;
        EPI_FENCE();
#pragma unroll
        for (int it = 0; it < 8; ++it) {
            const int ai = it >> 2, m = it & 3, row = row0 + ai * 128 + m * 16;
            const float rs = rsv[it];
#pragma unroll
            for (int bj = 0; bj < 2; ++bj) {
                f32x4 v0 = acc[ai][bj][m][0] * rs, v1 = acc[ai][bj][m][1] * rs;
#pragma unroll
                for (int e = 0; e < 4; ++e) { v0[e] = fmaxf(__builtin_amdgcn_rcpf(1.0f + __builtin_amdgcn_exp2f(v0[e])), 1e-30f); v1[e] = fmaxf(__builtin_amdgcn_rcpf(1.0f + __builtin_amdgcn_exp2f(v1[e])), 1e-30f); }
                u32x4 w; w.x = cvt_pk_bf16(v0[0], v0[1]); w.y = cvt_pk_bf16(v0[2], v0[3]); w.z = cvt_pk_bf16(v1[0], v1[1]); w.w = cvt_pk_bf16(v1[2], v1[3]);
                *(GAS u32x4*)(G + (size_t)row * NGATE + col0 + bj * 128) = w;
            }
        }
    }
};
struct EpiChain {
    static constexpr bool PERM = true, AFTER_DRAIN = false;
    const bf16* G; bf16* out;
    __device__ __forceinline__ bool keep(const pg8::Unit& u) const { return u.seg != 2; }
    __device__ __forceinline__ void operator()(f32x4 (&acc)[2][2][4][2], const pg8::Unit& u, int wr, int wc, int fr, int fq) const {
        const int col0 = u.pn * 256 + wc * 32 + 8 * fq, row0 = u.pm * 256 + wr * 64 + fr;
        const int seg = u.seg;
        const bf16* gbase = G + seg * DM + col0;
        u32x4 ga[2], gb[2];
#pragma unroll
        for (int bj = 0; bj < 2; ++bj) { const bf16* gp = gbase + (size_t)row0 * NGATE + bj * 128; ga[bj] = *(const GAS u32x4*)gp; gb[bj] = ga[bj]; if (seg != 2) gb[bj] = *(const GAS u32x4*)(gp + DM); }
#pragma unroll
        for (int it = 0; it < 8; ++it) {
            const int ai = it >> 2, m = it & 3, row = row0 + ai * 128 + m * 16;
            u32x4 na[2] = {ga[0], ga[1]}, nb[2] = {gb[0], gb[1]};
            if (it < 7) { const int rn = row0 + ((it + 1) >> 2) * 128 + ((it + 1) & 3) * 16;
#pragma unroll
                for (int bj = 0; bj < 2; ++bj) { const bf16* gp = gbase + (size_t)rn * NGATE + bj * 128; na[bj] = *(const GAS u32x4*)gp; nb[bj] = na[bj]; if (seg != 2) nb[bj] = *(const GAS u32x4*)(gp + DM); } }
            EPI_FENCE();
#pragma unroll
            for (int bj = 0; bj < 2; ++bj) {
                float f[8]; unpack8(ga[bj], f);
                if (seg != 2) {
                    float h[8]; unpack8(gb[bj], h);
#pragma unroll
                    for (int e = 0; e < 8; ++e) f[e] = f[e] * __builtin_amdgcn_rcpf(h[e]);
                }
                f32x4 v0 = acc[ai][bj][m][0], v1 = acc[ai][bj][m][1];
#pragma unroll
                for (int e = 0; e < 4; ++e) { v0[e] *= f[e]; v1[e] *= f[4 + e]; }
                if (seg != 2) { acc[ai][bj][m][0] = v0; acc[ai][bj][m][1] = v1; }
                else {
                    u32x4 w; w.x = cvt_pk_bf16(v0[0], v0[1]); w.y = cvt_pk_bf16(v0[2], v0[3]); w.z = cvt_pk_bf16(v1[0], v1[1]); w.w = cvt_pk_bf16(v1[2], v1[3]);
                    *(GAS u32x4*)(out + (size_t)row * DM + col0 + bj * 128) = w;
                }
            }
            ga[0] = na[0]; ga[1] = na[1]; gb[0] = nb[0]; gb[1] = nb[1];
        }
    }
};
struct ChainOrder {
    pg8::StaticOrder S;
    __device__ bool next(int i, pg8::Unit& u) const { if (!S.next(i / 3, u)) return false; u.seg = i % 3; return true; }
    __device__ __forceinline__ void a_ready(const pg8::Unit&) const {}
    __device__ __forceinline__ void done(const pg8::Unit&) const {}
};
template <bool LAST> struct EpiOutT {
    static constexpr bool PERM = true, AFTER_DRAIN = false;
    const float* xres; const bf16* xbres; float* xout; bf16* xb; float* ssq;
    __device__ __forceinline__ bool keep(const pg8::Unit&) const { return false; }
    __device__ __forceinline__ void operator()(f32x4 (&acc)[2][2][4][2], const pg8::Unit& u, int wr, int wc, int fr, int fq) const {
        const int col0 = u.pn * 256 + wc * 32 + 8 * fq, row0 = u.pm * 256 + wr * 64 + fr;
        f32x4 r[4]; u32x4 rb[2];
#pragma unroll
        for (int bj = 0; bj < 2; ++bj) {
            if (LAST) rb[bj] = *(const GAS u32x4*)(xbres + (size_t)row0 * DM + col0 + bj * 128);
            else { const float* p = xres + (size_t)row0 * DM + col0 + bj * 128; r[2 * bj] = *(const GAS f32x4*)p; r[2 * bj + 1] = *(const GAS f32x4*)(p + 4); } }
#pragma unroll
        for (int it = 0; it < 8; ++it) {
            const int ai = it >> 2, m = it & 3, row = row0 + ai * 128 + m * 16;
            f32x4 nr[4] = {r[0], r[1], r[2], r[3]}; u32x4 nrb[2] = {rb[0], rb[1]};
            if (it < 7) { const int rn = row0 + ((it + 1) >> 2) * 128 + ((it + 1) & 3) * 16;
#pragma unroll
                for (int bj = 0; bj < 2; ++bj) {
                    if (LAST) nrb[bj] = *(const GAS u32x4*)(xbres + (size_t)rn * DM + col0 + bj * 128);
                    else { const float* p = xres + (size_t)rn * DM + col0 + bj * 128; nr[2 * bj] = *(const GAS f32x4*)p; nr[2 * bj + 1] = *(const GAS f32x4*)(p + 4); } } }
            EPI_FENCE();
            float q = 0.f;
#pragma unroll
            for (int bj = 0; bj < 2; ++bj) {
                const size_t o = (size_t)row * DM + col0 + bj * 128;
                f32x4 r0, r1;
                if (LAST) { r0 = (f32x4){bflo(rb[bj].x), bfhi(rb[bj].x), bflo(rb[bj].y), bfhi(rb[bj].y)}; r1 = (f32x4){bflo(rb[bj].z), bfhi(rb[bj].z), bflo(rb[bj].w), bfhi(rb[bj].w)}; }
                else { r0 = r[2 * bj]; r1 = r[2 * bj + 1]; }
                const f32x4 v0 = acc[ai][bj][m][0] + r0, v1 = acc[ai][bj][m][1] + r1;
                q += ((v0[0] * v0[0] + v0[1] * v0[1]) + (v0[2] * v0[2] + v0[3] * v0[3])) + ((v1[0] * v1[0] + v1[1] * v1[1]) + (v1[2] * v1[2] + v1[3] * v1[3]));
                if (LAST) { *(GAS f32x4*)(xout + o) = v0; *(GAS f32x4*)(xout + o + 4) = v1; }
                else { u32x4 w; w.x = cvt_pk_bf16(v0[0], v0[1]); w.y = cvt_pk_bf16(v0[2], v0[3]); w.z = cvt_pk_bf16(v1[0], v1[1]); w.w = cvt_pk_bf16(v1[2], v1[3]);
                    *(GAS u32x4*)(xb + o) = w; }
            }
            q += __shfl_xor(q, 16); q += __shfl_xor(q, 32);
            if (fq == 0) ((GAS float*)ssq)[(size_t)row * 16 + u.pn * 4 + wc] = q;
            r[0] = nr[0]; r[1] = nr[1]; r[2] = nr[2]; r[3] = nr[3]; rb[0] = nrb[0]; rb[1] = nrb[1];
        }
    }
};

template <bool PERMUTE>
__device__ __forceinline__ void p0_transpose_item(const float* W, int K, int N, bf16* WT, const float* gk, LAS float* scr, int item, int lane) {
    const int nblk = N / 32, kb = item / nblk, nb = item % nblk, k0 = 64 * kb, n0 = 32 * nb;
    const int kr = lane >> 3, c4 = lane & 7;
    const int nsrc = PERMUTE ? orig_col(n0 + 4 * c4) : (n0 + 4 * c4);
    f32x4 wv[8];
#pragma unroll
    for (int i = 0; i < 8; ++i) wv[i] = *(const GAS f32x4*)(W + (size_t)(k0 + 8 * i + kr) * N + nsrc);
#pragma unroll
    for (int i = 0; i < 8; ++i) { const int kk = 8 * i + kr; f32x4 v = wv[i]; if (gk) v = v * gk[k0 + kk];
        LAS float* d = scr + kk * 33 + 4 * c4; d[0] = v[0]; d[1] = v[1]; d[2] = v[2]; d[3] = v[3]; }
    asm volatile("s_waitcnt lgkmcnt(0)" ::: "memory");
    const int c = lane & 7;
#pragma unroll
    for (int j = 0; j < 4; ++j) { const int n = (lane >> 3) + 8 * j; const LAS float* s = scr + (8 * c) * 33 + n;
        u32x4 o; o.x = cvt_pk_bf16(s[0 * 33], s[1 * 33]); o.y = cvt_pk_bf16(s[2 * 33], s[3 * 33]); o.z = cvt_pk_bf16(s[4 * 33], s[5 * 33]); o.w = cvt_pk_bf16(s[6 * 33], s[7 * 33]);
        *(GAS u32x4*)(WT + (size_t)(n0 + n) * K + k0 + 8 * c) = o; }
    asm volatile("s_waitcnt lgkmcnt(0)" ::: "memory");
}

struct Args { const float* in[9]; float* out; unsigned char* ws; int ph_lo, ph_hi; };

__device__ __forceinline__ void phase_prologue(const Args& a, LAS unsigned char* lds, int vcu, int G, int wave, int lane) {
    unsigned char* ws = a.ws;
    LAS float* scr = (LAS float*)(lds + wave * 16384);
    const int gw = vcu * NWAVES + wave, NGW = G * NWAVES;
    constexpr int I_IN = (DM / 64) * (NIN / 32), I_BR = (512 / 64) * (DM / 32), I_OUT = (DM / 64) * (DM / 32), I_L = I_IN + 3 * I_BR + I_OUT;
    for (int it = gw; it < DEPTH * I_L; it += NGW) {
        const int l = it / I_L; int r = it % I_L;
        if (r < I_IN) { p0_transpose_item<true>(a.in[2] + (size_t)l * DM * NIN, DM, NIN, (bf16*)(ws + WS_WIN + l * WIN_L), a.in[1] + l * DM, scr, r, lane); continue; } r -= I_IN;
        if (r < 3 * I_BR) { const int i = r / I_BR; p0_transpose_item<false>(a.in[6] + ((size_t)l * 3 + i) * 512 * DM, 512, DM, (bf16*)(ws + WS_WBR + l * WBR_L) + (size_t)i * DM * 512, nullptr, scr, r % I_BR, lane); continue; } r -= 3 * I_BR;
        p0_transpose_item<false>(a.in[7] + (size_t)l * DM * DM, DM, DM, (bf16*)(ws + WS_WOUT + l * WOUT_L), nullptr, scr, r, lane);
    }
    const float* x = a.in[0]; bf16* xb = (bf16*)(ws + WS_XB); float* ssq = (float*)(ws + WS_SSQ);
    for (int m0 = gw * 4; m0 < T; m0 += NGW * 4) {
        f32x4 v[4][4];
#pragma unroll
        for (int r = 0; r < 4; ++r) { const GAS f32x4* xr = (const GAS f32x4*)(x + (size_t)(m0 + r) * DM) + lane;
#pragma unroll
            for (int j = 0; j < 4; ++j) v[r][j] = xr[64 * j]; }
#pragma unroll
        for (int r = 0; r < 4; ++r) {
            float s = 0.f;
#pragma unroll
            for (int j = 0; j < 4; ++j) s += (v[r][j][0] * v[r][j][0] + v[r][j][1] * v[r][j][1]) + (v[r][j][2] * v[r][j][2] + v[r][j][3] * v[r][j][3]);
            s = wave_sum(s);
            GAS u32x2* o8 = (GAS u32x2*)(xb + (size_t)(m0 + r) * DM) + lane;
#pragma unroll
            for (int j = 0; j < 4; ++j) { u32x2 w; w.x = cvt_pk_bf16(v[r][j][0], v[r][j][1]); w.y = cvt_pk_bf16(v[r][j][2], v[r][j][3]); o8[64 * j] = w; }
            if (lane == 0) ((GAS float*)(ws + WS_RSTD))[m0 + r] = __builtin_amdgcn_rsqf(s * (1.0f / DM) + EPS);
        }
    }
    float2* ropeA = (float2*)(ws + WS_ROPEA); float2* ropeR = (float2*)(ws + WS_ROPER);
    const int gt = gw * 64 + lane, NT_ = NGW * 64;
    for (int i = gt; i < SEQ * 40; i += NT_) {
        float inv; float2* dst;
        if (i < SEQ * 8) { inv = INV_A[i & 7]; dst = ropeA + i; } else { const int k = i - SEQ * 8; inv = INV_R[k & 31]; dst = ropeR + k; }
        const int pos = (i < SEQ * 8) ? (i >> 3) : ((i - SEQ * 8) >> 5);
        const float ang = (float)pos * inv;
        double rev = (double)ang * 0.15915494309189533577; rev -= __builtin_rint(rev);
        const float rf = (float)rev;
        { typedef float f32x2v __attribute__((ext_vector_type(2))); *(GAS f32x2v*)dst = (f32x2v){__builtin_amdgcn_cosf(rf), __builtin_amdgcn_sinf(rf)}; }
    }
}

__device__ __forceinline__ void conv_item(unsigned char* ws, const float* cw, int item, int tid) {
    const bf16* U = (const bf16*)(ws + WS_CX); bf16* GB = (bf16*)(ws + WS_CB);
    const int ch = (tid & 63) * 8, t0 = item * 64 + (tid >> 6) * 8;
    float w0[8], w1[8], w2[8];
#pragma unroll
    for (int e = 0; e < 8; ++e) { w0[e] = cw[ch + e]; w1[e] = cw[512 + ch + e]; w2[e] = cw[1024 + ch + e]; }
    float um2[8], um1[8];
#pragma unroll
    for (int e = 0; e < 8; ++e) { um2[e] = 0.f; um1[e] = 0.f; }
    if ((t0 & (SEQ - 1)) >= 2) { unpack8(*(const GAS u32x4*)(U + (size_t)(t0 - 2) * 512 + ch), um2); unpack8(*(const GAS u32x4*)(U + (size_t)(t0 - 1) * 512 + ch), um1); }
    u32x4 ua[8], ga[8];
#pragma unroll
    for (int i = 0; i < 8; ++i) { const size_t o = (size_t)(t0 + i) * 512 + ch; ua[i] = *(const GAS u32x4*)(U + o); ga[i] = *(const GAS u32x4*)(GB + o); }
#pragma unroll
    for (int i = 0; i < 8; ++i) {
        float u[8], gb[8], y[8]; unpack8(ua[i], u); unpack8(ga[i], gb);
#pragma unroll
        for (int e = 0; e < 8; ++e) { y[e] = gb[e] * (w0[e] * um2[e] + w1[e] * um1[e] + w2[e] * u[e]); um2[e] = um1[e]; um1[e] = u[e]; }
        u32x4 w; w.x = cvt_pk_bf16(y[0], y[1]); w.y = cvt_pk_bf16(y[2], y[3]); w.z = cvt_pk_bf16(y[4], y[5]); w.w = cvt_pk_bf16(y[6], y[7]);
        *(GAS u32x4*)(GB + (size_t)(t0 + i) * 512 + ch) = w;
    }
}

constexpr int R_SQ = 0, R_SK = 18432, R_SVT = 36864, R_SPT = 71680, R_SP = 90112;
__device__ __forceinline__ bf16x8 lds_frag(LAS const unsigned char* p) { return *(LAS const bf16x8*)p; }

struct RetV { u32x4 v[4]; };
__device__ __forceinline__ void load_v(RetV& r, const bf16* Rv, int t0, int h, int tid) {
#pragma unroll
    for (int i = 0; i < 4; ++i) { const int id = tid + i * 512, m = id & 127, chn = id >> 7; r.v[i] = *(const GAS u32x4*)(Rv + (size_t)(t0 + m) * 512 + h * 128 + chn * 8); }
}
__device__ __forceinline__ void stage_vT(LAS unsigned char* lds, const RetV& r, int tid) {
#pragma unroll
    for (int i = 0; i < 4; ++i) {
        const int id = tid + i * 512, m = id & 127, chn = id >> 7; const u32x4 v = r.v[i];
        LAS bf16* d = (LAS bf16*)(lds + R_SVT) + (chn * 8) * 136 + m;
        d[0 * 136] = (bf16)(v.x & 0xffff); d[1 * 136] = (bf16)(v.x >> 16); d[2 * 136] = (bf16)(v.y & 0xffff); d[3 * 136] = (bf16)(v.y >> 16);
        d[4 * 136] = (bf16)(v.z & 0xffff); d[5 * 136] = (bf16)(v.z >> 16); d[6 * 136] = (bf16)(v.w & 0xffff); d[7 * 136] = (bf16)(v.w >> 16);
    }
}
struct RetK { u32x4 k[2]; };
__device__ __forceinline__ void retkv_load(unsigned char* ws, int item, int tid, RetV& rv, RetK& rk) {
    const int bh = item >> 6, n = item & 63, b = bh >> 2, h = bh & 3, t0 = b * SEQ + n * 128;
    load_v(rv, (const bf16*)(ws + WS_RV), t0, h, tid);
    const bf16* Rk = (const bf16*)(ws + WS_RK);
#pragma unroll
    for (int i = 0; i < 2; ++i) { const int id = tid + i * 512, m = id & 127, chn = id >> 7; rk.k[i] = *(const GAS u32x4*)(Rk + (size_t)(t0 + m) * 256 + h * 64 + chn * 8); }
}
__device__ __forceinline__ void retkv_items(unsigned char* ws, LAS unsigned char* lds, int first, int stride, int tid, int wave, int lane) {
    RetV rv; RetK rk;
    if (first < 1024) retkv_load(ws, first, tid, rv, rk);
    for (int item = first; item < 1024; item += stride) {
        const int h = (item >> 6) & 3;
        float* KV = (float*)(ws + WS_KV) + (size_t)item * 8192;
        const float lg = LG2[h];
        stage_vT(lds, rv, tid);
#pragma unroll
        for (int i = 0; i < 2; ++i) {
            const int id = tid + i * 512, m = id & 127, chn = id >> 7; const u32x4 v = rk.k[i];
            const float z = exp2f((float)(127 - m) * lg);
            LAS bf16* d = (LAS bf16*)(lds + R_SQ) + (chn * 8) * 136 + m;
            const unsigned p0 = cvt_pk_bf16(bflo(v.x) * z, bfhi(v.x) * z), p1 = cvt_pk_bf16(bflo(v.y) * z, bfhi(v.y) * z), p2 = cvt_pk_bf16(bflo(v.z) * z, bfhi(v.z) * z), p3 = cvt_pk_bf16(bflo(v.w) * z, bfhi(v.w) * z);
            d[0 * 136] = (bf16)(p0 & 0xffff); d[1 * 136] = (bf16)(p0 >> 16); d[2 * 136] = (bf16)(p1 & 0xffff); d[3 * 136] = (bf16)(p1 >> 16);
            d[4 * 136] = (bf16)(p2 & 0xffff); d[5 * 136] = (bf16)(p2 >> 16); d[6 * 136] = (bf16)(p3 & 0xffff); d[7 * 136] = (bf16)(p3 >> 16);
        }
        if (item + stride < 1024) retkv_load(ws, item + stride, tid, rv, rk);
        __syncthreads();
        const int dt = wave & 3, eg = wave >> 2, lr = lane & 15, lq = lane >> 4;
        f32x4 acc[4];
#pragma unroll
        for (int j = 0; j < 4; ++j) acc[j] = (f32x4){0.f, 0.f, 0.f, 0.f};
#pragma unroll
        for (int kk = 0; kk < 4; ++kk) {
            const bf16x8 af = lds_frag(lds + R_SQ + ((dt * 16 + lr) * 136 + kk * 32 + 8 * lq) * 2);
#pragma unroll
            for (int j = 0; j < 4; ++j) {
                const bf16x8 bfr = lds_frag(lds + R_SVT + (((eg * 4 + j) * 16 + lr) * 136 + kk * 32 + 8 * lq) * 2);
                acc[j] = __builtin_amdgcn_mfma_f32_16x16x32_bf16(af, bfr, acc[j], 0, 0, 0);
            }
        }
#pragma unroll
        for (int j = 0; j < 4; ++j) *(GAS f32x4*)(KV + (size_t)((eg * 4 + j) * 16 + lr) * 64 + dt * 16 + lq * 4) = acc[j];
        __syncthreads();
    }
}
__device__ __forceinline__ void scan_phase(unsigned char* ws, int vcu, int G, int tid, size_t dst_off = WS_PREVT) {
    const float* KV = (const float*)(ws + WS_KV); bf16* DST = (bf16*)(ws + dst_off);
    for (int gid = vcu * 512 + tid; gid < 16 * 8192; gid += G * 512) {
        const int bh = gid >> 13, rem = gid & 8191, h = bh & 3;
        const float decay = exp2f(128.0f * LG2[h]);
        const GAS float* p = (const GAS float*)(KV + ((size_t)bh * 64) * 8192 + rem); GAS bf16* pd = (GAS bf16*)(DST + ((size_t)bh * 64) * 8192 + rem);
        float st = 0.f;
#pragma unroll
        for (int n0 = 0; n0 < 64; n0 += 16) {
            float kv[16];
#pragma unroll
            for (int j = 0; j < 16; ++j) kv[j] = p[(size_t)(n0 + j) * 8192];
#pragma unroll
            for (int j = 0; j < 16; ++j) { pd[(size_t)(n0 + j) * 8192] = (bf16)(cvt_pk_bf16(st, 0.f) & 0xffff); st = decay * st + kv[j]; }
        }
    }
}
struct RetQKP { u32x4 q[2], k[2]; };
__device__ __forceinline__ void retout_load(unsigned char* ws, int item, int tid, RetV& rv) {
    const int bh = item >> 6, n = item & 63, b = bh >> 2, h = bh & 3, t0 = b * SEQ + n * 128;
    load_v(rv, (const bf16*)(ws + WS_RV), t0, h, tid);
}
__device__ __forceinline__ void retout_load_qk(unsigned char* ws, int item, int tid, RetQKP& r) {
    const int bh = item >> 6, n = item & 63, b = bh >> 2, h = bh & 3, t0 = b * SEQ + n * 128;
    const bf16* Rq = (const bf16*)(ws + WS_RQ); const bf16* Rk = (const bf16*)(ws + WS_RK);
#pragma unroll
    for (int i = 0; i < 2; ++i) {
        const int id = tid + i * 512, row = id >> 3, chn = id & 7;
        r.q[i] = *(const GAS u32x4*)(Rq + (size_t)(t0 + row) * 256 + h * 64 + chn * 8);
        r.k[i] = *(const GAS u32x4*)(Rk + (size_t)(t0 + row) * 256 + h * 64 + chn * 8);
    }
}
__device__ __forceinline__ void retout_item(unsigned char* ws, LAS unsigned char* lds, int item, int next_item, RetV& rv, int tid, int wave, int lane, size_t dst_off = WS_SRZ) {
    const int bh = item >> 6, n = item & 63, b = bh >> 2, h = bh & 3, t0 = b * SEQ + n * 128;
    const bf16* Z = (const bf16*)(ws + WS_SRZ); bf16* R = (bf16*)(ws + dst_off); const bf16* PT = (const bf16*)(ws + WS_PREVT) + (size_t)item * 8192;
    const float lg = LG2[h];
    retout_load(ws, item, tid, rv);
    RetQKP rq; retout_load_qk(ws, item, tid, rq);
    u32x4 pt[2];
#pragma unroll
    for (int i = 0; i < 2; ++i) pt[i] = *(const GAS u32x4*)(PT + (size_t)(tid + i * 512) * 8);
    stage_vT(lds, rv, tid);
#pragma unroll
    for (int i = 0; i < 2; ++i) {
        const int id = tid + i * 512, row = id >> 3, chn = id & 7;
        *(LAS u32x4*)(lds + R_SQ + row * 144 + chn * 16) = rq.q[i];
        *(LAS u32x4*)(lds + R_SK + row * 144 + chn * 16) = rq.k[i];
    }
#pragma unroll
    for (int i = 0; i < 2; ++i) { const int id = tid + i * 512, e = id >> 3, chn = id & 7; *(LAS u32x4*)(lds + R_SPT + e * 144 + chn * 16) = pt[i]; }
    __syncthreads();
    const int lr = lane & 15, lq = lane >> 4, c0 = wave * 16;
    bf16x8 aq[2];
#pragma unroll
    for (int kk = 0; kk < 2; ++kk) aq[kk] = lds_frag(lds + R_SQ + ((c0 + lr) * 72 + kk * 32 + 8 * lq) * 2);
#pragma unroll
    for (int mt = 0; mt < 8; ++mt) {
        f32x4 s = (f32x4){0.f, 0.f, 0.f, 0.f};
#pragma unroll
        for (int kk = 0; kk < 2; ++kk) {
            const bf16x8 bk = lds_frag(lds + R_SK + ((mt * 16 + lr) * 72 + kk * 32 + 8 * lq) * 2);
            s = __builtin_amdgcn_mfma_f32_16x16x32_bf16(aq[kk], bk, s, 0, 0, 0);
        }
        const int mm = mt * 16 + lr;
#pragma unroll
        for (int i = 0; i < 4; ++i) {
            const int c = c0 + lq * 4 + i, df = c - mm;
            const float pv = (df >= 0) ? s[i] * exp2f((float)df * lg) : 0.f;
            ((LAS bf16*)(lds + R_SP))[c * 136 + mm] = (bf16)(cvt_pk_bf16(pv, 0.f) & 0xffff);
        }
    }
    f32x4 acc[8];
#pragma unroll
    for (int et = 0; et < 8; ++et) {
        acc[et] = (f32x4){0.f, 0.f, 0.f, 0.f};
#pragma unroll
        for (int kk = 0; kk < 2; ++kk) {
            const bf16x8 bp = lds_frag(lds + R_SPT + ((et * 16 + lr) * 72 + kk * 32 + 8 * lq) * 2);
            acc[et] = __builtin_amdgcn_mfma_f32_16x16x32_bf16(aq[kk], bp, acc[et], 0, 0, 0);
        }
    }
    float xi[4];
#pragma unroll
    for (int i = 0; i < 4; ++i) xi[i] = exp2f((float)(lq * 4 + i + 1 + (c0 & 127)) * lg);
#pragma unroll
    for (int et = 0; et < 8; ++et)
#pragma unroll
        for (int i = 0; i < 4; ++i) acc[et][i] *= xi[i];
    asm volatile("s_waitcnt lgkmcnt(0)" ::: "memory");
#pragma unroll
    for (int kk = 0; kk < 4; ++kk) {
        const bf16x8 ap = lds_frag(lds + R_SP + ((c0 + lr) * 136 + kk * 32 + 8 * lq) * 2);
#pragma unroll
        for (int et = 0; et < 8; ++et) {
            const bf16x8 bv = lds_frag(lds + R_SVT + ((et * 16 + lr) * 136 + kk * 32 + 8 * lq) * 2);
            acc[et] = __builtin_amdgcn_mfma_f32_16x16x32_bf16(ap, bv, acc[et], 0, 0, 0);
        }
    }
    asm volatile("s_waitcnt lgkmcnt(0)" ::: "memory");
#pragma unroll
    for (int i = 0; i < 4; ++i) {
        float q = 0.f;
#pragma unroll
        for (int et = 0; et < 8; ++et) q += acc[et][i] * acc[et][i];
        q += __shfl_xor(q, 1); q += __shfl_xor(q, 2); q += __shfl_xor(q, 4); q += __shfl_xor(q, 8);
        const float rs = __builtin_amdgcn_rsqf(q * (1.0f / 128.0f) + EPS);
        LAS bf16* sp = (LAS bf16*)(lds + R_SP) + (c0 + lq * 4 + i) * 136 + lr;
#pragma unroll
        for (int et = 0; et < 8; ++et) sp[et * 16] = (bf16)(cvt_pk_bf16(acc[et][i] * rs, 0.f) & 0xffff);
    }
    asm volatile("s_waitcnt lgkmcnt(0)" ::: "memory");
#pragma unroll
    for (int i = 0; i < 4; ++i) {
        const int r = i * 4 + lq;
        const u32x4 o = *(LAS const u32x4*)(lds + R_SP + ((c0 + r) * 136 + 8 * lr) * 2);
        GAS u32x4* rp = (GAS u32x4*)(R + (size_t)(t0 + c0 + r) * 512 + h * 128 + 8 * lr);
        const u32x4 z = *(const GAS u32x4*)(Z + (size_t)(t0 + c0 + r) * 512 + h * 128 + 8 * lr);
        u32x4 w;
        w.x = cvt_pk_bf16(bflo(o.x) * bflo(z.x), bfhi(o.x) * bfhi(z.x)); w.y = cvt_pk_bf16(bflo(o.y) * bflo(z.y), bfhi(o.y) * bfhi(z.y));
        w.z = cvt_pk_bf16(bflo(o.z) * bflo(z.z), bfhi(o.z) * bfhi(z.z)); w.w = cvt_pk_bf16(bflo(o.w) * bflo(z.w), bfhi(o.w) * bfhi(z.w));
        *rp = w;
    }
    __syncthreads();
}

__device__ __forceinline__ void attn_post(unsigned char* ws, int b, int h, int qi, const bf16* otmp, int l, const float* lp, const float* subg, size_t dst_off = WS_SZA) {
    int tid_ = threadIdx.x; asm volatile("" : "+v"(tid_));
    const int lane = tid_ & 63, wave = __builtin_amdgcn_readfirstlane(tid_ >> 6);
    const float e1 = wave_sum(lp[lane] * lp[64 + lane]), e2 = wave_sum(lp[128 + lane] * lp[192 + lane]);
    const float lam_init = 0.8f - 0.6f * expf(-0.3f * (float)l);
    const float lam = expf(e1) - expf(e2) + lam_init, oml = 1.0f - lam_init;
    asm volatile("s_waitcnt vmcnt(0)" ::: "memory");
    __syncthreads();
    __builtin_amdgcn_fence(__ATOMIC_ACQUIRE, "agent");
    bf16* A = (bf16*)(ws + dst_off); const bf16* ZA = (const bf16*)(ws + WS_SZA);
    const int lr = lane & 15, lq = lane >> 4;
    float gg[8];
#pragma unroll
    for (int e = 0; e < 8; ++e) gg[e] = subg[8 * lr + e] * oml;
#pragma unroll 4
    for (int it = 0; it < 8; ++it) {
        const int row = wave * 32 + it * 4 + lq;
        const u32x4 o0 = *(const GAS u32x4*)(otmp + row * 256 + 8 * lr), o1 = *(const GAS u32x4*)(otmp + row * 256 + 128 + 8 * lr);
        GAS u32x4* ap = (GAS u32x4*)(A + (size_t)(b * SEQ + qi * 256 + row) * 512 + h * 128 + 8 * lr);
        const u32x4 z = *(const GAS u32x4*)(ZA + (size_t)(b * SEQ + qi * 256 + row) * 512 + h * 128 + 8 * lr);
        float d[8] = {bflo(o0.x) - lam * bflo(o1.x), bfhi(o0.x) - lam * bfhi(o1.x), bflo(o0.y) - lam * bflo(o1.y), bfhi(o0.y) - lam * bfhi(o1.y),
                      bflo(o0.z) - lam * bflo(o1.z), bfhi(o0.z) - lam * bfhi(o1.z), bflo(o0.w) - lam * bflo(o1.w), bfhi(o0.w) - lam * bfhi(o1.w)};
        float ss = ((d[0] * d[0] + d[1] * d[1]) + (d[2] * d[2] + d[3] * d[3])) + ((d[4] * d[4] + d[5] * d[5]) + (d[6] * d[6] + d[7] * d[7]));
        ss += __shfl_xor(ss, 1); ss += __shfl_xor(ss, 2); ss += __shfl_xor(ss, 4); ss += __shfl_xor(ss, 8);
        const float rs = __builtin_amdgcn_rsqf(ss * (1.0f / 128.0f) + EPS);
        const float zz[8] = {bflo(z.x), bfhi(z.x), bflo(z.y), bfhi(z.y), bflo(z.z), bfhi(z.z), bflo(z.w), bfhi(z.w)};
#pragma unroll
        for (int e = 0; e < 8; ++e) d[e] = d[e] * rs * gg[e] * zz[e];
        u32x4 w; w.x = cvt_pk_bf16(d[0], d[1]); w.y = cvt_pk_bf16(d[2], d[3]); w.z = cvt_pk_bf16(d[4], d[5]); w.w = cvt_pk_bf16(d[6], d[7]);
        *ap = w;
    }
    asm volatile("s_waitcnt vmcnt(0)" ::: "memory");
    __syncthreads();
}
__device__ __forceinline__ void attn_phase(unsigned char* ws, char* lds, int vcu, int G, int bx, int l, const float* lp, const float* subg) {
    const attn_body::bf16* Qa = (const attn_body::bf16*)(ws + WS_QA); const attn_body::bf16* Ka = (const attn_body::bf16*)(ws + WS_KA); const attn_body::bf16* Va = (const attn_body::bf16*)(ws + WS_VA);
    bf16* otmp = (bf16*)(ws + WS_OTMP) + (size_t)bx * 65536;
    for (int v = vcu; v < 256; v += G) {
        const int xg = v >> 5, j = v & 31;
        for (int u4 = 0; u4 < 4; ++u4) {
            const int bh = 2 * xg + (u4 >> 1), b = bh >> 2, h = bh & 3;
            const int qi = (u4 < 2) ? j : 31 - j, c = u4 & 1;
            for (int rp = 0; rp < REP_ATTN; ++rp) attn_body::attn_unit128<8, 512, 512, 512, 256>(qi * 256, Qa + (size_t)(b * SEQ + qi * 256) * 512 + (h * 2 + c) * 64, Ka + (size_t)(b * SEQ) * 512 + (h * 2 + c) * 64,
                                                        Va + (size_t)(b * SEQ) * 512 + h * 128, (attn_body::bf16*)otmp + c * 128, lds);
            if (c == 1) {
#ifdef PROBE_LIGHT
                attn_post(ws, b, h, qi, otmp, l, lp, subg, WS_SCZ);
#endif
                attn_post(ws, b, h, qi, otmp, l, lp, subg);
            }
        }
    }
}

#define GAS __attribute__((address_space(1)))
#define RLX_AGENT __ATOMIC_RELAXED, __HIP_MEMORY_SCOPE_AGENT
#define LDS_WAIT() asm volatile("s_waitcnt lgkmcnt(0)" ::: "memory")
#define VM_WAIT() asm volatile("s_waitcnt vmcnt(0)" ::: "memory")
__device__ __forceinline__ unsigned long long rt() { return __builtin_amdgcn_s_memrealtime(); }
#define XB_TMO      128
#define XB_XCNT(j)  (256  + 64 * (j))
#define XB_XSUB(j)  (1280 + 64 * (j))
#define XB_XGEN(j)  (2304 + 64 * (j))
#define XB_TOP      3328
#define XB_TOPGEN   3392
#define XCD_BAR_WORDS 3456
#define XB_SPIN_CAP (1u << 18)

__device__ __forceinline__ unsigned xb_ld(unsigned* p)              { return __hip_atomic_load(p, __ATOMIC_RELAXED, __HIP_MEMORY_SCOPE_AGENT); }
__device__ __forceinline__ unsigned xb_add(unsigned* p, unsigned v) { return __hip_atomic_fetch_add(p, v, __ATOMIC_RELAXED, __HIP_MEMORY_SCOPE_AGENT); }
__device__ __forceinline__ unsigned xb_xcc_id() { return (unsigned)__builtin_amdgcn_s_getreg((3 << 11) | 20) & 0xFu; }
#define XB_SPIN(cond, bar) do { unsigned _sp = 0; while (cond) { __builtin_amdgcn_s_sleep(1); \
    if ((++_sp & 255u) == 0u) { if (xb_ld(&(bar)[XB_TMO])) break; if (_sp > XB_SPIN_CAP) { atomicAdd(&(bar)[XB_TMO], 1u); break; } } } } while (0)

struct XcdBarrier {
    unsigned* bar; unsigned x;
    volatile LAS unsigned* st;
};

__device__ __forceinline__ XcdBarrier xcd_barrier_post(unsigned* bar, volatile LAS unsigned* st) {
    XcdBarrier b; b.bar = bar; b.x = xb_xcc_id(); b.st = st;
    if (threadIdx.x == 0) (void)xb_add(&bar[XB_XCNT(b.x)], 1u);
    return b;
}
__device__ __forceinline__ void xcd_barrier_complete(unsigned* bar, unsigned x, unsigned& nloc, unsigned& nx) {
    const unsigned G = gridDim.x * gridDim.y * gridDim.z;
    unsigned sum, cnt, mine, sp = 0u;
    for (;;) {
        sum = 0u; cnt = 0u; mine = 0u;
#pragma unroll
        for (unsigned j = 0; j < 16; ++j) { const unsigned c = xb_ld(&bar[XB_XCNT(j)]); sum += c; cnt += (c > 0u) ? 1u : 0u; mine = (j == x) ? c : mine; }
        if (sum == G) break;
        __builtin_amdgcn_s_sleep(1);
        if ((++sp & 255u) == 0u) { if (xb_ld(&bar[XB_TMO])) break; if (sp > XB_SPIN_CAP) { atomicAdd(&bar[XB_TMO], 1u); break; } }
    }
    nloc = mine > 0u ? mine : 1u; nx = cnt > 0u ? cnt : 1u;
}

__device__ __forceinline__ void xcd_barrier(const XcdBarrier& b) {
    asm volatile("s_waitcnt vmcnt(0)" ::: "memory");
    __syncthreads();
    if (threadIdx.x == 0) {
        unsigned* bar = b.bar;
        __builtin_amdgcn_s_waitcnt(0);
        unsigned nloc = b.st[0], nx = b.st[1];
        if (nloc == 0u) { xcd_barrier_complete(bar, b.x, nloc, nx); b.st[0] = nloc; b.st[1] = nx; }
        const unsigned old = xb_add(&bar[XB_XSUB(b.x)], 1u);
        const unsigned gen = old / nloc;
        if (old + 1u == (gen + 1u) * nloc) {
            __builtin_amdgcn_fence(__ATOMIC_RELEASE, "agent");
            asm volatile("s_waitcnt vmcnt(0)" ::: "memory");
            const unsigned og = xb_add(&bar[XB_TOP], 1u);
            const unsigned tg = og / nx;
            if (og + 1u == (tg + 1u) * nx) xb_add(&bar[XB_TOPGEN], 1u);
            else XB_SPIN(xb_ld(&bar[XB_TOPGEN]) == tg, bar);
            __builtin_amdgcn_fence(__ATOMIC_ACQUIRE, "agent");
            xb_add(&bar[XB_XGEN(b.x)], 1u);
            asm volatile("s_waitcnt vmcnt(0)" ::: "memory");
        } else {
            XB_SPIN(xb_ld(&bar[XB_XGEN(b.x)]) == gen, bar);
            __builtin_amdgcn_fence(__ATOMIC_ACQUIRE, "agent");
            asm volatile("s_waitcnt vmcnt(0)" ::: "memory");
        }
    }
    __syncthreads();
}

constexpr int PH_PER_LAYER = 6, N_PHASES = 1 + DEPTH * PH_PER_LAYER + 1;

__global__ void __launch_bounds__(NWAVES * 64, 2) trunk_fwd(Args args) {
    extern __shared__ __attribute__((aligned(16))) unsigned char lds_raw[];
    LAS unsigned char* lds = (LAS unsigned char*)lds_raw;
#define TIDS() int tid = threadIdx.x; asm volatile("" : "+v"(tid)); const int lane = tid & 63, wave = __builtin_amdgcn_readfirstlane(tid >> 6); (void)lane; (void)wave
#define WSO() unsigned char* ws = args.ws; asm volatile("" : "+s"(ws)); float* ssq = (float*)(ws + WS_SSQ); bf16* xb = (bf16*)(ws + WS_XB); (void)ssq; (void)xb
    const int G = gridDim.x, bx = blockIdx.x;
    const int vcu = (G % 8 == 0) ? (bx % 8) * (G / 8) + bx / 8 : bx;
    const int lo = args.ph_lo, hi = args.ph_hi;
#if MK_MULTI
#define SEAM() do {} while (0)
#else
    cg::grid_group grid = cg::this_grid();
    volatile LAS unsigned* bst = (volatile LAS unsigned*)(lds + LDS_BYTES - 16);
    if (threadIdx.x < 2) bst[threadIdx.x] = 0u;
    __syncthreads();
    XcdBarrier bar = xcd_barrier_post((unsigned*)args.ws, bst);
#define SEAM() xcd_barrier(bar)
#endif
#ifndef PHASE_MASK
#define PHASE_MASK 0x1ff
#endif
#define PH_ON(t) ((PHASE_MASK >> (t)) & 1)
#define IN(k) (lo <= (k) && (k) < hi)
#define BOTH(k) (IN(k) && IN((k) + 1))

    if (PH_ON(0) && IN(0)) { TIDS();
#if defined(PROBE_LIGHT) || defined(PROBE_PRO)
        phase_prologue(args, lds, vcu, G, wave, lane);
#endif
        phase_prologue(args, lds, vcu, G, wave, lane); if (BOTH(0)) {
#if MK_MULTI
        SEAM();
#else
        grid.sync();
#endif
    } }

    for (int l = 0; l < DEPTH; ++l) {
        const int p0 = 1 + l * PH_PER_LAYER;
        if (PH_ON(1) && IN(p0)) {
            WSO(); const bf16* Win = (const bf16*)(ws + WS_WIN + l * WIN_L);
            pg8::Gemm g{xb, xb, xb, Win, 0, T, NPROJ, DM}; pg8::StaticOrder S; S.init(T, NPROJ, G, bx);
            float* rstd = (float*)(ws + WS_RSTD) + (size_t)l * T;
            if (l > 0) {
                TIDS(); int lastpm = -1; pg8::Unit uu;
                for (int i = 0; S.next(i, uu); ++i) if (uu.pm != lastpm) { lastpm = uu.pm;
                    const int row = uu.pm * 256 + (tid >> 1); const GAS f32x4* sp = (const GAS f32x4*)(ssq + (size_t)row * 16 + (tid & 1) * 8);
                    const f32x4 a0 = sp[0], a1 = sp[1]; float s = ((a0[0] + a0[1]) + (a0[2] + a0[3])) + ((a1[0] + a1[1]) + (a1[2] + a1[3])); s += __shfl_xor(s, 1);
                    if ((tid & 1) == 0) ((GAS float*)rstd)[row] = __builtin_amdgcn_rsqf(s * (1.0f / DM) + EPS); }
                asm volatile("s_waitcnt vmcnt(0)" ::: "memory"); __syncthreads();
            }
            EpiProj E{ws, rstd, (const float2*)(ws + WS_ROPEA), (const float2*)(ws + WS_ROPER)};
            for (int rp = 0; rp < REP_GEMM; ++rp) pg8::gemm_phase<EpiProj, pg8::StaticOrder, true, true>(lds, g, S, E);
            if (BOTH(p0)) SEAM();
        }
        if (PH_ON(2) && IN(p0 + 1)) {
            WSO();
            TIDS();
            for (int rp = 0; rp < REP_LIGHT; ++rp) retkv_items(ws, lds, vcu, G, tid, wave, lane);
            for (int it = vcu; it < T / 64; it += G) conv_item(ws, args.in[5] + (size_t)l * 3 * 512, it, tid);
            if (BOTH(p0 + 1)) SEAM();
        }
        if (PH_ON(4) && IN(p0 + 2)) {
            WSO();
            { TIDS();
#ifdef PROBE_LIGHT
              scan_phase(ws, vcu, G, tid, WS_SCZ);
#endif
              scan_phase(ws, vcu, G, tid); }
            attn_phase(ws, (char*)lds_raw, vcu, G, bx, l, args.in[3] + (size_t)l * 4 * 64, args.in[4] + l * 128);
            if (BOTH(p0 + 2)) SEAM();
        }
        if (PH_ON(5) && IN(p0 + 3)) {
            WSO();
            { TIDS();
              RetV rv;
#ifdef PROBE_LIGHT
              if (vcu < 1024) retout_load(ws, vcu, tid, rv);
              for (int it = vcu; it < 1024; it += G) retout_item(ws, lds, it, it + G, rv, tid, wave, lane, WS_CC);
#endif
              for (int it = vcu; it < 1024; it += G) retout_item(ws, lds, it, it + G, rv, tid, wave, lane); }
            const bf16* Win = (const bf16*)(ws + WS_WIN + l * WIN_L);
            pg8::Gemm g{xb, xb, xb, Win + (size_t)NPROJ * DM, 0, T, NGATE, DM}; pg8::StaticOrder S; S.init(T, NGATE, G, bx);
            EpiGate E{(bf16*)(ws + WS_G), (const float*)(ws + WS_RSTD) + (size_t)l * T};
            for (int rp = 0; rp < REP_GEMM; ++rp) pg8::gemm_phase<EpiGate, pg8::StaticOrder, true, true>(lds, g, S, E);
            if (BOTH(p0 + 3)) SEAM();
        }
        if (PH_ON(6) && IN(p0 + 4)) {
            WSO();
            pg8::Gemm g{(const bf16*)(ws + WS_SZA), (const bf16*)(ws + WS_CB), (const bf16*)(ws + WS_SRZ), (const bf16*)(ws + WS_WBR + l * WBR_L), (size_t)DM * 512 * 2, T, DM, 512};
            ChainOrder S; S.S.init(T, DM, G, bx);
            EpiChain E{(const bf16*)(ws + WS_G), (bf16*)(ws + WS_MERGED)};
            for (int rp = 0; rp < REP_GEMM; ++rp) pg8::gemm_phase<EpiChain, ChainOrder, true, true>(lds, g, S, E);
            if (BOTH(p0 + 4)) SEAM();
        }
        if (PH_ON(7) && IN(p0 + 5)) {
            WSO();
            const bf16* mg = (const bf16*)(ws + WS_MERGED);
            pg8::Gemm g{mg, mg, mg, (const bf16*)(ws + WS_WOUT + l * WOUT_L), 0, T, DM, DM}; pg8::StaticOrder S; S.init(T, DM, G, bx);
            static_assert(DEPTH == 2, "residual hand-over below is written for two layers: layer 0 reads the f32 input, the last layer reads the bf16 stream");
            if (l + 1 < DEPTH) { EpiOutT<false> E{args.in[0], nullptr, nullptr, xb, ssq}; pg8::gemm_phase<EpiOutT<false>, pg8::StaticOrder, true, true>(lds, g, S, E); }
            else { EpiOutT<true> E{nullptr, xb, args.out, nullptr, ssq}; pg8::gemm_phase<EpiOutT<true>, pg8::StaticOrder, true, true>(lds, g, S, E); }
            if (BOTH(p0 + 5)) SEAM();
        }
    }
    if (PH_ON(8) && IN(N_PHASES - 1)) {
        WSO(); TIDS(); const float* gf = args.in[8]; float* out = args.out;
        const int gw = vcu * NWAVES + wave, NGW = G * NWAVES;
        f32x4 gv[4];
#pragma unroll
        for (int j = 0; j < 4; ++j) gv[j] = ((const f32x4*)gf)[lane + 64 * j];
        for (int m0 = gw * 4; m0 < T; m0 += NGW * 4) {
            f32x4 v[4][4]; float sv[4];
#pragma unroll
            for (int r = 0; r < 4; ++r) { const GAS f32x4* xr = (const GAS f32x4*)(out + (size_t)(m0 + r) * DM) + lane; sv[r] = (lane < 16) ? ((const GAS float*)ssq)[(size_t)(m0 + r) * 16 + lane] : 0.f;
#pragma unroll
                for (int j = 0; j < 4; ++j) v[r][j] = xr[64 * j]; }
#pragma unroll
            for (int r = 0; r < 4; ++r) {
                float s = sv[r];
                s += __shfl_xor(s, 1); s += __shfl_xor(s, 2); s += __shfl_xor(s, 4); s += __shfl_xor(s, 8);
                s = __shfl(s, 0);
                const float rs = __builtin_amdgcn_rsqf(s * (1.0f / DM) + EPS);
                GAS f32x4* xw = (GAS f32x4*)(out + (size_t)(m0 + r) * DM) + lane;
#pragma unroll
                for (int j = 0; j < 4; ++j) xw[64 * j] = v[r][j] * rs * gv[j];
            }
        }
    }
#undef IN
#undef BOTH
#undef SEAM
}

extern "C" void kernel_launch(void* const* d_in, const int* in_sizes, int n_in, void* d_out, int out_size, void* d_ws, size_t ws_size, hipStream_t stream) {
    static int grid = 0;
    if (grid == 0) {
        if (n_in != 9 || in_sizes[0] != T * DM || out_size != T * DM || ws_size < WS_END) { fprintf(stderr, "kernel_launch: unexpected shapes / workspace (n_in %d, ws %zu)\n", n_in, ws_size); grid = -1; return; }
        int dev = 0, cus = 0, per_cu = 0;
        (void)hipGetDevice(&dev); (void)hipDeviceGetAttribute(&cus, hipDeviceAttributeMultiprocessorCount, dev);
        if (hipFuncSetAttribute((const void*)trunk_fwd, hipFuncAttributeMaxDynamicSharedMemorySize, LDS_BYTES) != hipSuccess) { fprintf(stderr, "kernel_launch: hipFuncSetAttribute failed\n"); grid = -1; return; }
        if (hipOccupancyMaxActiveBlocksPerMultiprocessor(&per_cu, (const void*)trunk_fwd, NWAVES * 64, LDS_BYTES) != hipSuccess || per_cu < 1) { fprintf(stderr, "kernel_launch: occupancy query gave %d\n", per_cu); per_cu = 1; }
        (void)hipGetLastError();
        grid = cus * per_cu;
    }
    if (grid < 0) return;
    Args a{};
    for (int i = 0; i < 9; ++i) a.in[i] = (const float*)d_in[i];
    a.out = (float*)d_out; a.ws = (unsigned char*)d_ws;
#if MK_MULTI
    for (int p = 0; p < N_PHASES; ++p) { a.ph_lo = p; a.ph_hi = p + 1; hipLaunchKernelGGL(trunk_fwd, dim3(grid), dim3(NWAVES * 64), LDS_BYTES, stream, a); }
#else
    a.ph_lo = 0; a.ph_hi = N_PHASES;
    if (hipMemsetAsync(d_ws, 0, 16384, stream) != hipSuccess) { fprintf(stderr, "kernel_launch: memset of the barrier words failed\n"); return; }
    void* kargs[] = {&a};
    hipError_t e = hipLaunchCooperativeKernel((const void*)trunk_fwd, dim3(grid), dim3(NWAVES * 64), kargs, LDS_BYTES, stream);
    if (e != hipSuccess) fprintf(stderr, "kernel_launch: cooperative launch failed: %s (grid %d)\n", hipGetErrorString(e), grid);
#endif
}
```

```cpp
#include <hip/hip_runtime.h>
#include <hip/hip_cooperative_groups.h>
#include <hip/hip_bf16.h>
#include <cstdio>
#include <cstdint>
#include <cmath>
namespace cg = cooperative_groups;
namespace pg8 {
#define PG8_LAS __attribute__((address_space(3)))
typedef unsigned short bf16_t;
typedef short bf16x8 __attribute__((ext_vector_type(8)));
typedef float f32x4 __attribute__((ext_vector_type(4)));
typedef unsigned u32x4 __attribute__((ext_vector_type(4)));
constexpr int BM = 256, BK = 64, HALF = 128, HTB = HALF * BK * 2  , STAGE_BYTES = 8 * HTB, NXCD = 8, WGM = 8;

__host__ __device__ __forceinline__ int lds_byte(int r, int c) { const int st = (r >> 4) * 2 + (c >> 5), rr = r & 15, cc = c & 31, ob = rr * 64 + cc * 2; return st * 1024 + (ob ^ (((ob >> 9) & 1) << 5)); }
__host__ __device__ __forceinline__ void stage_rc(int b, int& R, int& C) { const int st = b / 1024, sb = b % 1024, swz = sb ^ (((sb >> 9) & 1) << 5); R = (st >> 1) * 16 + swz / 64; C = (st & 1) * 32 + (swz % 64) / 2; }
__host__ __device__ __forceinline__ int perm32(int rho) { const int n = rho >> 4, i = rho & 15; return 8 * (i >> 2) + 4 * n + (i & 3); }

struct Unit { int pm, pn, seg; };
struct Gemm { const bf16_t* A0; const bf16_t* A1; const bf16_t* A2; const bf16_t* Bt; size_t bseg  ; int M, N, K; };
__device__ __forceinline__ const char* gemm_abase(const Gemm& g, int seg) { return (const char*)(seg == 0 ? g.A0 : (seg == 1 ? g.A1 : g.A2)); }

struct StaticOrder {
    int nM, nN, nwg, G, c;
    __host__ __device__ void init(int M, int N, int G_, int c_) { nM = M / BM; nN = N / BM; nwg = nM * nN; G = G_; c = c_; }
    __host__ __device__ bool next(int i, Unit& u) const {
        const long L = (long)i * G + c; if (L >= nwg) return false;
        int wgid = (int)L; { const int q = nwg / NXCD, r = nwg % NXCD, xcd = wgid % NXCD, off = wgid / NXCD; wgid = (xcd < r ? xcd * (q + 1) : r * (q + 1) + (xcd - r) * q) + off; }
        const int nig = WGM * nN, gid = wgid / nig, fm = gid * WGM, gsz = (nM - fm) < WGM ? (nM - fm) : WGM;
        u.pm = fm + ((wgid % nig) % gsz); u.pn = (wgid % nig) / gsz; u.seg = 0; return true;
    }
    __device__ __forceinline__ void a_ready(const Unit&) const {}
    __device__ __forceinline__ void done(const Unit&) const {}
};

__device__ __forceinline__ unsigned cvt_pk_bf16(float lo, float hi) { unsigned r; asm volatile("v_cvt_pk_bf16_f32 %0, %1, %2" : "=v"(r) : "v"(lo), "v"(hi)); return r; }
typedef float f32x2 __attribute__((ext_vector_type(2)));
template <class Epi, class Sched, bool ALIGN_EPI = false, bool SP2 = false>
__device__ __forceinline__ void gemm_phase(PG8_LAS unsigned char* lds, const Gemm g, const Sched& S, const Epi& E) {
    int tid = threadIdx.x; asm volatile("" : "+v"(tid));
    const int wid = __builtin_amdgcn_readfirstlane(tid >> 6), lane = tid & 63, wr = wid >> 2, wc = wid & 3, fr = lane & 15, fq = lane >> 4;
    const int K = g.K, nt = K / BK;
    unsigned voffA[2], voffB[2];
#pragma unroll
    for (int i = 0; i < 2; ++i) { int R, C; stage_rc(tid * 16 + i * 8192, R, C); const int Rb = Epi::PERM ? ((R & ~31) + perm32(R & 31)) : R;
        voffA[i] = (unsigned)(R * K + C) * 2u; voffB[i] = (unsigned)(Rb * K + C) * 2u; }
    const size_t kstep = (size_t)(BK * 2);
    const size_t hstep = (size_t)HALF * K * 2;
    const size_t tstep = 2 * hstep;
    const unsigned ldsw = (unsigned)wid * 1024u;
    const int aoff = lds_byte(wr * 64 + fr, fq * 8), boff = lds_byte(wc * 32 + fr, fq * 8);
#define PG8_SA(b, h) (((b) * 2 + (h)) * HTB)
#define PG8_SB(b, h) ((4 + (b) * 2 + (h)) * HTB)
#define PG8_STAGE(bufoff, gbase, voff) do { _Pragma("unroll") for (int _i = 0; _i < 2; ++_i) \
        __builtin_amdgcn_global_load_lds((const unsigned*)((const char*)(gbase) + (voff)[_i]), (PG8_LAS unsigned*)(lds + (bufoff) + ldsw + _i * 8192), 16, 0, 0); } while (0)
#define PG8_LDA(dst, b, h) do { _Pragma("unroll") for (int m = 0; m < 4; ++m) _Pragma("unroll") for (int k = 0; k < 2; ++k) dst[m][k] = *(const PG8_LAS bf16x8*)(lds + PG8_SA(b, h) + aoff + m * 2048 + k * 1024); } while (0)
#define PG8_LDB(dst, b, h) do { _Pragma("unroll") for (int n = 0; n < 2; ++n) _Pragma("unroll") for (int k = 0; k < 2; ++k) dst[n][k] = *(const PG8_LAS bf16x8*)(lds + PG8_SB(b, h) + boff + n * 2048 + k * 1024); } while (0)
#define PG8_MMA(ai, bj, At, Bt) do { __builtin_amdgcn_s_setprio(1); _Pragma("unroll") for (int m = 0; m < 4; ++m) _Pragma("unroll") for (int n = 0; n < 2; ++n) _Pragma("unroll") for (int k = 0; k < 2; ++k) \
        acc[ai][bj][m][n] = __builtin_amdgcn_mfma_f32_16x16x32_bf16(Bt[n][k], At[m][k], acc[ai][bj][m][n], 0, 0, 0); __builtin_amdgcn_s_setprio(0); } while (0)
#define PG8_WAIT_V(n) asm volatile("s_waitcnt vmcnt(" #n ")" ::: "memory")
#define PG8_WAIT_L(n) asm volatile("s_waitcnt lgkmcnt(" #n ")" ::: "memory")
#define PG8_BAR __builtin_amdgcn_s_barrier()
#define PG8_SCHED __builtin_amdgcn_sched_barrier(0)
    Unit cur, nxt; int ui = 0;
    if (!S.next(0, cur)) return;
    f32x4 acc[2][2][4][2];
#pragma unroll
    for (int a = 0; a < 2; ++a)
#pragma unroll
        for (int b = 0; b < 2; ++b)
#pragma unroll
            for (int m = 0; m < 4; ++m)
#pragma unroll
                for (int n = 0; n < 2; ++n) acc[a][b][m][n] = (f32x4){0.f, 0.f, 0.f, 0.f};
    bf16x8 At[4][2], B0[2][2], B1[2][2];
    const char* cA = gemm_abase(g, cur.seg) + (size_t)cur.pm * tstep; const char* cB = (const char*)g.Bt + (size_t)cur.seg * g.bseg + (size_t)cur.pn * tstep;
    S.a_ready(cur);
    if constexpr (SP2) {
        PG8_STAGE(PG8_SB(0, 0), cB, voffB); PG8_STAGE(PG8_SB(0, 1), cB + hstep, voffB); PG8_STAGE(PG8_SA(0, 0), cA, voffA); PG8_STAGE(PG8_SA(0, 1), cA + hstep, voffA);
        if (wr == 1) PG8_BAR;
        PG8_WAIT_V(2); PG8_BAR;
        PG8_STAGE(PG8_SB(1, 0), cB + kstep, voffB); PG8_STAGE(PG8_SA(1, 0), cA + kstep, voffA); PG8_STAGE(PG8_SB(1, 1), cB + hstep + kstep, voffB);
        PG8_WAIT_V(6); PG8_BAR;
    } else {
        PG8_STAGE(PG8_SB(0, 0), cB, voffB); PG8_STAGE(PG8_SA(0, 0), cA, voffA); PG8_STAGE(PG8_SB(0, 1), cB + hstep, voffB); PG8_STAGE(PG8_SA(0, 1), cA + hstep, voffA);
        if (wr == 1) PG8_BAR;
        PG8_WAIT_V(4); PG8_BAR;
        PG8_STAGE(PG8_SB(1, 0), cB + kstep, voffB); PG8_STAGE(PG8_SA(1, 0), cA + kstep, voffA); PG8_STAGE(PG8_SB(1, 1), cB + hstep + kstep, voffB);
        PG8_WAIT_V(6); PG8_BAR;
    }
    for (;;) {
        const bool has_next = S.next(ui + 1, nxt);
        const char* nA = has_next ? gemm_abase(g, nxt.seg) + (size_t)nxt.pm * tstep : cA; const char* nB = has_next ? (const char*)g.Bt + (size_t)nxt.seg * g.bseg + (size_t)nxt.pn * tstep : cB;
        for (int t = 0; t < nt; t += 2) {
            const bool last = (t == nt - 2);
            const char* a1 = cA + (size_t)(t + 1) * kstep;
            const char* a2 = last ? nA : cA + (size_t)(t + 2) * kstep; const char* b2 = last ? nB : cB + (size_t)(t + 2) * kstep;
            const char* a3 = a2 + kstep; const char* b3 = b2 + kstep;
            if (last && has_next) S.a_ready(nxt);
            if constexpr (SP2) {
            PG8_LDB(B0, 0, 0); PG8_LDB(B1, 0, 1); PG8_SCHED; PG8_LDA(At, 0, 0); PG8_STAGE(PG8_SA(1, 1), a1 + hstep, voffA);
            PG8_WAIT_V(8); PG8_WAIT_L(0); PG8_BAR; PG8_MMA(0, 0, At, B0); PG8_MMA(0, 1, At, B1); PG8_BAR; PG8_SCHED;
            PG8_LDA(At, 0, 1); PG8_STAGE(PG8_SB(0, 0), b2, voffB); PG8_STAGE(PG8_SB(0, 1), b2 + hstep, voffB); PG8_STAGE(PG8_SA(0, 0), a2, voffA);
            PG8_WAIT_V(8); PG8_WAIT_L(0); PG8_BAR; PG8_MMA(1, 0, At, B0); PG8_MMA(1, 1, At, B1); PG8_BAR; PG8_SCHED;
            PG8_LDB(B0, 1, 0); PG8_LDB(B1, 1, 1); PG8_SCHED; PG8_LDA(At, 1, 0); PG8_STAGE(PG8_SA(0, 1), a2 + hstep, voffA);
            PG8_WAIT_V(8); PG8_WAIT_L(0); PG8_BAR; PG8_MMA(0, 0, At, B0); PG8_MMA(0, 1, At, B1); PG8_BAR; PG8_SCHED;
            PG8_LDA(At, 1, 1); PG8_STAGE(PG8_SB(1, 0), b3, voffB); PG8_STAGE(PG8_SB(1, 1), b3 + hstep, voffB); PG8_STAGE(PG8_SA(1, 0), a3, voffA);
            PG8_WAIT_V(8); PG8_WAIT_L(0); PG8_BAR; PG8_MMA(1, 0, At, B0); PG8_MMA(1, 1, At, B1); PG8_BAR; PG8_SCHED;
            } else {
            PG8_LDB(B0, 0, 0); PG8_SCHED; PG8_LDA(At, 0, 0); PG8_STAGE(PG8_SA(1, 1), a1 + hstep, voffA);
            PG8_WAIT_L(8); PG8_BAR; PG8_WAIT_L(0); PG8_MMA(0, 0, At, B0); PG8_BAR; PG8_SCHED;
            PG8_LDB(B1, 0, 1); PG8_STAGE(PG8_SB(0, 0), b2, voffB);
            PG8_BAR; PG8_WAIT_L(0); PG8_MMA(0, 1, At, B1); PG8_BAR;
            PG8_LDA(At, 0, 1); PG8_STAGE(PG8_SA(0, 0), a2, voffA);
            PG8_BAR; PG8_WAIT_L(0); PG8_MMA(1, 0, At, B0); PG8_BAR; PG8_SCHED;
            PG8_STAGE(PG8_SB(0, 1), b2 + hstep, voffB);
            PG8_WAIT_V(6); PG8_BAR; PG8_MMA(1, 1, At, B1); PG8_BAR;
            PG8_LDB(B0, 1, 0); PG8_SCHED; PG8_LDA(At, 1, 0); PG8_STAGE(PG8_SA(0, 1), a2 + hstep, voffA);
            PG8_WAIT_L(8); PG8_BAR; PG8_WAIT_L(0); PG8_MMA(0, 0, At, B0); PG8_BAR; PG8_SCHED;
            PG8_LDB(B1, 1, 1); PG8_STAGE(PG8_SB(1, 0), b3, voffB);
            PG8_BAR; PG8_WAIT_L(0); PG8_MMA(0, 1, At, B1); PG8_BAR;
            PG8_LDA(At, 1, 1); PG8_STAGE(PG8_SA(1, 0), a3, voffA);
            PG8_BAR; PG8_WAIT_L(0); PG8_MMA(1, 0, At, B0); PG8_BAR; PG8_SCHED;
            PG8_STAGE(PG8_SB(1, 1), b3 + hstep, voffB);
            PG8_WAIT_V(6); PG8_BAR; PG8_MMA(1, 1, At, B1); PG8_BAR;
            }
        }
        if constexpr (ALIGN_EPI) { if (wr == 0) PG8_BAR; }
        if constexpr (!Epi::AFTER_DRAIN) { E(acc, cur, wr, wc, fr, fq); S.done(cur); }
        if (!has_next) break;
        if (!E.keep(cur)) {
#pragma unroll
        for (int a = 0; a < 2; ++a)
#pragma unroll
            for (int b = 0; b < 2; ++b)
#pragma unroll
                for (int m = 0; m < 4; ++m)
#pragma unroll
                    for (int n = 0; n < 2; ++n) acc[a][b][m][n] = (f32x4){0.f, 0.f, 0.f, 0.f};
        }
        cur = nxt; cA = nA; cB = nB; ++ui;
        if constexpr (ALIGN_EPI) { if (wr == 1) PG8_BAR; }
    }
    PG8_WAIT_V(0);
    if constexpr (!ALIGN_EPI) { if (wr == 0) PG8_BAR; }
    PG8_BAR;
    if constexpr (Epi::AFTER_DRAIN) { E.fused(acc, cur, wr, wc, fr, fq, lds, wid, lane); S.done(cur); }
#undef PG8_SA
#undef PG8_SB
#undef PG8_STAGE
#undef PG8_LDA
#undef PG8_LDB
#undef PG8_MMA
#undef PG8_WAIT_V
#undef PG8_WAIT_L
#undef PG8_BAR
#undef PG8_SCHED
}
}
namespace attn_body {
using bf16=__hip_bfloat16;
using bf16x8=__attribute__((ext_vector_type(8)))short;
using s16x4=__attribute__((ext_vector_type(4)))short;
using f32x16=__attribute__((ext_vector_type(16)))float;
using u32x4=__attribute__((ext_vector_type(4)))unsigned;
constexpr int SEQ=8192,D=64;
constexpr int NW=8,QBLK=32,QB=QBLK*NW,KVBLK=64,NQB=SEQ/QB;
constexpr int ATTN_UNIT_ROWS=QB;
__device__ __forceinline__ int crow(int r,int hi){return (r&3)+8*(r>>2)+4*hi;}
#define SBAR() __builtin_amdgcn_sched_barrier(0)
__device__ __forceinline__ void cmask(f32x16&p0,f32x16&p1,int jb,int qrel,int hi){
  const float NEG=-INFINITY; int kb=64*jb+4*hi;
  #pragma unroll
  for(int r=0;r<16;++r){int kv=kb+(r&3)+8*(r>>2); if(kv>qrel)p0[r]=NEG; if(kv+32>qrel)p1[r]=NEG;}
}

constexpr int NSLOT=3, SLOTB=8192;
constexpr int LDS_K=0, LDS_V=NSLOT*SLOTB, LDS_WS=2*NSLOT*SLOTB, LDS_OST=LDS_WS+NW*64*4, LDS_BYTES=LDS_OST+NW*4096;
constexpr float C2=0.125f*1.4426950408889634f;
__device__ __forceinline__ void glds16(const void*gsrc,unsigned lds_dst){unsigned keep;
  asm volatile("s_mov_b32 %0, m0\n\ts_mov_b32 m0, %2\n\ts_nop 0\n\tglobal_load_lds_dwordx4 %1, off\n\ts_mov_b32 m0, %0":"=&s"(keep):"v"(gsrc),"s"(lds_dst):"memory");}
__device__ __forceinline__ float max3f(float a,float b,float c){float r;asm("v_max3_f32 %0, %1, %2, %3":"=v"(r):"v"(a),"v"(b),"v"(c));return r;}
__device__ __forceinline__ float max2f(float a,float b){float r;asm("v_max_f32_e32 %0, %1, %2":"=v"(r):"v"(a),"v"(b));return r;}
__device__ __forceinline__ float fadd_s(float a,float b){float r;asm("v_add_f32_e32 %0, %1, %2":"=v"(r):"v"(a),"v"(b));return r;}
__device__ __forceinline__ float fsub_s(float a,float b){float r;asm("v_sub_f32_e32 %0, %1, %2":"=v"(r):"v"(a),"v"(b));return r;}
typedef float f32x2_t __attribute__((ext_vector_type(2))); typedef __bf16 bf16x2_t __attribute__((ext_vector_type(2)));
__device__ __forceinline__ unsigned cvtpk_s(float lo,float hi){f32x2_t v={lo,hi};bf16x2_t b=__builtin_convertvector(v,bf16x2_t);return __builtin_bit_cast(unsigned,b);}
#define WAIT_BAR(N) asm volatile("s_waitcnt vmcnt(" #N ") lgkmcnt(0)\n\ts_barrier":::"memory")

__device__ __forceinline__ void qkt(f32x16&p0,f32x16&p1,const char*Kslot,const bf16x8*qr,const f32x16&negm,int r32,int hi){
  const char*kb=Kslot+hi*1024+r32*16;
  #pragma unroll
  for(int d0=0;d0<4;++d0){
    const bf16x8 b0=*reinterpret_cast<const bf16x8*>(kb+d0*2048);
    const bf16x8 b1=*reinterpret_cast<const bf16x8*>(kb+d0*2048+512);
    if(d0==0){p0=__builtin_amdgcn_mfma_f32_32x32x16_bf16(b0,qr[0],negm,0,0,0);p1=__builtin_amdgcn_mfma_f32_32x32x16_bf16(b1,qr[0],negm,0,0,0);}
    else{p0=__builtin_amdgcn_mfma_f32_32x32x16_bf16(b0,qr[d0],p0,0,0,0);p1=__builtin_amdgcn_mfma_f32_32x32x16_bf16(b1,qr[d0],p1,0,0,0);}}
}
typedef __attribute__((address_space(3))) const char* lds_cptr;
typedef short v4i16_t __attribute__((ext_vector_type(4)));
__device__ __forceinline__ void kload8(bf16x8*kf,lds_cptr kp){
  kf[0]=*(const __attribute__((address_space(3))) bf16x8*)(kp);      kf[1]=*(const __attribute__((address_space(3))) bf16x8*)(kp+512);
  kf[2]=*(const __attribute__((address_space(3))) bf16x8*)(kp+2048); kf[3]=*(const __attribute__((address_space(3))) bf16x8*)(kp+2560);
  kf[4]=*(const __attribute__((address_space(3))) bf16x8*)(kp+4096); kf[5]=*(const __attribute__((address_space(3))) bf16x8*)(kp+4608);
  kf[6]=*(const __attribute__((address_space(3))) bf16x8*)(kp+6144); kf[7]=*(const __attribute__((address_space(3))) bf16x8*)(kp+6656);
}
__device__ __forceinline__ void kload2(bf16x8*kf,lds_cptr kp,int j){ kf[2*j]=*(const __attribute__((address_space(3))) bf16x8*)(kp+j*2048); kf[2*j+1]=*(const __attribute__((address_space(3))) bf16x8*)(kp+j*2048+512); }
__device__ __forceinline__ s16x4 vtr(lds_cptr p){ return __builtin_bit_cast(s16x4,__builtin_amdgcn_ds_read_tr16_b64_v4i16((__attribute__((address_space(3))) v4i16_t*)p)); }
__device__ __forceinline__ float rowmax(const f32x16&p0,const f32x16&p1){
  float a=max3f(p0[0],p0[1],p1[0]),b=max3f(p0[2],p0[3],p1[1]);a=max3f(a,p1[2],p1[3]);
  #pragma unroll
  for(int r=4;r<16;r+=4){a=max3f(a,p0[r],p0[r+1]);b=max3f(b,p0[r+2],p0[r+3]);a=max3f(a,p1[r],p1[r+1]);b=max3f(b,p1[r+2],p1[r+3]);}
  const float m=max2f(a,b);
  auto rr=__builtin_amdgcn_permlane32_swap(__float_as_uint(m),__float_as_uint(m),false,false);
  return max2f(__uint_as_float(rr[0]),__uint_as_float(rr[1]));
}
__device__ __forceinline__ void pv(f32x16*o,int vb,bf16x8 pa0,bf16x8 pa1,bf16x8 pa2,bf16x8 pa3){
  #pragma unroll
  for(int d0=0;d0<2;++d0){s16x4 lo[4],hi[4];
    #pragma unroll
    for(int ks=0;ks<4;++ks){
      asm volatile("ds_read_b64_tr_b16 %0,%1 offset:%c2":"=&v"(lo[ks]):"v"(vb),"i"(d0*4096+ks*1024):"memory");
      asm volatile("ds_read_b64_tr_b16 %0,%1 offset:%c2":"=&v"(hi[ks]):"v"(vb),"i"(d0*4096+ks*1024+512):"memory");}
    asm volatile("s_waitcnt lgkmcnt(0)":::"memory");SBAR();
    #define PK(k) (bf16x8){lo[k][0],lo[k][1],lo[k][2],lo[k][3],hi[k][0],hi[k][1],hi[k][2],hi[k][3]}
    o[d0]=__builtin_amdgcn_mfma_f32_32x32x16_bf16(pa0,PK(0),o[d0],0,0,0);
    o[d0]=__builtin_amdgcn_mfma_f32_32x32x16_bf16(pa1,PK(1),o[d0],0,0,0);
    o[d0]=__builtin_amdgcn_mfma_f32_32x32x16_bf16(pa2,PK(2),o[d0],0,0,0);
    o[d0]=__builtin_amdgcn_mfma_f32_32x32x16_bf16(pa3,PK(3),o[d0],0,0,0);
    #undef PK
  }
}

#ifndef ATTN_STORE16
#define ATTN_STORE16(p,v) (*(u32x4*)(p)=(v))
#endif
template<int THRL,int PQ,int PK,int PV,int PO> __device__ __forceinline__ void attn_unit(int q0,const bf16*Qu,const bf16*__restrict__ Kh,const bf16*__restrict__ Vh,bf16*Ou,char*shm){
  int tid=threadIdx.x; asm volatile("":"+v"(tid)); const int lane=tid&63,r32=lane&31,hi=lane>>5; const int wid=__builtin_amdgcn_readfirstlane(tid>>6);
  const bf16*Qw=Qu+(long)(wid*QBLK)*PQ;
  const unsigned lds0=(unsigned)(uintptr_t)shm;
  float*wsf=(float*)(shm+LDS_WS)+wid*64;
  const bf16*ksrc=Kh+(long)lane*PK+wid*8;
  const bf16*vsrc=Vh+(long)(16*(wid&3)+(lane>>2))*PV+(wid>>2)*32+(lane&3)*8;
  const unsigned kdst=lds0+LDS_K+wid*1024, vdst=lds0+LDS_V+wid*1024;
  #define DMA_K(t,slot) glds16(ksrc+(long)(t)*KVBLK*PK,(unsigned)__builtin_amdgcn_readfirstlane(kdst+(slot)))
  #define DMA_V(t,slot) glds16(vsrc+(long)(t)*KVBLK*PV,(unsigned)__builtin_amdgcn_readfirstlane(vdst+(slot)))
  const int vb0=(int)(lds0+LDS_V)+((lane>>4)&1)*32+(lane&3)*8+(4*hi+((lane&15)>>2))*64;
  const char*Kbase=shm+LDS_K; bf16x8 kf[8];
  const lds_cptr shm3=(lds_cptr)shm; const lds_cptr kp0=shm3+LDS_K+hi*1024+r32*16; const lds_cptr vp0=shm3+LDS_V+((lane>>4)&1)*32+(lane&3)*8+(4*hi+((lane&15)>>2))*64;
  const int NT=(q0+QB)/KVBLK;
  DMA_K(0,0);DMA_V(0,0);DMA_K(1,SLOTB);
  bf16x8 qr[4];
  #pragma unroll
  for(int d0=0;d0<4;++d0)qr[d0]=*reinterpret_cast<const bf16x8*>(&Qw[(long)r32*PQ+d0*16+hi*8]);
  float mhat=0.f,l_reg=0.f;f32x16 o[2];o[0]=f32x16{};o[1]=f32x16{};f32x16 negm=f32x16{};asm volatile("":"+v"(negm));
  const int qrel=wid*QBLK+r32;
  #define CMASK(P0,P1,t) do{int jb_=(t)-(NT-4); if(jb_>=0)cmask(P0,P1,jb_,qrel,hi);}while(0)
  bool resc=false;
  #define START(P0,P1) do{ const float rm=rowmax(P0,P1); resc=false; \
    { const float dl=rm; mhat=fadd_s(mhat,dl); \
      _Pragma("unroll") for(int r=0;r<16;++r){P0[r]=fsub_s(P0[r],dl);P1[r]=fsub_s(P1[r],dl);} \
      _Pragma("unroll") for(int r=0;r<16;++r)negm[r]=-mhat; asm volatile("":"+v"(negm)); } \
    _Pragma("unroll") for(int r=0;r<16;++r)P0[r]=__builtin_amdgcn_exp2f(P0[r]); }while(0)
  #define RESC() do{ if(resc){ asm volatile("s_waitcnt lgkmcnt(0)":::"memory"); \
      _Pragma("unroll") for(int d_=0;d_<2;++d_) _Pragma("unroll") for(int r=0;r<16;++r)o[d_][r]*=wsf[crow(r,hi)]; } }while(0)
  f32x16 pA0,pA1,pB0,pB1;
  int sl_prev=0,sl_cur=0,sl_next=SLOTB;
  #define ROT() do{sl_prev=sl_cur;sl_cur=sl_next;sl_next=(sl_next==(NSLOT-1)*SLOTB)?0:sl_next+SLOTB;}while(0)
  DMA_K(2,2*SLOTB);
  WAIT_BAR(3);
  qkt(pA0,pA1,Kbase,qr,negm,r32,hi);asm volatile("s_nop 15\n\ts_nop 7":"+v"(pA0),"+v"(pA1));CMASK(pA0,pA1,0);
  START(pA0,pA1);
  _Pragma("unroll") for(int r=0;r<16;++r)pA1[r]=__builtin_amdgcn_exp2f(pA1[r]);
  WAIT_BAR(0);
  DMA_K(3,0);DMA_V(1,SLOTB);
  ROT();
  kload8(kf,kp0+sl_cur);
  WAIT_BAR(2);
  s16x4 vlo[8],vhi[8]; u32x4 pw0,pw1,pw2,pw3;
  #define PKW(P,B) cvtpk_s(P[B],P[B+1])
  #define PAF(k) __builtin_bit_cast(bf16x8,pw##k)
  #define VFR(i) (bf16x8){vlo[i][0],vlo[i][1],vlo[i][2],vlo[i][3],vhi[i][0],vhi[i][1],vhi[i][2],vhi[i][3]}
  #define PIN(x) asm volatile("":"+v"(x))
  #define MX3(a,b,c) __builtin_fmaxf(__builtin_fmaxf((a),(b)),(c))
  #define GAPA(MF,A0,A1,A2,A3,W0,W1,PW) do{ MF; sacc+=A0; sacc+=A1; sacc+=A2; sacc+=A3; PIN(sacc); W0; W1; PIN(PW); SBAR(); }while(0)
  #define EX(v) __builtin_amdgcn_exp2f(v)
  #define GAPB(MF,X,B) do{ MF; X[B]=EX(X[B]); X[B+1]=EX(X[B+1]); X[B+2]=EX(X[B+2]); X[B+3]=EX(X[B+3]); PIN(X); SBAR(); }while(0)
  #define VRD(i) do{ vlo[i]=vtr(vp_+(((i)>>2)*4096+((i)&3)*1024)); vhi[i]=vtr(vp_+(((i)>>2)*4096+((i)&3)*1024+512)); }while(0)
  #define KRD(G,j) do{ if(G){ kload2(kf,kp0+sl_next,j); SBAR(); } }while(0)
  #define STEP(C0,C1,P0,P1,t,GK,GV,GL) do{ SBAR(); \
    const lds_cptr vp_=vp0+sl_prev; \
    VRD(0); SBAR(); float sacc=(P0[0]+P0[1]); \
    GAPA(C0=__builtin_amdgcn_mfma_f32_32x32x16_bf16(kf[0],qr[0],negm,0,0,0), P0[2],P0[3],P0[4],P0[5],     pw0[0]=PKW(P0,0), pw0[1]=PKW(P0,2), pw0); \
    VRD(4); SBAR(); GAPA(C1=__builtin_amdgcn_mfma_f32_32x32x16_bf16(kf[1],qr[0],negm,0,0,0), P0[6],P0[7],P0[8],P0[9],     pw0[2]=PKW(P0,4), pw0[3]=PKW(P0,6), pw0); \
    VRD(1); SBAR(); GAPA(C0=__builtin_amdgcn_mfma_f32_32x32x16_bf16(kf[2],qr[1],C0,0,0,0),   P0[10],P0[11],P0[12],P0[13], pw1[0]=PKW(P0,8), pw1[1]=PKW(P0,10), pw1); \
    VRD(5); SBAR(); GAPA(C1=__builtin_amdgcn_mfma_f32_32x32x16_bf16(kf[3],qr[1],C1,0,0,0),   P0[14],P0[15],P1[0],P1[1],   pw1[2]=PKW(P0,12),pw1[3]=PKW(P0,14), pw1); \
    VRD(2); SBAR(); GAPA(C0=__builtin_amdgcn_mfma_f32_32x32x16_bf16(kf[4],qr[2],C0,0,0,0),   P1[2],P1[3],P1[4],P1[5],     pw2[0]=PKW(P1,0), pw2[1]=PKW(P1,2), pw2); \
    VRD(6); SBAR(); GAPA(C1=__builtin_amdgcn_mfma_f32_32x32x16_bf16(kf[5],qr[2],C1,0,0,0),   P1[6],P1[7],P1[8],P1[9],     pw2[2]=PKW(P1,4), pw2[3]=PKW(P1,6), pw2); \
    VRD(3); SBAR(); GAPA(C0=__builtin_amdgcn_mfma_f32_32x32x16_bf16(kf[6],qr[3],C0,0,0,0),   P1[10],P1[11],P1[12],P1[13], pw3[0]=PKW(P1,8), pw3[1]=PKW(P1,10), pw3); \
    VRD(7); SBAR(); GAPA(C1=__builtin_amdgcn_mfma_f32_32x32x16_bf16(kf[7],qr[3],C1,0,0,0),   P1[14],P1[15],0.f,0.f,       pw3[2]=PKW(P1,12),pw3[3]=PKW(P1,14), pw3); \
    l_reg+=sacc; \
    if(GK){DMA_K((t)+3,sl_cur);} if(GV){DMA_V((t)+1,sl_next);} \
    CMASK(C0,C1,t); \
    { float a=MX3(C0[0],C0[1],C1[0]),b=MX3(C0[2],C0[3],C1[1]); a=MX3(a,C1[2],C1[3]); \
      _Pragma("unroll") for(int r=4;r<16;r+=4){a=MX3(a,C0[r],C0[r+1]);b=MX3(b,C0[r+2],C0[r+3]);a=MX3(a,C1[r],C1[r+1]);b=MX3(b,C1[r+2],C1[r+3]);} \
      float rm=__builtin_fmaxf(a,b); { auto rr=__builtin_amdgcn_permlane32_swap(__float_as_uint(rm),__float_as_uint(rm),false,false); rm=__builtin_fmaxf(__uint_as_float(rr[0]),__uint_as_float(rr[1])); } \
      resc=false; \
      if(__builtin_expect(__any(rm>(float)THRL),0)){ const float dl=__builtin_fmaxf(rm,0.f); mhat+=dl; \
        _Pragma("unroll") for(int r=0;r<16;++r){C0[r]-=dl;C1[r]-=dl;} \
        _Pragma("unroll") for(int r=0;r<16;++r)negm[r]=-mhat; asm volatile("":"+v"(negm)); \
        const float f=__builtin_amdgcn_exp2f(-dl); l_reg*=f; if(hi==0)wsf[r32]=f; resc=true; } } \
    SBAR(); \
    GAPB(o[0]=__builtin_amdgcn_mfma_f32_32x32x16_bf16(PAF(0),VFR(0),o[0],0,0,0), C0,0); \
    GAPB(o[1]=__builtin_amdgcn_mfma_f32_32x32x16_bf16(PAF(0),VFR(4),o[1],0,0,0), C0,4); \
    KRD(GL,0); GAPB(o[0]=__builtin_amdgcn_mfma_f32_32x32x16_bf16(PAF(1),VFR(1),o[0],0,0,0), C0,8); \
    KRD(GL,1); GAPB(o[1]=__builtin_amdgcn_mfma_f32_32x32x16_bf16(PAF(1),VFR(5),o[1],0,0,0), C0,12); \
    KRD(GL,2); GAPB(o[0]=__builtin_amdgcn_mfma_f32_32x32x16_bf16(PAF(2),VFR(2),o[0],0,0,0), C1,0); \
    KRD(GL,3); GAPB(o[1]=__builtin_amdgcn_mfma_f32_32x32x16_bf16(PAF(2),VFR(6),o[1],0,0,0), C1,4); \
    GAPB(o[0]=__builtin_amdgcn_mfma_f32_32x32x16_bf16(PAF(3),VFR(3),o[0],0,0,0), C1,8); \
    GAPB(o[1]=__builtin_amdgcn_mfma_f32_32x32x16_bf16(PAF(3),VFR(7),o[1],0,0,0), C1,12); \
    }while(0)
  int t=1;
  #undef CMASK
  #define CMASK(P0,P1,t) do{}while(0)
  for(;t+5<NT;t+=2){
    STEP(pB0,pB1,pA0,pA1,t,true,true,true);     WAIT_BAR(2); RESC(); ROT();
    STEP(pA0,pA1,pB0,pB1,t+1,true,true,true);   WAIT_BAR(2); RESC(); ROT();
  }
  #undef CMASK
  #define CMASK(P0,P1,t) do{int jb_=(t)-(NT-4); if(jb_>=0)cmask(P0,P1,jb_,qrel,hi);}while(0)
  #define ENDW(tt) do{ if((tt)+3<NT){WAIT_BAR(2);} else if((tt)+2<NT){WAIT_BAR(1);} else {WAIT_BAR(0);} }while(0)
  for(;t+1<NT;t+=2){
    STEP(pB0,pB1,pA0,pA1,t,(t+3<NT),(t+1<NT),(t+1<NT));       ENDW(t);   RESC(); ROT();
    STEP(pA0,pA1,pB0,pB1,t+1,(t+4<NT),(t+2<NT),(t+2<NT));     ENDW(t+1); RESC(); ROT();
  }
  STEP(pB0,pB1,pA0,pA1,NT-1,false,false,false); RESC();
  { float sacc=pB0[0]+pB0[1]; _Pragma("unroll") for(int r=2;r<16;++r)sacc+=pB0[r]; _Pragma("unroll") for(int r=0;r<16;++r)sacc+=pB1[r]; l_reg+=sacc;
    pw0=(u32x4){PKW(pB0,0),PKW(pB0,2),PKW(pB0,4),PKW(pB0,6)};pw1=(u32x4){PKW(pB0,8),PKW(pB0,10),PKW(pB0,12),PKW(pB0,14)};pw2=(u32x4){PKW(pB1,0),PKW(pB1,2),PKW(pB1,4),PKW(pB1,6)};pw3=(u32x4){PKW(pB1,8),PKW(pB1,10),PKW(pB1,12),PKW(pB1,14)};
    SBAR(); pv(o,vb0+sl_cur,PAF(0),PAF(1),PAF(2),PAF(3)); }
  #undef PKW
  #undef PAF
  #undef VFR
  #undef PIN
  #undef MX3
  #undef GAPA
  #undef GAPB
  #undef EX
  #undef VRD
  #undef KRD
  #undef STEP
  #undef ENDW
  {auto rr=__builtin_amdgcn_permlane32_swap(__float_as_uint(l_reg),__float_as_uint(l_reg),false,false);l_reg=__uint_as_float(rr[0])+__uint_as_float(rr[1]);}
  if(hi==0)wsf[32+r32]=l_reg;asm volatile("s_waitcnt lgkmcnt(0)":::"memory");
  float rli[16];
  #pragma unroll
  for(int r=0;r<16;++r)rli[r]=__builtin_amdgcn_rcpf(wsf[32+crow(r,hi)]);
  bf16*Ow=Ou+(long)(wid*QBLK)*PO;
  { bf16*stg=(bf16*)(shm+LDS_OST)+wid*2048;
    #pragma unroll
    for(int r=0;r<16;++r){const int orow=crow(r,hi);
      #pragma unroll
      for(int d0=0;d0<2;++d0)stg[orow*64+d0*32+r32]=__float2bfloat16(o[d0][r]*rli[r]);}
    asm volatile("s_waitcnt lgkmcnt(0)":::"memory");
    #pragma unroll
    for(int i=0;i<4;++i){const int row=i*8+(lane>>3),ch=lane&7; const u32x4 v=*(const u32x4*)(stg+row*64+ch*8); ATTN_STORE16(Ow+(long)row*PO+ch*8,v);} }
  asm volatile("s_waitcnt lgkmcnt(0)\n\ts_barrier":::"memory");
  #undef DMA_K
  #undef DMA_V
  #undef CMASK
  #undef START
  #undef RESC
  #undef ROT
}
constexpr int VSLOTB=16384;
constexpr int L2_K=0, L2_V=NSLOT*SLOTB, L2_WS=L2_V+NSLOT*VSLOTB, L2_OST=L2_WS+NW*64*4, L2_QS=L2_OST+NW*4096, L2_BYTES=L2_QS+NW*4096;
__device__ __forceinline__ void pv128(f32x16*o,int vb,bf16x8 pa0,bf16x8 pa1,bf16x8 pa2,bf16x8 pa3){
  #pragma unroll
  for(int d0=0;d0<4;++d0){s16x4 lo[4],hi[4];
    #pragma unroll
    for(int ks=0;ks<4;++ks){
      asm volatile("ds_read_b64_tr_b16 %0,%1 offset:%c2":"=&v"(lo[ks]):"v"(vb),"i"(d0*4096+ks*1024):"memory");
      asm volatile("ds_read_b64_tr_b16 %0,%1 offset:%c2":"=&v"(hi[ks]):"v"(vb),"i"(d0*4096+ks*1024+512):"memory");}
    asm volatile("s_waitcnt lgkmcnt(0)":::"memory");SBAR();
    #define PK(k) (bf16x8){lo[k][0],lo[k][1],lo[k][2],lo[k][3],hi[k][0],hi[k][1],hi[k][2],hi[k][3]}
    o[d0]=__builtin_amdgcn_mfma_f32_32x32x16_bf16(pa0,PK(0),o[d0],0,0,0);
    o[d0]=__builtin_amdgcn_mfma_f32_32x32x16_bf16(pa1,PK(1),o[d0],0,0,0);
    o[d0]=__builtin_amdgcn_mfma_f32_32x32x16_bf16(pa2,PK(2),o[d0],0,0,0);
    o[d0]=__builtin_amdgcn_mfma_f32_32x32x16_bf16(pa3,PK(3),o[d0],0,0,0);
    #undef PK
  }
}
template<int THRL,int PQ,int PK,int PV,int PO> __device__ __forceinline__ void attn_unit128(int q0,const bf16*Qu,const bf16*__restrict__ Kh,const bf16*__restrict__ Vh,bf16*Ou,char*shm){
  int tid=threadIdx.x; asm volatile("":"+v"(tid)); const int lane=tid&63,r32=lane&31,hi=lane>>5; const int wid=__builtin_amdgcn_readfirstlane(tid>>6);
  const bf16*Qw=Qu+(long)(wid*QBLK)*PQ;
  const unsigned lds0=(unsigned)(uintptr_t)shm;
  float*wsf=(float*)(shm+L2_WS)+wid*64;
  const bf16*ksrc=Kh+(long)lane*PK+wid*8;
  const bf16*vsrc=Vh+(long)(16*(wid&3)+(lane>>2))*PV+(wid>>2)*32+(lane&3)*8;
  const unsigned kdst=lds0+L2_K+wid*1024, vdst=lds0+L2_V+wid*1024;
  #define DMA_K(t,slot) glds16(ksrc+(long)(t)*KVBLK*PK,(unsigned)__builtin_amdgcn_readfirstlane(kdst+(slot)))
  #define DMA_V(t,slot) do{ glds16(vsrc+(long)(t)*KVBLK*PV,(unsigned)__builtin_amdgcn_readfirstlane(vdst+2*(slot))); glds16(vsrc+(long)(t)*KVBLK*PV+64,(unsigned)__builtin_amdgcn_readfirstlane(vdst+2*(slot)+8192)); }while(0)
  const int vb0=(int)(lds0+L2_V)+((lane>>4)&1)*32+(lane&3)*8+(4*hi+((lane&15)>>2))*64;
  const char*Kbase=shm+L2_K; bf16x8 kf[8];
  const lds_cptr shm3=(lds_cptr)shm; const lds_cptr kp0=shm3+L2_K+hi*1024+r32*16; const lds_cptr vp0=shm3+L2_V+((lane>>4)&1)*32+(lane&3)*8+(4*hi+((lane&15)>>2))*64;
  const int NT=(q0+QB)/KVBLK;
  DMA_K(0,0);DMA_V(0,0);DMA_K(1,SLOTB);
  bf16x8 qr[4];
  #pragma unroll
  for(int d0=0;d0<4;++d0)qr[d0]=*(const __attribute__((address_space(1))) bf16x8*)(&Qw[(long)r32*PQ+d0*16+hi*8]);
  typedef __attribute__((address_space(3))) bf16x8* lds_q_ptr; const lds_q_ptr qsp=(lds_q_ptr)((__attribute__((address_space(3))) char*)shm+L2_QS+wid*4096+lane*16);
  #pragma unroll
  for(int d0=0;d0<4;++d0)qsp[d0*64]=qr[d0];
  #define QL(d0) (qsp[(d0)*64])
  float mhat=0.f,l_reg=0.f;f32x16 o[4];o[0]=f32x16{};o[1]=f32x16{};o[2]=f32x16{};o[3]=f32x16{};f32x16 negm=f32x16{};asm volatile("":"+v"(negm));
  const int qrel=wid*QBLK+r32;
  #define CMASK(P0,P1,t) do{int jb_=(t)-(NT-4); if(jb_>=0)cmask(P0,P1,jb_,qrel,hi);}while(0)
  bool resc=false;
  #define START(P0,P1) do{ const float rm=rowmax(P0,P1); resc=false; \
    { const float dl=rm; mhat=fadd_s(mhat,dl); \
      _Pragma("unroll") for(int r=0;r<16;++r){P0[r]=fsub_s(P0[r],dl);P1[r]=fsub_s(P1[r],dl);} \
      _Pragma("unroll") for(int r=0;r<16;++r)negm[r]=-mhat; asm volatile("":"+v"(negm)); } \
    _Pragma("unroll") for(int r=0;r<16;++r)P0[r]=__builtin_amdgcn_exp2f(P0[r]); }while(0)
  #define RESC() do{ if(resc){ asm volatile("s_waitcnt lgkmcnt(0)":::"memory"); \
      _Pragma("unroll") for(int d_=0;d_<4;++d_) _Pragma("unroll") for(int r=0;r<16;++r)o[d_][r]*=wsf[crow(r,hi)]; } }while(0)
  f32x16 pA0,pA1,pB0,pB1;
  int sl_prev=0,sl_cur=0,sl_next=SLOTB;
  #define ROT() do{sl_prev=sl_cur;sl_cur=sl_next;sl_next=(sl_next==(NSLOT-1)*SLOTB)?0:sl_next+SLOTB;}while(0)
  DMA_K(2,2*SLOTB);
  WAIT_BAR(3);
  qkt(pA0,pA1,Kbase,qr,negm,r32,hi);asm volatile("s_nop 15\n\ts_nop 7":"+v"(pA0),"+v"(pA1));CMASK(pA0,pA1,0);
  START(pA0,pA1);
  _Pragma("unroll") for(int r=0;r<16;++r)pA1[r]=__builtin_amdgcn_exp2f(pA1[r]);
  WAIT_BAR(0);
  DMA_K(3,0);DMA_V(1,SLOTB);
  ROT();
  kload8(kf,kp0+sl_cur);
  bf16x8 qa=QL(0), qb=QL(1);
  WAIT_BAR(3);
  s16x4 val,vah,vbl,vbh,vcl,vch,vdl,vdh; u32x4 pw0,pw1,pw2,pw3;
  #define PKW(P,B) cvtpk_s(P[B],P[B+1])
  #define PAF(k) __builtin_bit_cast(bf16x8,pw##k)
  #define PIN(x) asm volatile("":"+v"(x))
  #define MX3(a,b,c) __builtin_fmaxf(__builtin_fmaxf((a),(b)),(c))
  #define GAPA(MF,A0,A1,A2,A3,W0,W1,PW) do{ MF; sacc+=A0; sacc+=A1; sacc+=A2; sacc+=A3; PIN(sacc); W0; W1; PIN(PW); SBAR(); }while(0)
  #define EX(v) __builtin_amdgcn_exp2f(v)
  #define GAPB(MF,X,B) do{ MF; X[B]=EX(X[B]); X[B+1]=EX(X[B+1]); PIN(X); SBAR(); }while(0)
  #define VADDR(n) ((((n)&3)*4096)+(((n)>>2)*1024))
  #define VLD(S,n) do{ S##l=vtr(vp_+VADDR(n)); S##h=vtr(vp_+VADDR(n)+512); SBAR(); }while(0)
  #define VFRS(S) (bf16x8){S##l[0],S##l[1],S##l[2],S##l[3],S##h[0],S##h[1],S##h[2],S##h[3]}
  #define MF32(A,B,C) __builtin_amdgcn_mfma_f32_32x32x16_bf16(A,B,C,0,0,0)
  #define KRD(G,j) do{ if(G){ kload2(kf,kp0+sl_next,j); SBAR(); } }while(0)
  #define STEP(C0,C1,P0,P1,t,GK,GV,GL) do{ SBAR(); \
    const lds_cptr vp_=vp0+2*sl_prev; \
    float sacc=(P0[0]+P0[1]); \
    GAPA(C0=MF32(kf[0],qa,negm), P0[2],P0[3],P0[4],P0[5],     pw0[0]=PKW(P0,0), pw0[1]=PKW(P0,2), pw0); \
    GAPA(C1=MF32(kf[1],qa,negm), P0[6],P0[7],P0[8],P0[9],     pw0[2]=PKW(P0,4), pw0[3]=PKW(P0,6), pw0); \
    qa=QL(2); SBAR(); GAPA(C0=MF32(kf[2],qb,C0),     P0[10],P0[11],P0[12],P0[13], pw1[0]=PKW(P0,8), pw1[1]=PKW(P0,10), pw1); \
    GAPA(C1=MF32(kf[3],qb,C1),     P0[14],P0[15],P1[0],P1[1],   pw1[2]=PKW(P0,12),pw1[3]=PKW(P0,14), pw1); \
    qb=QL(3); SBAR(); GAPA(C0=MF32(kf[4],qa,C0),     P1[2],P1[3],P1[4],P1[5],     pw2[0]=PKW(P1,0), pw2[1]=PKW(P1,2), pw2); \
    GAPA(C1=MF32(kf[5],qa,C1),     P1[6],P1[7],P1[8],P1[9],     pw2[2]=PKW(P1,4), pw2[3]=PKW(P1,6), pw2); \
    GAPA(C0=MF32(kf[6],qb,C0),     P1[10],P1[11],P1[12],P1[13], pw3[0]=PKW(P1,8), pw3[1]=PKW(P1,10), pw3); \
    GAPA(C1=MF32(kf[7],qb,C1),     P1[14],P1[15],0.f,0.f,       pw3[2]=PKW(P1,12),pw3[3]=PKW(P1,14), pw3); \
    l_reg+=sacc; \
    VLD(va,0); VLD(vb,1); VLD(vc,2); \
    if(GK){DMA_K((t)+3,sl_cur);} if(GV){DMA_V((t)+1,sl_next);} \
    CMASK(C0,C1,t); \
    { float a=MX3(C0[0],C0[1],C1[0]),b=MX3(C0[2],C0[3],C1[1]); a=MX3(a,C1[2],C1[3]); \
      _Pragma("unroll") for(int r=4;r<16;r+=4){a=MX3(a,C0[r],C0[r+1]);b=MX3(b,C0[r+2],C0[r+3]);a=MX3(a,C1[r],C1[r+1]);b=MX3(b,C1[r+2],C1[r+3]);} \
      float rm=__builtin_fmaxf(a,b); { auto rr=__builtin_amdgcn_permlane32_swap(__float_as_uint(rm),__float_as_uint(rm),false,false); rm=__builtin_fmaxf(__uint_as_float(rr[0]),__uint_as_float(rr[1])); } \
      resc=false; \
      if(__builtin_expect(__any(rm>(float)THRL),0)){ const float dl=__builtin_fmaxf(rm,0.f); mhat+=dl; \
        _Pragma("unroll") for(int r=0;r<16;++r){C0[r]-=dl;C1[r]-=dl;} \
        _Pragma("unroll") for(int r=0;r<16;++r)negm[r]=-mhat; asm volatile("":"+v"(negm)); \
        const float f=__builtin_amdgcn_exp2f(-dl); l_reg*=f; if(hi==0)wsf[r32]=f; resc=true; } } \
    SBAR(); \
    VLD(vd,3); GAPB(o[0]=MF32(PAF(0),VFRS(va),o[0]), C0,0); \
    VLD(va,4); GAPB(o[1]=MF32(PAF(0),VFRS(vb),o[1]), C0,2); \
    VLD(vb,5); GAPB(o[2]=MF32(PAF(0),VFRS(vc),o[2]), C0,4); \
    VLD(vc,6); GAPB(o[3]=MF32(PAF(0),VFRS(vd),o[3]), C0,6); \
    VLD(vd,7); KRD(GL,0); GAPB(o[0]=MF32(PAF(1),VFRS(va),o[0]), C0,8); \
    VLD(va,8); KRD(GL,1); GAPB(o[1]=MF32(PAF(1),VFRS(vb),o[1]), C0,10); \
    VLD(vb,9); KRD(GL,2); GAPB(o[2]=MF32(PAF(1),VFRS(vc),o[2]), C0,12); \
    VLD(vc,10); KRD(GL,3); GAPB(o[3]=MF32(PAF(1),VFRS(vd),o[3]), C0,14); \
    VLD(vd,11); GAPB(o[0]=MF32(PAF(2),VFRS(va),o[0]), C1,0); \
    VLD(va,12); GAPB(o[1]=MF32(PAF(2),VFRS(vb),o[1]), C1,2); \
    VLD(vb,13); GAPB(o[2]=MF32(PAF(2),VFRS(vc),o[2]), C1,4); \
    VLD(vc,14); GAPB(o[3]=MF32(PAF(2),VFRS(vd),o[3]), C1,6); \
    VLD(vd,15); GAPB(o[0]=MF32(PAF(3),VFRS(va),o[0]), C1,8); \
    GAPB(o[1]=MF32(PAF(3),VFRS(vb),o[1]), C1,10); \
    GAPB(o[2]=MF32(PAF(3),VFRS(vc),o[2]), C1,12); \
    GAPB(o[3]=MF32(PAF(3),VFRS(vd),o[3]), C1,14); \
    qa=QL(0); qb=QL(1);   \
    }while(0)
  int t=1;
  #undef CMASK
  #define CMASK(P0,P1,t) do{}while(0)
  for(;t+5<NT;t+=2){
    STEP(pB0,pB1,pA0,pA1,t,true,true,true);     WAIT_BAR(3); RESC(); ROT();
    STEP(pA0,pA1,pB0,pB1,t+1,true,true,true);   WAIT_BAR(3); RESC(); ROT();
  }
  #undef CMASK
  #define CMASK(P0,P1,t) do{int jb_=(t)-(NT-4); if(jb_>=0)cmask(P0,P1,jb_,qrel,hi);}while(0)
  #define ENDW(tt) do{ if((tt)+3<NT){WAIT_BAR(3);} else if((tt)+2<NT){WAIT_BAR(2);} else {WAIT_BAR(0);} }while(0)
  for(;t+1<NT;t+=2){
    STEP(pB0,pB1,pA0,pA1,t,(t+3<NT),(t+1<NT),(t+1<NT));       ENDW(t);   RESC(); ROT();
    STEP(pA0,pA1,pB0,pB1,t+1,(t+4<NT),(t+2<NT),(t+2<NT));     ENDW(t+1); RESC(); ROT();
  }
  STEP(pB0,pB1,pA0,pA1,NT-1,false,false,false); RESC();
  { float sacc=pB0[0]+pB0[1]; _Pragma("unroll") for(int r=2;r<16;++r)sacc+=pB0[r]; _Pragma("unroll") for(int r=0;r<16;++r)sacc+=pB1[r]; l_reg+=sacc;
    pw0=(u32x4){PKW(pB0,0),PKW(pB0,2),PKW(pB0,4),PKW(pB0,6)};pw1=(u32x4){PKW(pB0,8),PKW(pB0,10),PKW(pB0,12),PKW(pB0,14)};pw2=(u32x4){PKW(pB1,0),PKW(pB1,2),PKW(pB1,4),PKW(pB1,6)};pw3=(u32x4){PKW(pB1,8),PKW(pB1,10),PKW(pB1,12),PKW(pB1,14)};
    SBAR(); pv128(o,vb0+2*sl_cur,PAF(0),PAF(1),PAF(2),PAF(3)); }
  #undef PKW
  #undef PAF
  #undef QL
  #undef VADDR
  #undef VLD
  #undef VFRS
  #undef MF32
  #undef PIN
  #undef MX3
  #undef GAPA
  #undef GAPB
  #undef EX
  #undef KRD
  #undef STEP
  #undef ENDW
  {auto rr=__builtin_amdgcn_permlane32_swap(__float_as_uint(l_reg),__float_as_uint(l_reg),false,false);l_reg=__uint_as_float(rr[0])+__uint_as_float(rr[1]);}
  if(hi==0)wsf[32+r32]=l_reg;asm volatile("s_waitcnt lgkmcnt(0)":::"memory");
  float rli[16];
  #pragma unroll
  for(int r=0;r<16;++r)rli[r]=__builtin_amdgcn_rcpf(wsf[32+crow(r,hi)]);
  bf16*Ow=Ou+(long)(wid*QBLK)*PO;
  { bf16*stg=(bf16*)(shm+L2_OST)+wid*2048;
    #pragma unroll
    for(int hp=0;hp<2;++hp){
      #pragma unroll
      for(int r=0;r<16;++r){const int orow=crow(r,hi);
        #pragma unroll
        for(int d0=0;d0<2;++d0)stg[orow*64+d0*32+r32]=__float2bfloat16(o[hp*2+d0][r]*rli[r]);}
      asm volatile("s_waitcnt lgkmcnt(0)":::"memory");
      #pragma unroll
      for(int i=0;i<4;++i){const int row=i*8+(lane>>3),ch=lane&7; const u32x4 v=*(const u32x4*)(stg+row*64+ch*8); *(__attribute__((address_space(1))) u32x4*)(Ow+(long)row*PO+hp*64+ch*8)=v;}
      asm volatile("s_waitcnt lgkmcnt(0)":::"memory");
    } }
  asm volatile("s_waitcnt lgkmcnt(0)\n\ts_barrier":::"memory");
  #undef DMA_K
  #undef DMA_V
  #undef CMASK
  #undef START
  #undef RESC
  #undef ROT
}
constexpr int ATTN_LDS_BYTES=LDS_BYTES;
#undef SBAR
#undef WAIT_BAR
}

#ifndef MK_MULTI
#define MK_MULTI 0
#endif
#ifndef REP_GEMM
#define REP_GEMM 1
#endif
#ifndef REP_ATTN
#define REP_ATTN 1
#endif
#ifndef REP_LIGHT
#define REP_LIGHT 1
#endif
#define LAS __attribute__((address_space(3)))
typedef unsigned short bf16;
typedef float f32x4 __attribute__((ext_vector_type(4)));
typedef unsigned u32x4 __attribute__((ext_vector_type(4)));
typedef unsigned u32x2 __attribute__((ext_vector_type(2)));
typedef short bf16x8 __attribute__((ext_vector_type(8)));
using pg8::cvt_pk_bf16;

constexpr int DM = 1024, NB = 4, SEQ = 8192, T = NB * SEQ, DEPTH = 2;
constexpr int NIN = 8704, NPROJ = 5632, NGATE = 3072;
constexpr float EPS = 1e-6f;
constexpr float C2 = 0.18033688011112042f;
__device__ const float LG2[4] = {-0.04580368961312479f, -0.02272007650008353f, -0.011315313227834146f, -0.005646563141142063f};
__device__ const float INV_A[8] = {1.0f, 0.19392274474868576f, 0.03760603093086393f, 0.007292664737217109f, 0.001414213562373095f, 0.0002742481756762073f, 5.318295896944988e-05f, 1.031338537721246e-05f};
__device__ const float INV_R[32] = {1.0f, 0.7429639507594948f, 0.551995432128157f, 0.41011270705513014f, 0.30469895709035083f, 0.22638034095214482f, 0.16819243248808696f, 0.1249609141291987f,
    0.09284145445194744f, 0.06897785379387654f, 0.05124805876960934f, 0.038075460212223716f, 0.028288694346259694f, 0.021017480113324882f, 0.015615230060004972f, 0.011601553017399714f,
    0.008619535664753033f, 0.006404004271197283f, 0.004757944314009409f, 0.0035349811050301057f, 0.0026263635276533325f, 0.0019512934226359642f, 0.0014497406703726315f, 0.001077105056036769f,
    0.0008002502278161052f, 0.0005945570708544394f, 0.00044173447031400687f, 0.0003281927872511474f, 0.0002438354098268829f, 0.00018116091942004152f, 0.00013459603241553644f, 0.0001f};

constexpr size_t MiB = 1u << 20;
constexpr size_t WS_WIN = 2 * MiB;
constexpr size_t WIN_L = (size_t)NIN * DM * 2;
constexpr size_t WS_WBR = 36 * MiB;
constexpr size_t WBR_L = (size_t)3 * DM * 512 * 2;
constexpr size_t WS_WOUT = 42 * MiB;
constexpr size_t WOUT_L = (size_t)DM * DM * 2;
constexpr size_t WS_ROPEA = 46 * MiB;
constexpr size_t WS_ROPER = 46 * MiB + 512 * 1024;
constexpr size_t WS_SSQ = 49 * MiB;
constexpr size_t WS_RSTD = 51 * MiB;
constexpr size_t WS_XB = 52 * MiB;
constexpr size_t WS_PREVT = 116 * MiB;
constexpr size_t WS_ACT = 148 * MiB;
constexpr size_t SEG512 = (size_t)T * 512 * 2;
constexpr size_t WS_QA = WS_ACT, WS_KA = WS_QA + SEG512, WS_VA = WS_KA + SEG512, WS_CX = WS_VA + SEG512, WS_CC = WS_CX + SEG512, WS_SCZ = WS_CC + SEG512,
                 WS_SZA = WS_SCZ + SEG512, WS_CB = WS_SZA + SEG512, WS_RQ = WS_CB + SEG512, WS_RK = WS_RQ + SEG512 / 2, WS_RV = WS_RK + SEG512 / 2, WS_SRZ = WS_RV + SEG512,
                 WS_END = WS_SRZ + SEG512;
constexpr size_t WS_G = WS_QA;
constexpr size_t WS_MERGED = WS_RQ;
constexpr size_t WS_KV = WS_CC;
constexpr size_t WS_OTMP = WS_CX;
static_assert(WS_END == 500 * MiB, "ws map");
constexpr int LDS_BYTES = 147456;
constexpr int NWAVES = 8;

__device__ __forceinline__ int orig_col(int p) {
    if (p < 1024) { int d = p & 63; if (d < 16) { const int blk = d >> 3, half = (d >> 2) & 1, e = d & 3; d = half * 8 + blk * 4 + e; } return (p & ~63) | d; }
    if (p >= 2048 && p < 4096) { const int r = p & 255; return 2048 + 512 * (r >> 6) + 64 * ((p - 2048) >> 8) + (r & 63); }
    if (p >= 4096 && p < 4608) { const int d = p & 63, blk = d >> 3, half = (d >> 2) & 1, e = d & 3; return (p & ~63) | (half * 32 + blk * 4 + e); }
    return p;
}
__device__ __forceinline__ float wave_sum(float v) {
#pragma unroll
    for (int o = 1; o < 64; o <<= 1) v += __shfl_xor(v, o);
    return v;
}
__device__ __forceinline__ float bf2f(unsigned short b) { return __uint_as_float((unsigned)b << 16); }
__device__ __forceinline__ float bflo(unsigned w) { return __uint_as_float(w << 16); }
__device__ __forceinline__ float bfhi(unsigned w) { return __uint_as_float(w & 0xffff0000u); }
__device__ __forceinline__ float sigmoidf_(float x) { return __builtin_amdgcn_rcpf(1.0f + __builtin_amdgcn_exp2f(-1.4426950408889634f * x)); }
__device__ __forceinline__ float siluf_(float x) { return x * sigmoidf_(x); }

__device__ __forceinline__ void unpack8(const u32x4 a, float (&o)[8]) { o[0] = bflo(a.x); o[1] = bfhi(a.x); o[2] = bflo(a.y); o[3] = bfhi(a.y); o[4] = bflo(a.z); o[5] = bfhi(a.z); o[6] = bflo(a.w); o[7] = bfhi(a.w); }
#define GAS __attribute__((address_space(1)))
#define EPI_FENCE() asm volatile("" ::: "memory")
__device__ __forceinline__ float ssq_sum(const f32x4 s0, const f32x4 s1, const f32x4 s2, const f32x4 s3) {
    return ((s0[0] + s0[1]) + (s0[2] + s0[3])) + ((s1[0] + s1[1]) + (s1[2] + s1[3])) + ((s2[0] + s2[1]) + (s2[2] + s2[3])) + ((s3[0] + s3[1]) + (s3[2] + s3[3]));
}
struct EpiProj {
    static constexpr bool PERM = true, AFTER_DRAIN = false;
    unsigned char* ws; const float* rstd; const float2* ropeA; const float2* ropeR;
    __device__ __forceinline__ bool keep(const pg8::Unit&) const { return false; }
    __device__ __forceinline__ void operator()(f32x4 (&acc)[2][2][4][2], const pg8::Unit& u, int wr, int wc, int fr, int fq) const {
        const int pn = u.pn;
        const int row0 = u.pm * 256 + wr * 64 + fr;
        if (pn >= 8 && pn < 16) {
            const bool isu = wc < 2;
            bf16* dstc = (bf16*)(ws + (isu ? WS_CX : WS_CB)) + (pn - 8) * 64 + (wc & 1) * 32 + 8 * fq;
            float rsv[8];
#pragma unroll
            for (int it = 0; it < 8; ++it) rsv[it] = ((const GAS float*)rstd)[row0 + (it >> 2) * 128 + (it & 3) * 16];
            EPI_FENCE();
#pragma unroll
            for (int it = 0; it < 8; ++it) {
                const int ai = it >> 2, m = it & 3, row = row0 + ai * 128 + m * 16;
                const float rs = rsv[it];
                f32x4 a0 = acc[ai][0][m][0] * rs, a1 = acc[ai][0][m][1] * rs, b0 = acc[ai][1][m][0] * rs, b1 = acc[ai][1][m][1] * rs;
                if (!isu) {
#pragma unroll
                    for (int e = 0; e < 4; ++e) { b0[e] = siluf_(b0[e]); b1[e] = siluf_(b1[e]); }
                }
                a0 = a0 * b0; a1 = a1 * b1;
                u32x4 w; w.x = cvt_pk_bf16(a0[0], a0[1]); w.y = cvt_pk_bf16(a0[2], a0[3]); w.z = cvt_pk_bf16(a1[0], a1[1]); w.w = cvt_pk_bf16(a1[2], a1[3]);
                *(GAS u32x4*)(dstc + (size_t)row * 512) = w;
            }
            return;
        }
        int seg, lt;
        if (pn < 16) { seg = pn >> 1; lt = pn & 1; } else if (pn < 18) { seg = 8 + (pn - 16); lt = 0; } else { seg = 10 + ((pn - 18) >> 1); lt = (pn - 18) & 1; }
        size_t off; int pitch = 512;
        switch (seg) {
            case 0: off = WS_QA; break; case 1: off = WS_KA; break; case 2: off = WS_VA; break; case 3: off = WS_SZA; break;
            case 8: off = WS_RQ; pitch = 256; break; case 9: off = WS_RK; pitch = 256; break; case 10: off = WS_RV; break; default: off = WS_SRZ; break;
        }
        bf16* dst = (bf16*)(ws + off);
        const int lc0 = lt * 256 + wc * 32 + 8 * fq;
        const int ropemode = (seg <= 1) ? (((wc & 1) == 0 && fq < 2) ? 1 : 0) : ((seg == 8 || seg == 9) ? 2 : 0);
        const bool dosilu = (seg == 3 || seg == 11);
        const float scale = (seg == 0) ? C2 : ((seg == 9) ? 0.125f : 1.0f);
        const float* ropebase = (ropemode == 1) ? (const float*)(ropeA + 4 * fq) : (const float*)(ropeR + (4 * (wc & 1) + fq) * 4);
        const int ropepitch = (ropemode == 1) ? 16 : 64;
        f32x4 cr0 = (f32x4){0.f, 0.f, 0.f, 0.f}, cr1 = cr0;
        float rsv[8];
#pragma unroll
        for (int it = 0; it < 8; ++it) rsv[it] = ((const GAS float*)rstd)[row0 + (it >> 2) * 128 + (it & 3) * 16];
        { if (ropemode) { const GAS f32x4* rp = (const GAS f32x4*)(ropebase + (size_t)(row0 & (SEQ - 1)) * ropepitch); cr0 = rp[0]; cr1 = rp[1]; } }
#pragma unroll
        for (int it = 0; it < 8; ++it) {
            const int ai = it >> 2, m = it & 3, row = row0 + ai * 128 + m * 16;
            f32x4 nr0 = cr0, nr1 = cr1;
            if (it < 7) { const int rn = row0 + ((it + 1) >> 2) * 128 + ((it + 1) & 3) * 16;
                if (ropemode) { const GAS f32x4* rp = (const GAS f32x4*)(ropebase + (size_t)(rn & (SEQ - 1)) * ropepitch); nr0 = rp[0]; nr1 = rp[1]; } }
            EPI_FENCE();
            const float rs = rsv[it] * scale;
#pragma unroll
            for (int bj = 0; bj < 2; ++bj) {
                f32x4 v0 = acc[ai][bj][m][0] * rs, v1 = acc[ai][bj][m][1] * rs;
                if (ropemode) {
                    const float cs[8] = {cr0[0], cr0[1], cr0[2], cr0[3], cr1[0], cr1[1], cr1[2], cr1[3]};
#pragma unroll
                    for (int e = 0; e < 4; ++e) { const float c = cs[2 * e], s = cs[2 * e + 1], x1 = v0[e], x2 = v1[e]; v0[e] = x1 * c - x2 * s; v1[e] = x2 * c + x1 * s; }
                }
                if (dosilu) {
#pragma unroll
                    for (int e = 0; e < 4; ++e) { v0[e] = siluf_(v0[e]); v1[e] = siluf_(v1[e]); }
                }
                u32x4 w; w.x = cvt_pk_bf16(v0[0], v0[1]); w.y = cvt_pk_bf16(v0[2], v0[3]); w.z = cvt_pk_bf16(v1[0], v1[1]); w.w = cvt_pk_bf16(v1[2], v1[3]);
                *(GAS u32x4*)(dst + (size_t)row * pitch + lc0 + bj * 128) = w;
            }
            cr0 = nr0; cr1 = nr1;
        }
    }
};
struct EpiGate {
    static constexpr bool PERM = true, AFTER_DRAIN = false;
    bf16* G; const float* rstd;
    __device__ __forceinline__ bool keep(const pg8::Unit&) const { return false; }
    __device__ __forceinline__ void operator()(f32x4 (&acc)[2][2][4][2], const pg8::Unit& u, int wr, int wc, int fr, int fq) const {
        const int col0 = u.pn * 256 + wc * 32 + 8 * fq, row0 = u.pm * 256 + wr * 64 + fr;
        float rsv[8];
#pragma unroll
        for (int it = 0; it < 8; ++it) rsv[it] = ((const GAS float*)rstd)[row0 + (it >> 2) * 128 + (it & 3) * 16] * -1.4426950408889634f;
        EPI_FENCE();
#pragma unroll
        for (int it = 0; it < 8; ++it) {
            const int ai = it >> 2, m = it & 3, row = row0 + ai * 128 + m * 16;
            const float rs = rsv[it];
#pragma unroll
            for (int bj = 0; bj < 2; ++bj) {
                f32x4 v0 = acc[ai][bj][m][0] * rs, v1 = acc[ai][bj][m][1] * rs;
#pragma unroll
                for (int e = 0; e < 4; ++e) { v0[e] = fmaxf(__builtin_amdgcn_rcpf(1.0f + __builtin_amdgcn_exp2f(v0[e])), 1e-30f); v1[e] = fmaxf(__builtin_amdgcn_rcpf(1.0f + __builtin_amdgcn_exp2f(v1[e])), 1e-30f); }
                u32x4 w; w.x = cvt_pk_bf16(v0[0], v0[1]); w.y = cvt_pk_bf16(v0[2], v0[3]); w.z = cvt_pk_bf16(v1[0], v1[1]); w.w = cvt_pk_bf16(v1[2], v1[3]);
                *(GAS u32x4*)(G + (size_t)row * NGATE + col0 + bj * 128) = w;
            }
        }
    }
};
struct EpiChain {
    static constexpr bool PERM = true, AFTER_DRAIN = false;
    const bf16* G; bf16* out;
    __device__ __forceinline__ bool keep(const pg8::Unit& u) const { return u.seg != 2; }
    __device__ __forceinline__ void operator()(f32x4 (&acc)[2][2][4][2], const pg8::Unit& u, int wr, int wc, int fr, int fq) const {
        const int col0 = u.pn * 256 + wc * 32 + 8 * fq, row0 = u.pm * 256 + wr * 64 + fr;
        const int seg = u.seg;
        const bf16* gbase = G + seg * DM + col0;
        u32x4 ga[2], gb[2];
#pragma unroll
        for (int bj = 0; bj < 2; ++bj) { const bf16* gp = gbase + (size_t)row0 * NGATE + bj * 128; ga[bj] = *(const GAS u32x4*)gp; gb[bj] = ga[bj]; if (seg != 2) gb[bj] = *(const GAS u32x4*)(gp + DM); }
#pragma unroll
        for (int it = 0; it < 8; ++it) {
            const int ai = it >> 2, m = it & 3, row = row0 + ai * 128 + m * 16;
            u32x4 na[2] = {ga[0], ga[1]}, nb[2] = {gb[0], gb[1]};
            if (it < 7) { const int rn = row0 + ((it + 1) >> 2) * 128 + ((it + 1) & 3) * 16;
#pragma unroll
                for (int bj = 0; bj < 2; ++bj) { const bf16* gp = gbase + (size_t)rn * NGATE + bj * 128; na[bj] = *(const GAS u32x4*)gp; nb[bj] = na[bj]; if (seg != 2) nb[bj] = *(const GAS u32x4*)(gp + DM); } }
            EPI_FENCE();
#pragma unroll
            for (int bj = 0; bj < 2; ++bj) {
                float f[8]; unpack8(ga[bj], f);
                if (seg != 2) {
                    float h[8]; unpack8(gb[bj], h);
#pragma unroll
                    for (int e = 0; e < 8; ++e) f[e] = f[e] * __builtin_amdgcn_rcpf(h[e]);
                }
                f32x4 v0 = acc[ai][bj][m][0], v1 = acc[ai][bj][m][1];
#pragma unroll
                for (int e = 0; e < 4; ++e) { v0[e] *= f[e]; v1[e] *= f[4 + e]; }
                if (seg != 2) { acc[ai][bj][m][0] = v0; acc[ai][bj][m][1] = v1; }
                else {
                    u32x4 w; w.x = cvt_pk_bf16(v0[0], v0[1]); w.y = cvt_pk_bf16(v0[2], v0[3]); w.z = cvt_pk_bf16(v1[0], v1[1]); w.w = cvt_pk_bf16(v1[2], v1[3]);
                    *(GAS u32x4*)(out + (size_t)row * DM + col0 + bj * 128) = w;
                }
            }
            ga[0] = na[0]; ga[1] = na[1]; gb[0] = nb[0]; gb[1] = nb[1];
        }
    }
};
struct ChainOrder {
    pg8::StaticOrder S;
    __device__ bool next(int i, pg8::Unit& u) const { if (!S.next(i / 3, u)) return false; u.seg = i % 3; return true; }
    __device__ __forceinline__ void a_ready(const pg8::Unit&) const {}
    __device__ __forceinline__ void done(const pg8::Unit&) const {}
};
template <bool LAST> struct EpiOutT {
    static constexpr bool PERM = true, AFTER_DRAIN = false;
    const float* xres; const bf16* xbres; float* xout; bf16* xb; float* ssq;
    __device__ __forceinline__ bool keep(const pg8::Unit&) const { return false; }
    __device__ __forceinline__ void operator()(f32x4 (&acc)[2][2][4][2], const pg8::Unit& u, int wr, int wc, int fr, int fq) const {
        const int col0 = u.pn * 256 + wc * 32 + 8 * fq, row0 = u.pm * 256 + wr * 64 + fr;
        f32x4 r[4]; u32x4 rb[2];
#pragma unroll
        for (int bj = 0; bj < 2; ++bj) {
            if (LAST) rb[bj] = *(const GAS u32x4*)(xbres + (size_t)row0 * DM + col0 + bj * 128);
            else { const float* p = xres + (size_t)row0 * DM + col0 + bj * 128; r[2 * bj] = *(const GAS f32x4*)p; r[2 * bj + 1] = *(const GAS f32x4*)(p + 4); } }
#pragma unroll
        for (int it = 0; it < 8; ++it) {
            const int ai = it >> 2, m = it & 3, row = row0 + ai * 128 + m * 16;
            f32x4 nr[4] = {r[0], r[1], r[2], r[3]}; u32x4 nrb[2] = {rb[0], rb[1]};
            if (it < 7) { const int rn = row0 + ((it + 1) >> 2) * 128 + ((it + 1) & 3) * 16;
#pragma unroll
                for (int bj = 0; bj < 2; ++bj) {
                    if (LAST) nrb[bj] = *(const GAS u32x4*)(xbres + (size_t)rn * DM + col0 + bj * 128);
                    else { const float* p = xres + (size_t)rn * DM + col0 + bj * 128; nr[2 * bj] = *(const GAS f32x4*)p; nr[2 * bj + 1] = *(const GAS f32x4*)(p + 4); } } }
            EPI_FENCE();
            float q = 0.f;
#pragma unroll
            for (int bj = 0; bj < 2; ++bj) {
                const size_t o = (size_t)row * DM + col0 + bj * 128;
                f32x4 r0, r1;
                if (LAST) { r0 = (f32x4){bflo(rb[bj].x), bfhi(rb[bj].x), bflo(rb[bj].y), bfhi(rb[bj].y)}; r1 = (f32x4){bflo(rb[bj].z), bfhi(rb[bj].z), bflo(rb[bj].w), bfhi(rb[bj].w)}; }
                else { r0 = r[2 * bj]; r1 = r[2 * bj + 1]; }
                const f32x4 v0 = acc[ai][bj][m][0] + r0, v1 = acc[ai][bj][m][1] + r1;
                q += ((v0[0] * v0[0] + v0[1] * v0[1]) + (v0[2] * v0[2] + v0[3] * v0[3])) + ((v1[0] * v1[0] + v1[1] * v1[1]) + (v1[2] * v1[2] + v1[3] * v1[3]));
                { u32x4 w; w.x = cvt_pk_bf16(v0[0], v0[1]); w.y = cvt_pk_bf16(v0[2], v0[3]); w.z = cvt_pk_bf16(v1[0], v1[1]); w.w = cvt_pk_bf16(v1[2], v1[3]);
                    *(GAS u32x4*)(xb + o) = w; }
            }
            q += __shfl_xor(q, 16); q += __shfl_xor(q, 32);
            if (fq == 0) ((GAS float*)ssq)[(size_t)row * 16 + u.pn * 4 + wc] = q;
            r[0] = nr[0]; r[1] = nr[1]; r[2] = nr[2]; r[3] = nr[3]; rb[0] = nrb[0]; rb[1] = nrb[1];
        }
    }
};

template <bool PERMUTE>
__device__ __forceinline__ void p0_transpose_item(const float* W, int K, int N, bf16* WT, const float* gk, LAS float* scr, int item, int lane) {
    const int nblk = N / 32, kb = item / nblk, nb = item % nblk, k0 = 64 * kb, n0 = 32 * nb;
    const int kr = lane >> 3, c4 = lane & 7;
    const int nsrc = PERMUTE ? orig_col(n0 + 4 * c4) : (n0 + 4 * c4);
    f32x4 wv[8];
#pragma unroll
    for (int i = 0; i < 8; ++i) wv[i] = *(const GAS f32x4*)(W + (size_t)(k0 + 8 * i + kr) * N + nsrc);
#pragma unroll
    for (int i = 0; i < 8; ++i) { const int kk = 8 * i + kr; f32x4 v = wv[i]; if (gk) v = v * gk[k0 + kk];
        LAS float* d = scr + kk * 33 + 4 * c4; d[0] = v[0]; d[1] = v[1]; d[2] = v[2]; d[3] = v[3]; }
    asm volatile("s_waitcnt lgkmcnt(0)" ::: "memory");
    const int c = lane & 7;
#pragma unroll
    for (int j = 0; j < 4; ++j) { const int n = (lane >> 3) + 8 * j; const LAS float* s = scr + (8 * c) * 33 + n;
        u32x4 o; o.x = cvt_pk_bf16(s[0 * 33], s[1 * 33]); o.y = cvt_pk_bf16(s[2 * 33], s[3 * 33]); o.z = cvt_pk_bf16(s[4 * 33], s[5 * 33]); o.w = cvt_pk_bf16(s[6 * 33], s[7 * 33]);
        *(GAS u32x4*)(WT + (size_t)(n0 + n) * K + k0 + 8 * c) = o; }
    asm volatile("s_waitcnt lgkmcnt(0)" ::: "memory");
}

struct Args { const float* in[9]; float* out; unsigned char* ws; int ph_lo, ph_hi; };

__device__ __forceinline__ void phase_prologue(const Args& a, LAS unsigned char* lds, int vcu, int G, int wave, int lane) {
    unsigned char* ws = a.ws;
    LAS float* scr = (LAS float*)(lds + wave * 16384);
    const int gw = vcu * NWAVES + wave, NGW = G * NWAVES;
    constexpr int I_IN = (DM / 64) * (NIN / 32), I_BR = (512 / 64) * (DM / 32), I_OUT = (DM / 64) * (DM / 32), I_L = I_IN + 3 * I_BR + I_OUT;
    for (int it = gw; it < DEPTH * I_L; it += NGW) {
        const int l = it / I_L; int r = it % I_L;
        if (r < I_IN) { p0_transpose_item<true>(a.in[2] + (size_t)l * DM * NIN, DM, NIN, (bf16*)(ws + WS_WIN + l * WIN_L), a.in[1] + l * DM, scr, r, lane); continue; } r -= I_IN;
        if (r < 3 * I_BR) { const int i = r / I_BR; p0_transpose_item<false>(a.in[6] + ((size_t)l * 3 + i) * 512 * DM, 512, DM, (bf16*)(ws + WS_WBR + l * WBR_L) + (size_t)i * DM * 512, nullptr, scr, r % I_BR, lane); continue; } r -= 3 * I_BR;
        p0_transpose_item<false>(a.in[7] + (size_t)l * DM * DM, DM, DM, (bf16*)(ws + WS_WOUT + l * WOUT_L), nullptr, scr, r, lane);
    }
    const float* x = a.in[0]; bf16* xb = (bf16*)(ws + WS_XB); float* ssq = (float*)(ws + WS_SSQ);
    for (int m0 = gw * 4; m0 < T; m0 += NGW * 4) {
        f32x4 v[4][4];
#pragma unroll
        for (int r = 0; r < 4; ++r) { const GAS f32x4* xr = (const GAS f32x4*)(x + (size_t)(m0 + r) * DM) + lane;
#pragma unroll
            for (int j = 0; j < 4; ++j) v[r][j] = xr[64 * j]; }
#pragma unroll
        for (int r = 0; r < 4; ++r) {
            float s = 0.f;
#pragma unroll
            for (int j = 0; j < 4; ++j) s += (v[r][j][0] * v[r][j][0] + v[r][j][1] * v[r][j][1]) + (v[r][j][2] * v[r][j][2] + v[r][j][3] * v[r][j][3]);
            s = wave_sum(s);
            GAS u32x2* o8 = (GAS u32x2*)(xb + (size_t)(m0 + r) * DM) + lane;
#pragma unroll
            for (int j = 0; j < 4; ++j) { u32x2 w; w.x = cvt_pk_bf16(v[r][j][0], v[r][j][1]); w.y = cvt_pk_bf16(v[r][j][2], v[r][j][3]); o8[64 * j] = w; }
            if (lane == 0) ((GAS float*)(ws + WS_RSTD))[m0 + r] = __builtin_amdgcn_rsqf(s * (1.0f / DM) + EPS);
        }
    }
    float2* ropeA = (float2*)(ws + WS_ROPEA); float2* ropeR = (float2*)(ws + WS_ROPER);
    const int gt = gw * 64 + lane, NT_ = NGW * 64;
    for (int i = gt; i < SEQ * 40; i += NT_) {
        float inv; float2* dst;
        if (i < SEQ * 8) { inv = INV_A[i & 7]; dst = ropeA + i; } else { const int k = i - SEQ * 8; inv = INV_R[k & 31]; dst = ropeR + k; }
        const int pos = (i < SEQ * 8) ? (i >> 3) : ((i - SEQ * 8) >> 5);
        const float ang = (float)pos * inv;
        double rev = (double)ang * 0.15915494309189533577; rev -= __builtin_rint(rev);
        const float rf = (float)rev;
        { typedef float f32x2v __attribute__((ext_vector_type(2))); *(GAS f32x2v*)dst = (f32x2v){__builtin_amdgcn_cosf(rf), __builtin_amdgcn_sinf(rf)}; }
    }
}

__device__ __forceinline__ void conv_item(unsigned char* ws, const float* cw, int item, int tid) {
    const bf16* U = (const bf16*)(ws + WS_CX); bf16* GB = (bf16*)(ws + WS_CB);
    const int ch = (tid & 63) * 8, t0 = item * 64 + (tid >> 6) * 8;
    float w0[8], w1[8], w2[8];
#pragma unroll
    for (int e = 0; e < 8; ++e) { w0[e] = cw[ch + e]; w1[e] = cw[512 + ch + e]; w2[e] = cw[1024 + ch + e]; }
    float um2[8], um1[8];
#pragma unroll
    for (int e = 0; e < 8; ++e) { um2[e] = 0.f; um1[e] = 0.f; }
    if ((t0 & (SEQ - 1)) >= 2) { unpack8(*(const GAS u32x4*)(U + (size_t)(t0 - 2) * 512 + ch), um2); unpack8(*(const GAS u32x4*)(U + (size_t)(t0 - 1) * 512 + ch), um1); }
    u32x4 ua[8], ga[8];
#pragma unroll
    for (int i = 0; i < 8; ++i) { const size_t o = (size_t)(t0 + i) * 512 + ch; ua[i] = *(const GAS u32x4*)(U + o); ga[i] = *(const GAS u32x4*)(GB + o); }
#pragma unroll
    for (int i = 0; i < 8; ++i) {
        float u[8], gb[8], y[8]; unpack8(ua[i], u); unpack8(ga[i], gb);
#pragma unroll
        for (int e = 0; e < 8; ++e) { y[e] = gb[e] * (w0[e] * um2[e] + w1[e] * um1[e] + w2[e] * u[e]); um2[e] = um1[e]; um1[e] = u[e]; }
        u32x4 w; w.x = cvt_pk_bf16(y[0], y[1]); w.y = cvt_pk_bf16(y[2], y[3]); w.z = cvt_pk_bf16(y[4], y[5]); w.w = cvt_pk_bf16(y[6], y[7]);
        *(GAS u32x4*)(GB + (size_t)(t0 + i) * 512 + ch) = w;
    }
}

constexpr int R_SQ = 0, R_SK = 18432, R_SVT = 36864, R_SPT = 71680, R_SP = 90112;
__device__ __forceinline__ bf16x8 lds_frag(LAS const unsigned char* p) { return *(LAS const bf16x8*)p; }

struct RetV { u32x4 v[4]; };
__device__ __forceinline__ void load_v(RetV& r, const bf16* Rv, int t0, int h, int tid) {
#pragma unroll
    for (int i = 0; i < 4; ++i) { const int id = tid + i * 512, m = id & 127, chn = id >> 7; r.v[i] = *(const GAS u32x4*)(Rv + (size_t)(t0 + m) * 512 + h * 128 + chn * 8); }
}
__device__ __forceinline__ void stage_vT(LAS unsigned char* lds, const RetV& r, int tid) {
#pragma unroll
    for (int i = 0; i < 4; ++i) {
        const int id = tid + i * 512, m = id & 127, chn = id >> 7; const u32x4 v = r.v[i];
        LAS bf16* d = (LAS bf16*)(lds + R_SVT) + (chn * 8) * 136 + m;
        d[0 * 136] = (bf16)(v.x & 0xffff); d[1 * 136] = (bf16)(v.x >> 16); d[2 * 136] = (bf16)(v.y & 0xffff); d[3 * 136] = (bf16)(v.y >> 16);
        d[4 * 136] = (bf16)(v.z & 0xffff); d[5 * 136] = (bf16)(v.z >> 16); d[6 * 136] = (bf16)(v.w & 0xffff); d[7 * 136] = (bf16)(v.w >> 16);
    }
}
struct RetK { u32x4 k[2]; };
__device__ __forceinline__ void retkv_load(unsigned char* ws, int item, int tid, RetV& rv, RetK& rk) {
    const int bh = item >> 6, n = item & 63, b = bh >> 2, h = bh & 3, t0 = b * SEQ + n * 128;
    load_v(rv, (const bf16*)(ws + WS_RV), t0, h, tid);
    const bf16* Rk = (const bf16*)(ws + WS_RK);
#pragma unroll
    for (int i = 0; i < 2; ++i) { const int id = tid + i * 512, m = id & 127, chn = id >> 7; rk.k[i] = *(const GAS u32x4*)(Rk + (size_t)(t0 + m) * 256 + h * 64 + chn * 8); }
}
__device__ __forceinline__ void retkv_items(unsigned char* ws, LAS unsigned char* lds, int first, int stride, int tid, int wave, int lane) {
    RetV rv; RetK rk;
    if (first < 1024) retkv_load(ws, first, tid, rv, rk);
    for (int item = first; item < 1024; item += stride) {
        const int h = (item >> 6) & 3;
        float* KV = (float*)(ws + WS_KV) + (size_t)item * 8192;
        const float lg = LG2[h];
        stage_vT(lds, rv, tid);
#pragma unroll
        for (int i = 0; i < 2; ++i) {
            const int id = tid + i * 512, m = id & 127, chn = id >> 7; const u32x4 v = rk.k[i];
            const float z = exp2f((float)(127 - m) * lg);
            LAS bf16* d = (LAS bf16*)(lds + R_SQ) + (chn * 8) * 136 + m;
            const unsigned p0 = cvt_pk_bf16(bflo(v.x) * z, bfhi(v.x) * z), p1 = cvt_pk_bf16(bflo(v.y) * z, bfhi(v.y) * z), p2 = cvt_pk_bf16(bflo(v.z) * z, bfhi(v.z) * z), p3 = cvt_pk_bf16(bflo(v.w) * z, bfhi(v.w) * z);
            d[0 * 136] = (bf16)(p0 & 0xffff); d[1 * 136] = (bf16)(p0 >> 16); d[2 * 136] = (bf16)(p1 & 0xffff); d[3 * 136] = (bf16)(p1 >> 16);
            d[4 * 136] = (bf16)(p2 & 0xffff); d[5 * 136] = (bf16)(p2 >> 16); d[6 * 136] = (bf16)(p3 & 0xffff); d[7 * 136] = (bf16)(p3 >> 16);
        }
        if (item + stride < 1024) retkv_load(ws, item + stride, tid, rv, rk);
        __syncthreads();
        const int dt = wave & 3, eg = wave >> 2, lr = lane & 15, lq = lane >> 4;
        f32x4 acc[4];
#pragma unroll
        for (int j = 0; j < 4; ++j) acc[j] = (f32x4){0.f, 0.f, 0.f, 0.f};
#pragma unroll
        for (int kk = 0; kk < 4; ++kk) {
            const bf16x8 af = lds_frag(lds + R_SQ + ((dt * 16 + lr) * 136 + kk * 32 + 8 * lq) * 2);
#pragma unroll
            for (int j = 0; j < 4; ++j) {
                const bf16x8 bfr = lds_frag(lds + R_SVT + (((eg * 4 + j) * 16 + lr) * 136 + kk * 32 + 8 * lq) * 2);
                acc[j] = __builtin_amdgcn_mfma_f32_16x16x32_bf16(af, bfr, acc[j], 0, 0, 0);
            }
        }
#pragma unroll
        for (int j = 0; j < 4; ++j) *(GAS f32x4*)(KV + (size_t)((eg * 4 + j) * 16 + lr) * 64 + dt * 16 + lq * 4) = acc[j];
        __syncthreads();
    }
}
__device__ __forceinline__ void scan_phase(unsigned char* ws, int vcu, int G, int tid, size_t dst_off = WS_PREVT) {
    const float* KV = (const float*)(ws + WS_KV); bf16* DST = (bf16*)(ws + dst_off);
    for (int gid = vcu * 512 + tid; gid < 16 * 8192; gid += G * 512) {
        const int bh = gid >> 13, rem = gid & 8191, h = bh & 3;
        const float decay = exp2f(128.0f * LG2[h]);
        const GAS float* p = (const GAS float*)(KV + ((size_t)bh * 64) * 8192 + rem); GAS bf16* pd = (GAS bf16*)(DST + ((size_t)bh * 64) * 8192 + rem);
        float st = 0.f;
#pragma unroll
        for (int n0 = 0; n0 < 64; n0 += 16) {
            float kv[16];
#pragma unroll
            for (int j = 0; j < 16; ++j) kv[j] = p[(size_t)(n0 + j) * 8192];
#pragma unroll
            for (int j = 0; j < 16; ++j) { pd[(size_t)(n0 + j) * 8192] = (bf16)(cvt_pk_bf16(st, 0.f) & 0xffff); st = decay * st + kv[j]; }
        }
    }
}
struct RetQKP { u32x4 q[2], k[2]; };
__device__ __forceinline__ void retout_load(unsigned char* ws, int item, int tid, RetV& rv) {
    const int bh = item >> 6, n = item & 63, b = bh >> 2, h = bh & 3, t0 = b * SEQ + n * 128;
    load_v(rv, (const bf16*)(ws + WS_RV), t0, h, tid);
}
__device__ __forceinline__ void retout_load_qk(unsigned char* ws, int item, int tid, RetQKP& r) {
    const int bh = item >> 6, n = item & 63, b = bh >> 2, h = bh & 3, t0 = b * SEQ + n * 128;
    const bf16* Rq = (const bf16*)(ws + WS_RQ); const bf16* Rk = (const bf16*)(ws + WS_RK);
#pragma unroll
    for (int i = 0; i < 2; ++i) {
        const int id = tid + i * 512, row = id >> 3, chn = id & 7;
        r.q[i] = *(const GAS u32x4*)(Rq + (size_t)(t0 + row) * 256 + h * 64 + chn * 8);
        r.k[i] = *(const GAS u32x4*)(Rk + (size_t)(t0 + row) * 256 + h * 64 + chn * 8);
    }
}
__device__ __forceinline__ void retout_item(unsigned char* ws, LAS unsigned char* lds, int item, int next_item, RetV& rv, int tid, int wave, int lane, size_t dst_off = WS_SRZ) {
    const int bh = item >> 6, n = item & 63, b = bh >> 2, h = bh & 3, t0 = b * SEQ + n * 128;
    const bf16* Z = (const bf16*)(ws + WS_SRZ); bf16* R = (bf16*)(ws + dst_off); const bf16* PT = (const bf16*)(ws + WS_PREVT) + (size_t)item * 8192;
    const float lg = LG2[h];
    retout_load(ws, item, tid, rv);
    RetQKP rq; retout_load_qk(ws, item, tid, rq);
    u32x4 pt[2];
#pragma unroll
    for (int i = 0; i < 2; ++i) pt[i] = *(const GAS u32x4*)(PT + (size_t)(tid + i * 512) * 8);
    stage_vT(lds, rv, tid);
#pragma unroll
    for (int i = 0; i < 2; ++i) {
        const int id = tid + i * 512, row = id >> 3, chn = id & 7;
        *(LAS u32x4*)(lds + R_SQ + row * 144 + chn * 16) = rq.q[i];
        *(LAS u32x4*)(lds + R_SK + row * 144 + chn * 16) = rq.k[i];
    }
#pragma unroll
    for (int i = 0; i < 2; ++i) { const int id = tid + i * 512, e = id >> 3, chn = id & 7; *(LAS u32x4*)(lds + R_SPT + e * 144 + chn * 16) = pt[i]; }
    __syncthreads();
    const int lr = lane & 15, lq = lane >> 4, c0 = wave * 16;
    bf16x8 aq[2];
#pragma unroll
    for (int kk = 0; kk < 2; ++kk) aq[kk] = lds_frag(lds + R_SQ + ((c0 + lr) * 72 + kk * 32 + 8 * lq) * 2);
#pragma unroll
    for (int mt = 0; mt < 8; ++mt) {
        f32x4 s = (f32x4){0.f, 0.f, 0.f, 0.f};
#pragma unroll
        for (int kk = 0; kk < 2; ++kk) {
            const bf16x8 bk = lds_frag(lds + R_SK + ((mt * 16 + lr) * 72 + kk * 32 + 8 * lq) * 2);
            s = __builtin_amdgcn_mfma_f32_16x16x32_bf16(aq[kk], bk, s, 0, 0, 0);
        }
        const int mm = mt * 16 + lr;
#pragma unroll
        for (int i = 0; i < 4; ++i) {
            const int c = c0 + lq * 4 + i, df = c - mm;
            const float pv = (df >= 0) ? s[i] * exp2f((float)df * lg) : 0.f;
            ((LAS bf16*)(lds + R_SP))[c * 136 + mm] = (bf16)(cvt_pk_bf16(pv, 0.f) & 0xffff);
        }
    }
    f32x4 acc[8];
#pragma unroll
    for (int et = 0; et < 8; ++et) {
        acc[et] = (f32x4){0.f, 0.f, 0.f, 0.f};
#pragma unroll
        for (int kk = 0; kk < 2; ++kk) {
            const bf16x8 bp = lds_frag(lds + R_SPT + ((et * 16 + lr) * 72 + kk * 32 + 8 * lq) * 2);
            acc[et] = __builtin_amdgcn_mfma_f32_16x16x32_bf16(aq[kk], bp, acc[et], 0, 0, 0);
        }
    }
    float xi[4];
#pragma unroll
    for (int i = 0; i < 4; ++i) xi[i] = exp2f((float)(lq * 4 + i + 1 + (c0 & 127)) * lg);
#pragma unroll
    for (int et = 0; et < 8; ++et)
#pragma unroll
        for (int i = 0; i < 4; ++i) acc[et][i] *= xi[i];
    asm volatile("s_waitcnt lgkmcnt(0)" ::: "memory");
#pragma unroll
    for (int kk = 0; kk < 4; ++kk) {
        const bf16x8 ap = lds_frag(lds + R_SP + ((c0 + lr) * 136 + kk * 32 + 8 * lq) * 2);
#pragma unroll
        for (int et = 0; et < 8; ++et) {
            const bf16x8 bv = lds_frag(lds + R_SVT + ((et * 16 + lr) * 136 + kk * 32 + 8 * lq) * 2);
            acc[et] = __builtin_amdgcn_mfma_f32_16x16x32_bf16(ap, bv, acc[et], 0, 0, 0);
        }
    }
    asm volatile("s_waitcnt lgkmcnt(0)" ::: "memory");
#pragma unroll
    for (int i = 0; i < 4; ++i) {
        float q = 0.f;
#pragma unroll
        for (int et = 0; et < 8; ++et) q += acc[et][i] * acc[et][i];
        q += __shfl_xor(q, 1); q += __shfl_xor(q, 2); q += __shfl_xor(q, 4); q += __shfl_xor(q, 8);
        const float rs = __builtin_amdgcn_rsqf(q * (1.0f / 128.0f) + EPS);
        LAS bf16* sp = (LAS bf16*)(lds + R_SP) + (c0 + lq * 4 + i) * 136 + lr;
#pragma unroll
        for (int et = 0; et < 8; ++et) sp[et * 16] = (bf16)(cvt_pk_bf16(acc[et][i] * rs, 0.f) & 0xffff);
    }
    asm volatile("s_waitcnt lgkmcnt(0)" ::: "memory");
#pragma unroll
    for (int i = 0; i < 4; ++i) {
        const int r = i * 4 + lq;
        const u32x4 o = *(LAS const u32x4*)(lds + R_SP + ((c0 + r) * 136 + 8 * lr) * 2);
        GAS u32x4* rp = (GAS u32x4*)(R + (size_t)(t0 + c0 + r) * 512 + h * 128 + 8 * lr);
        const u32x4 z = *(const GAS u32x4*)(Z + (size_t)(t0 + c0 + r) * 512 + h * 128 + 8 * lr);
        u32x4 w;
        w.x = cvt_pk_bf16(bflo(o.x) * bflo(z.x), bfhi(o.x) * bfhi(z.x)); w.y = cvt_pk_bf16(bflo(o.y) * bflo(z.y), bfhi(o.y) * bfhi(z.y));
        w.z = cvt_pk_bf16(bflo(o.z) * bflo(z.z), bfhi(o.z) * bfhi(z.z)); w.w = cvt_pk_bf16(bflo(o.w) * bflo(z.w), bfhi(o.w) * bfhi(z.w));
        *rp = w;
    }
    __syncthreads();
}

__device__ __forceinline__ void attn_post(unsigned char* ws, int b, int h, int qi, const bf16* otmp, int l, const float* lp, const float* subg, size_t dst_off = WS_SZA) {
    int tid_ = threadIdx.x; asm volatile("" : "+v"(tid_));
    const int lane = tid_ & 63, wave = __builtin_amdgcn_readfirstlane(tid_ >> 6);
    const float e1 = wave_sum(lp[lane] * lp[64 + lane]), e2 = wave_sum(lp[128 + lane] * lp[192 + lane]);
    const float lam_init = 0.8f - 0.6f * expf(-0.3f * (float)l);
    const float lam = expf(e1) - expf(e2) + lam_init, oml = 1.0f - lam_init;
    asm volatile("s_waitcnt vmcnt(0)" ::: "memory");
    __syncthreads();
    __builtin_amdgcn_fence(__ATOMIC_ACQUIRE, "agent");
    bf16* A = (bf16*)(ws + dst_off); const bf16* ZA = (const bf16*)(ws + WS_SZA);
    const int lr = lane & 15, lq = lane >> 4;
    float gg[8];
#pragma unroll
    for (int e = 0; e < 8; ++e) gg[e] = subg[8 * lr + e] * oml;
#pragma unroll 4
    for (int it = 0; it < 8; ++it) {
        const int row = wave * 32 + it * 4 + lq;
        const u32x4 o0 = *(const GAS u32x4*)(otmp + row * 256 + 8 * lr), o1 = *(const GAS u32x4*)(otmp + row * 256 + 128 + 8 * lr);
        GAS u32x4* ap = (GAS u32x4*)(A + (size_t)(b * SEQ + qi * 256 + row) * 512 + h * 128 + 8 * lr);
        const u32x4 z = *(const GAS u32x4*)(ZA + (size_t)(b * SEQ + qi * 256 + row) * 512 + h * 128 + 8 * lr);
        float d[8] = {bflo(o0.x) - lam * bflo(o1.x), bfhi(o0.x) - lam * bfhi(o1.x), bflo(o0.y) - lam * bflo(o1.y), bfhi(o0.y) - lam * bfhi(o1.y),
                      bflo(o0.z) - lam * bflo(o1.z), bfhi(o0.z) - lam * bfhi(o1.z), bflo(o0.w) - lam * bflo(o1.w), bfhi(o0.w) - lam * bfhi(o1.w)};
        float ss = ((d[0] * d[0] + d[1] * d[1]) + (d[2] * d[2] + d[3] * d[3])) + ((d[4] * d[4] + d[5] * d[5]) + (d[6] * d[6] + d[7] * d[7]));
        ss += __shfl_xor(ss, 1); ss += __shfl_xor(ss, 2); ss += __shfl_xor(ss, 4); ss += __shfl_xor(ss, 8);
        const float rs = __builtin_amdgcn_rsqf(ss * (1.0f / 128.0f) + EPS);
        const float zz[8] = {bflo(z.x), bfhi(z.x), bflo(z.y), bfhi(z.y), bflo(z.z), bfhi(z.z), bflo(z.w), bfhi(z.w)};
#pragma unroll
        for (int e = 0; e < 8; ++e) d[e] = d[e] * rs * gg[e] * zz[e];
        u32x4 w; w.x = cvt_pk_bf16(d[0], d[1]); w.y = cvt_pk_bf16(d[2], d[3]); w.z = cvt_pk_bf16(d[4], d[5]); w.w = cvt_pk_bf16(d[6], d[7]);
        *ap = w;
    }
    asm volatile("s_waitcnt vmcnt(0)" ::: "memory");
    __syncthreads();
}
__device__ __forceinline__ void attn_phase(unsigned char* ws, char* lds, int vcu, int G, int bx, int l, const float* lp, const float* subg) {
    const attn_body::bf16* Qa = (const attn_body::bf16*)(ws + WS_QA); const attn_body::bf16* Ka = (const attn_body::bf16*)(ws + WS_KA); const attn_body::bf16* Va = (const attn_body::bf16*)(ws + WS_VA);
    bf16* otmp = (bf16*)(ws + WS_OTMP) + (size_t)bx * 65536;
    for (int v = vcu; v < 256; v += G) {
        const int xg = v >> 5, j = v & 31;
        for (int u4 = 0; u4 < 4; ++u4) {
            const int bh = 2 * xg + (u4 >> 1), b = bh >> 2, h = bh & 3;
            const int qi = (u4 < 2) ? j : 31 - j, c = u4 & 1;
            for (int rp = 0; rp < REP_ATTN; ++rp) attn_body::attn_unit128<8, 512, 512, 512, 256>(qi * 256, Qa + (size_t)(b * SEQ + qi * 256) * 512 + (h * 2 + c) * 64, Ka + (size_t)(b * SEQ) * 512 + (h * 2 + c) * 64,
                                                        Va + (size_t)(b * SEQ) * 512 + h * 128, (attn_body::bf16*)otmp + c * 128, lds);
            if (c == 1) {
#ifdef PROBE_LIGHT
                attn_post(ws, b, h, qi, otmp, l, lp, subg, WS_SCZ);
#endif
                attn_post(ws, b, h, qi, otmp, l, lp, subg);
            }
        }
    }
}

#define GAS __attribute__((address_space(1)))
#define RLX_AGENT __ATOMIC_RELAXED, __HIP_MEMORY_SCOPE_AGENT
#define LDS_WAIT() asm volatile("s_waitcnt lgkmcnt(0)" ::: "memory")
#define VM_WAIT() asm volatile("s_waitcnt vmcnt(0)" ::: "memory")
__device__ __forceinline__ unsigned long long rt() { return __builtin_amdgcn_s_memrealtime(); }
#define XB_TMO      128
#define XB_XCNT(j)  (256  + 64 * (j))
#define XB_XSUB(j)  (1280 + 64 * (j))
#define XB_XGEN(j)  (2304 + 64 * (j))
#define XB_TOP      3328
#define XB_TOPGEN   3392
#define XCD_BAR_WORDS 3456
#define XB_SPIN_CAP (1u << 18)

__device__ __forceinline__ unsigned xb_ld(unsigned* p)              { return __hip_atomic_load(p, __ATOMIC_RELAXED, __HIP_MEMORY_SCOPE_AGENT); }
__device__ __forceinline__ unsigned xb_add(unsigned* p, unsigned v) { return __hip_atomic_fetch_add(p, v, __ATOMIC_RELAXED, __HIP_MEMORY_SCOPE_AGENT); }
__device__ __forceinline__ unsigned xb_xcc_id() { return (unsigned)__builtin_amdgcn_s_getreg((3 << 11) | 20) & 0xFu; }
#define XB_SPIN(cond, bar) do { unsigned _sp = 0; while (cond) { __builtin_amdgcn_s_sleep(1); \
    if ((++_sp & 255u) == 0u) { if (xb_ld(&(bar)[XB_TMO])) break; if (_sp > XB_SPIN_CAP) { atomicAdd(&(bar)[XB_TMO], 1u); break; } } } } while (0)

struct XcdBarrier {
    unsigned* bar; unsigned x;
    volatile LAS unsigned* st;
};

__device__ __forceinline__ XcdBarrier xcd_barrier_post(unsigned* bar, volatile LAS unsigned* st) {
    XcdBarrier b; b.bar = bar; b.x = xb_xcc_id(); b.st = st;
    if (threadIdx.x == 0) (void)xb_add(&bar[XB_XCNT(b.x)], 1u);
    return b;
}
__device__ __forceinline__ void xcd_barrier_complete(unsigned* bar, unsigned x, unsigned& nloc, unsigned& nx) {
    const unsigned G = gridDim.x * gridDim.y * gridDim.z;
    unsigned sum, cnt, mine, sp = 0u;
    for (;;) {
        sum = 0u; cnt = 0u; mine = 0u;
#pragma unroll
        for (unsigned j = 0; j < 16; ++j) { const unsigned c = xb_ld(&bar[XB_XCNT(j)]); sum += c; cnt += (c > 0u) ? 1u : 0u; mine = (j == x) ? c : mine; }
        if (sum == G) break;
        __builtin_amdgcn_s_sleep(1);
        if ((++sp & 255u) == 0u) { if (xb_ld(&bar[XB_TMO])) break; if (sp > XB_SPIN_CAP) { atomicAdd(&bar[XB_TMO], 1u); break; } }
    }
    nloc = mine > 0u ? mine : 1u; nx = cnt > 0u ? cnt : 1u;
}

__device__ __forceinline__ void xcd_barrier(const XcdBarrier& b) {
    asm volatile("s_waitcnt vmcnt(0)" ::: "memory");
    __syncthreads();
    if (threadIdx.x == 0) {
        unsigned* bar = b.bar;
        __builtin_amdgcn_s_waitcnt(0);
        unsigned nloc = b.st[0], nx = b.st[1];
        if (nloc == 0u) { xcd_barrier_complete(bar, b.x, nloc, nx); b.st[0] = nloc; b.st[1] = nx; }
        const unsigned old = xb_add(&bar[XB_XSUB(b.x)], 1u);
        const unsigned gen = old / nloc;
        if (old + 1u == (gen + 1u) * nloc) {
            __builtin_amdgcn_fence(__ATOMIC_RELEASE, "agent");
            asm volatile("s_waitcnt vmcnt(0)" ::: "memory");
            const unsigned og = xb_add(&bar[XB_TOP], 1u);
            const unsigned tg = og / nx;
            if (og + 1u == (tg + 1u) * nx) xb_add(&bar[XB_TOPGEN], 1u);
            else XB_SPIN(xb_ld(&bar[XB_TOPGEN]) == tg, bar);
            __builtin_amdgcn_fence(__ATOMIC_ACQUIRE, "agent");
            xb_add(&bar[XB_XGEN(b.x)], 1u);
            asm volatile("s_waitcnt vmcnt(0)" ::: "memory");
        } else {
            XB_SPIN(xb_ld(&bar[XB_XGEN(b.x)]) == gen, bar);
            __builtin_amdgcn_fence(__ATOMIC_ACQUIRE, "agent");
            asm volatile("s_waitcnt vmcnt(0)" ::: "memory");
        }
    }
    __syncthreads();
}

constexpr int PH_PER_LAYER = 6, N_PHASES = 1 + DEPTH * PH_PER_LAYER + 1;

__global__ void __launch_bounds__(NWAVES * 64, 2) trunk_fwd(Args args) {
    extern __shared__ __attribute__((aligned(16))) unsigned char lds_raw[];
    LAS unsigned char* lds = (LAS unsigned char*)lds_raw;
#define TIDS() int tid = threadIdx.x; asm volatile("" : "+v"(tid)); const int lane = tid & 63, wave = __builtin_amdgcn_readfirstlane(tid >> 6); (void)lane; (void)wave
#define WSO() unsigned char* ws = args.ws; asm volatile("" : "+s"(ws)); float* ssq = (float*)(ws + WS_SSQ); bf16* xb = (bf16*)(ws + WS_XB); (void)ssq; (void)xb
    const int G = gridDim.x, bx = blockIdx.x;
    const int vcu = (G % 8 == 0) ? (bx % 8) * (G / 8) + bx / 8 : bx;
    const int lo = args.ph_lo, hi = args.ph_hi;
#if MK_MULTI
#define SEAM() do {} while (0)
#else
    cg::grid_group grid = cg::this_grid();
    volatile LAS unsigned* bst = (volatile LAS unsigned*)(lds + LDS_BYTES - 16);
    if (threadIdx.x < 2) bst[threadIdx.x] = 0u;
    __syncthreads();
    XcdBarrier bar = xcd_barrier_post((unsigned*)args.ws, bst);
#define SEAM() xcd_barrier(bar)
#endif
#ifndef PHASE_MASK
#define PHASE_MASK 0x1ff
#endif
#define PH_ON(t) ((PHASE_MASK >> (t)) & 1)
#define IN(k) (lo <= (k) && (k) < hi)
#define BOTH(k) (IN(k) && IN((k) + 1))

    if (PH_ON(0) && IN(0)) { TIDS();
#if defined(PROBE_LIGHT) || defined(PROBE_PRO)
        phase_prologue(args, lds, vcu, G, wave, lane);
#endif
        phase_prologue(args, lds, vcu, G, wave, lane); if (BOTH(0)) {
#if MK_MULTI
        SEAM();
#else
        grid.sync();
#endif
    } }

    for (int l = 0; l < DEPTH; ++l) {
        const int p0 = 1 + l * PH_PER_LAYER;
        if (PH_ON(1) && IN(p0)) {
            WSO(); const bf16* Win = (const bf16*)(ws + WS_WIN + l * WIN_L);
            pg8::Gemm g{xb, xb, xb, Win, 0, T, NPROJ, DM}; pg8::StaticOrder S; S.init(T, NPROJ, G, bx);
            float* rstd = (float*)(ws + WS_RSTD) + (size_t)l * T;
            if (l > 0) {
                TIDS(); int lastpm = -1; pg8::Unit uu;
                for (int i = 0; S.next(i, uu); ++i) if (uu.pm != lastpm) { lastpm = uu.pm;
                    const int row = uu.pm * 256 + (tid >> 1); const GAS f32x4* sp = (const GAS f32x4*)(ssq + (size_t)row * 16 + (tid & 1) * 8);
                    const f32x4 a0 = sp[0], a1 = sp[1]; float s = ((a0[0] + a0[1]) + (a0[2] + a0[3])) + ((a1[0] + a1[1]) + (a1[2] + a1[3])); s += __shfl_xor(s, 1);
                    if ((tid & 1) == 0) ((GAS float*)rstd)[row] = __builtin_amdgcn_rsqf(s * (1.0f / DM) + EPS); }
                asm volatile("s_waitcnt vmcnt(0)" ::: "memory"); __syncthreads();
            }
            EpiProj E{ws, rstd, (const float2*)(ws + WS_ROPEA), (const float2*)(ws + WS_ROPER)};
            for (int rp = 0; rp < REP_GEMM; ++rp) pg8::gemm_phase<EpiProj, pg8::StaticOrder, true, true>(lds, g, S, E);
            if (BOTH(p0)) SEAM();
        }
        if (PH_ON(2) && IN(p0 + 1)) {
            WSO();
            TIDS();
            for (int rp = 0; rp < REP_LIGHT; ++rp) retkv_items(ws, lds, vcu, G, tid, wave, lane);
            for (int it = vcu; it < T / 64; it += G) conv_item(ws, args.in[5] + (size_t)l * 3 * 512, it, tid);
            if (BOTH(p0 + 1)) SEAM();
        }
        if (PH_ON(4) && IN(p0 + 2)) {
            WSO();
            { TIDS();
#ifdef PROBE_LIGHT
              scan_phase(ws, vcu, G, tid, WS_SCZ);
#endif
              scan_phase(ws, vcu, G, tid); }
            attn_phase(ws, (char*)lds_raw, vcu, G, bx, l, args.in[3] + (size_t)l * 4 * 64, args.in[4] + l * 128);
            if (BOTH(p0 + 2)) SEAM();
        }
        if (PH_ON(5) && IN(p0 + 3)) {
            WSO();
            { TIDS();
              RetV rv;
#ifdef PROBE_LIGHT
              if (vcu < 1024) retout_load(ws, vcu, tid, rv);
              for (int it = vcu; it < 1024; it += G) retout_item(ws, lds, it, it + G, rv, tid, wave, lane, WS_CC);
#endif
              for (int it = vcu; it < 1024; it += G) retout_item(ws, lds, it, it + G, rv, tid, wave, lane); }
            const bf16* Win = (const bf16*)(ws + WS_WIN + l * WIN_L);
            pg8::Gemm g{xb, xb, xb, Win + (size_t)NPROJ * DM, 0, T, NGATE, DM}; pg8::StaticOrder S; S.init(T, NGATE, G, bx);
            EpiGate E{(bf16*)(ws + WS_G), (const float*)(ws + WS_RSTD) + (size_t)l * T};
            for (int rp = 0; rp < REP_GEMM; ++rp) pg8::gemm_phase<EpiGate, pg8::StaticOrder, true, true>(lds, g, S, E);
            if (BOTH(p0 + 3)) SEAM();
        }
        if (PH_ON(6) && IN(p0 + 4)) {
            WSO();
            pg8::Gemm g{(const bf16*)(ws + WS_SZA), (const bf16*)(ws + WS_CB), (const bf16*)(ws + WS_SRZ), (const bf16*)(ws + WS_WBR + l * WBR_L), (size_t)DM * 512 * 2, T, DM, 512};
            ChainOrder S; S.S.init(T, DM, G, bx);
            EpiChain E{(const bf16*)(ws + WS_G), (bf16*)(ws + WS_MERGED)};
            for (int rp = 0; rp < REP_GEMM; ++rp) pg8::gemm_phase<EpiChain, ChainOrder, true, true>(lds, g, S, E);
            if (BOTH(p0 + 4)) SEAM();
        }
        if (PH_ON(7) && IN(p0 + 5)) {
            WSO();
            const bf16* mg = (const bf16*)(ws + WS_MERGED);
            pg8::Gemm g{mg, mg, mg, (const bf16*)(ws + WS_WOUT + l * WOUT_L), 0, T, DM, DM}; pg8::StaticOrder S; S.init(T, DM, G, bx);
            static_assert(DEPTH == 2, "residual hand-over below is written for two layers: layer 0 reads the f32 input, the last layer reads the bf16 stream");
            if (l + 1 < DEPTH) { EpiOutT<false> E{args.in[0], nullptr, nullptr, xb, ssq}; pg8::gemm_phase<EpiOutT<false>, pg8::StaticOrder, true, true>(lds, g, S, E); }
            else { EpiOutT<true> E{nullptr, xb, nullptr, xb, ssq}; pg8::gemm_phase<EpiOutT<true>, pg8::StaticOrder, true, true>(lds, g, S, E); }
            if (BOTH(p0 + 5)) SEAM();
        }
    }
    if (PH_ON(8) && IN(N_PHASES - 1)) {
        WSO(); TIDS(); const float* gf = args.in[8]; float* out = args.out;
        const int gw = vcu * NWAVES + wave, NGW = G * NWAVES;
        f32x4 gv[4];
#pragma unroll
        for (int j = 0; j < 4; ++j) gv[j] = *(const GAS f32x4*)(gf + (j >> 1) * 512 + 8 * lane + (j & 1) * 4);
        for (int m0 = gw * 4; m0 < T; m0 += NGW * 4) {
            u32x4 v[4][2]; float sv[4];
#pragma unroll
            for (int r = 0; r < 4; ++r) { const bf16* xr = xb + (size_t)(m0 + r) * DM + 8 * lane; sv[r] = (lane < 16) ? ((const GAS float*)ssq)[(size_t)(m0 + r) * 16 + lane] : 0.f;
                v[r][0] = *(const GAS u32x4*)xr; v[r][1] = *(const GAS u32x4*)(xr + 512); }
#pragma unroll
            for (int r = 0; r < 4; ++r) {
                float s = sv[r];
                s += __shfl_xor(s, 1); s += __shfl_xor(s, 2); s += __shfl_xor(s, 4); s += __shfl_xor(s, 8);
                s = __shfl(s, 0);
                const float rs = __builtin_amdgcn_rsqf(s * (1.0f / DM) + EPS);
                float* xw = out + (size_t)(m0 + r) * DM + 8 * lane;
#pragma unroll
                for (int hb = 0; hb < 2; ++hb) {
                    const u32x4 w = v[r][hb];
                    const f32x4 a = (f32x4){bflo(w.x), bfhi(w.x), bflo(w.y), bfhi(w.y)}, b = (f32x4){bflo(w.z), bfhi(w.z), bflo(w.w), bfhi(w.w)};
                    *(GAS f32x4*)(xw + hb * 512) = a * rs * gv[2 * hb]; *(GAS f32x4*)(xw + hb * 512 + 4) = b * rs * gv[2 * hb + 1];
                }
            }
        }
    }
#undef IN
#undef BOTH
#undef SEAM
}

extern "C" void kernel_launch(void* const* d_in, const int* in_sizes, int n_in, void* d_out, int out_size, void* d_ws, size_t ws_size, hipStream_t stream) {
    static int grid = 0;
    if (grid == 0) {
        if (n_in != 9 || in_sizes[0] != T * DM || out_size != T * DM || ws_size < WS_END) { fprintf(stderr, "kernel_launch: unexpected shapes / workspace (n_in %d, ws %zu)\n", n_in, ws_size); grid = -1; return; }
        int dev = 0, cus = 0, per_cu = 0;
        (void)hipGetDevice(&dev); (void)hipDeviceGetAttribute(&cus, hipDeviceAttributeMultiprocessorCount, dev);
        if (hipFuncSetAttribute((const void*)trunk_fwd, hipFuncAttributeMaxDynamicSharedMemorySize, LDS_BYTES) != hipSuccess) { fprintf(stderr, "kernel_launch: hipFuncSetAttribute failed\n"); grid = -1; return; }
        if (hipOccupancyMaxActiveBlocksPerMultiprocessor(&per_cu, (const void*)trunk_fwd, NWAVES * 64, LDS_BYTES) != hipSuccess || per_cu < 1) { fprintf(stderr, "kernel_launch: occupancy query gave %d\n", per_cu); per_cu = 1; }
        (void)hipGetLastError();
        grid = cus * per_cu;
    }
    if (grid < 0) return;
    Args a{};
    for (int i = 0; i < 9; ++i) a.in[i] = (const float*)d_in[i];
    a.out = (float*)d_out; a.ws = (unsigned char*)d_ws;
#if MK_MULTI
    for (int p = 0; p < N_PHASES; ++p) { a.ph_lo = p; a.ph_hi = p + 1; hipLaunchKernelGGL(trunk_fwd, dim3(grid), dim3(NWAVES * 64), LDS_BYTES, stream, a); }
#else
    a.ph_lo = 0; a.ph_hi = N_PHASES;
    if (hipMemsetAsync(d_ws, 0, 16384, stream) != hipSuccess) { fprintf(stderr, "kernel_launch: memset of the barrier words failed\n"); return; }
    void* kargs[] = {&a};
    hipError_t e = hipLaunchCooperativeKernel((const void*)trunk_fwd, dim3(grid), dim3(NWAVES * 64), kargs, LDS_BYTES, stream);
    if (e != hipSuccess) fprintf(stderr, "kernel_launch: cooperative launch failed: %s (grid %d)\n", hipGetErrorString(e), grid);
#endif
}
```

```cpp
#include <hip/hip_runtime.h>
#include <hip/hip_cooperative_groups.h>
#include <hip/hip_bf16.h>
#include <cstdio>
#include <cstdint>
#include <cmath>
namespace cg = cooperative_groups;
namespace pg8 {
#define PG8_LAS __attribute__((address_space(3)))
typedef unsigned short bf16_t;
typedef short bf16x8 __attribute__((ext_vector_type(8)));
typedef float f32x4 __attribute__((ext_vector_type(4)));
typedef unsigned u32x4 __attribute__((ext_vector_type(4)));
constexpr int BM = 256, BK = 64, HALF = 128, HTB = HALF * BK * 2  , STAGE_BYTES = 8 * HTB, NXCD = 8, WGM = 8;

__host__ __device__ __forceinline__ int lds_byte(int r, int c) { const int st = (r >> 4) * 2 + (c >> 5), rr = r & 15, cc = c & 31, ob = rr * 64 + cc * 2; return st * 1024 + (ob ^ (((ob >> 9) & 1) << 5)); }
__host__ __device__ __forceinline__ void stage_rc(int b, int& R, int& C) { const int st = b / 1024, sb = b % 1024, swz = sb ^ (((sb >> 9) & 1) << 5); R = (st >> 1) * 16 + swz / 64; C = (st & 1) * 32 + (swz % 64) / 2; }
__host__ __device__ __forceinline__ int perm32(int rho) { const int n = rho >> 4, i = rho & 15; return 8 * (i >> 2) + 4 * n + (i & 3); }

struct Unit { int pm, pn, seg; };
struct Gemm { const bf16_t* A0; const bf16_t* A1; const bf16_t* A2; const bf16_t* Bt; size_t bseg  ; int M, N, K; };
__device__ __forceinline__ const char* gemm_abase(const Gemm& g, int seg) { return (const char*)(seg == 0 ? g.A0 : (seg == 1 ? g.A1 : g.A2)); }

struct StaticOrder {
    int nM, nN, nwg, G, c;
    __host__ __device__ void init(int M, int N, int G_, int c_) { nM = M / BM; nN = N / BM; nwg = nM * nN; G = G_; c = c_; }
    __host__ __device__ bool next(int i, Unit& u) const {
        const long L = (long)i * G + c; if (L >= nwg) return false;
        int wgid = (int)L; { const int q = nwg / NXCD, r = nwg % NXCD, xcd = wgid % NXCD, off = wgid / NXCD; wgid = (xcd < r ? xcd * (q + 1) : r * (q + 1) + (xcd - r) * q) + off; }
        const int nig = WGM * nN, gid = wgid / nig, fm = gid * WGM, gsz = (nM - fm) < WGM ? (nM - fm) : WGM;
        u.pm = fm + ((wgid % nig) % gsz); u.pn = (wgid % nig) / gsz; u.seg = 0; return true;
    }
    __device__ __forceinline__ void a_ready(const Unit&) const {}
    __device__ __forceinline__ void done(const Unit&) const {}
};

__device__ __forceinline__ unsigned cvt_pk_bf16(float lo, float hi) { unsigned r; asm volatile("v_cvt_pk_bf16_f32 %0, %1, %2" : "=v"(r) : "v"(lo), "v"(hi)); return r; }
typedef float f32x2 __attribute__((ext_vector_type(2)));
template <class Epi, class Sched, bool ALIGN_EPI = false, bool SP2 = false>
__device__ __forceinline__ void gemm_phase(PG8_LAS unsigned char* lds, const Gemm g, const Sched& S, const Epi& E) {
    int tid = threadIdx.x; asm volatile("" : "+v"(tid));
    const int wid = __builtin_amdgcn_readfirstlane(tid >> 6), lane = tid & 63, wr = wid >> 2, wc = wid & 3, fr = lane & 15, fq = lane >> 4;
    const int K = g.K, nt = K / BK;
    unsigned voffA[2], voffB[2];
#pragma unroll
    for (int i = 0; i < 2; ++i) { int R, C; stage_rc(tid * 16 + i * 8192, R, C); const int Rb = Epi::PERM ? ((R & ~31) + perm32(R & 31)) : R;
        voffA[i] = (unsigned)(R * K + C) * 2u; voffB[i] = (unsigned)(Rb * K + C) * 2u; }
    const size_t kstep = (size_t)(BK * 2);
    const size_t hstep = (size_t)HALF * K * 2;
    const size_t tstep = 2 * hstep;
    const unsigned ldsw = (unsigned)wid * 1024u;
    const int aoff = lds_byte(wr * 64 + fr, fq * 8), boff = lds_byte(wc * 32 + fr, fq * 8);
#define PG8_SA(b, h) (((b) * 2 + (h)) * HTB)
#define PG8_SB(b, h) ((4 + (b) * 2 + (h)) * HTB)
#define PG8_STAGE(bufoff, gbase, voff) do { _Pragma("unroll") for (int _i = 0; _i < 2; ++_i) \
        __builtin_amdgcn_global_load_lds((const unsigned*)((const char*)(gbase) + (voff)[_i]), (PG8_LAS unsigned*)(lds + (bufoff) + ldsw + _i * 8192), 16, 0, 0); } while (0)
#define PG8_LDA(dst, b, h) do { _Pragma("unroll") for (int m = 0; m < 4; ++m) _Pragma("unroll") for (int k = 0; k < 2; ++k) dst[m][k] = *(const PG8_LAS bf16x8*)(lds + PG8_SA(b, h) + aoff + m * 2048 + k * 1024); } while (0)
#define PG8_LDB(dst, b, h) do { _Pragma("unroll") for (int n = 0; n < 2; ++n) _Pragma("unroll") for (int k = 0; k < 2; ++k) dst[n][k] = *(const PG8_LAS bf16x8*)(lds + PG8_SB(b, h) + boff + n * 2048 + k * 1024); } while (0)
#define PG8_MMA(ai, bj, At, Bt) do { __builtin_amdgcn_s_setprio(1); _Pragma("unroll") for (int m = 0; m < 4; ++m) _Pragma("unroll") for (int n = 0; n < 2; ++n) _Pragma("unroll") for (int k = 0; k < 2; ++k) \
        acc[ai][bj][m][n] = __builtin_amdgcn_mfma_f32_16x16x32_bf16(Bt[n][k], At[m][k], acc[ai][bj][m][n], 0, 0, 0); __builtin_amdgcn_s_setprio(0); } while (0)
#define PG8_WAIT_V(n) asm volatile("s_waitcnt vmcnt(" #n ")" ::: "memory")
#define PG8_WAIT_L(n) asm volatile("s_waitcnt lgkmcnt(" #n ")" ::: "memory")
#define PG8_BAR __builtin_amdgcn_s_barrier()
#define PG8_SCHED __builtin_amdgcn_sched_barrier(0)
    Unit cur, nxt; int ui = 0;
    if (!S.next(0, cur)) return;
    f32x4 acc[2][2][4][2];
#pragma unroll
    for (int a = 0; a < 2; ++a)
#pragma unroll
        for (int b = 0; b < 2; ++b)
#pragma unroll
            for (int m = 0; m < 4; ++m)
#pragma unroll
                for (int n = 0; n < 2; ++n) acc[a][b][m][n] = (f32x4){0.f, 0.f, 0.f, 0.f};
    bf16x8 At[4][2], B0[2][2], B1[2][2];
    const char* cA = gemm_abase(g, cur.seg) + (size_t)cur.pm * tstep; const char* cB = (const char*)g.Bt + (size_t)cur.seg * g.bseg + (size_t)cur.pn * tstep;
    S.a_ready(cur);
    if constexpr (SP2) {
        PG8_STAGE(PG8_SB(0, 0), cB, voffB); PG8_STAGE(PG8_SB(0, 1), cB + hstep, voffB); PG8_STAGE(PG8_SA(0, 0), cA, voffA); PG8_STAGE(PG8_SA(0, 1), cA + hstep, voffA);
        if (wr == 1) PG8_BAR;
        PG8_WAIT_V(2); PG8_BAR;
        PG8_STAGE(PG8_SB(1, 0), cB + kstep, voffB); PG8_STAGE(PG8_SA(1, 0), cA + kstep, voffA); PG8_STAGE(PG8_SB(1, 1), cB + hstep + kstep, voffB);
        PG8_WAIT_V(6); PG8_BAR;
    } else {
        PG8_STAGE(PG8_SB(0, 0), cB, voffB); PG8_STAGE(PG8_SA(0, 0), cA, voffA); PG8_STAGE(PG8_SB(0, 1), cB + hstep, voffB); PG8_STAGE(PG8_SA(0, 1), cA + hstep, voffA);
        if (wr == 1) PG8_BAR;
        PG8_WAIT_V(4); PG8_BAR;
        PG8_STAGE(PG8_SB(1, 0), cB + kstep, voffB); PG8_STAGE(PG8_SA(1, 0), cA + kstep, voffA); PG8_STAGE(PG8_SB(1, 1), cB + hstep + kstep, voffB);
        PG8_WAIT_V(6); PG8_BAR;
    }
    for (;;) {
        const bool has_next = S.next(ui + 1, nxt);
        const char* nA = has_next ? gemm_abase(g, nxt.seg) + (size_t)nxt.pm * tstep : cA; const char* nB = has_next ? (const char*)g.Bt + (size_t)nxt.seg * g.bseg + (size_t)nxt.pn * tstep : cB;
        for (int t = 0; t < nt; t += 2) {
            const bool last = (t == nt - 2);
            const char* a1 = cA + (size_t)(t + 1) * kstep;
            const char* a2 = last ? nA : cA + (size_t)(t + 2) * kstep; const char* b2 = last ? nB : cB + (size_t)(t + 2) * kstep;
            const char* a3 = a2 + kstep; const char* b3 = b2 + kstep;
            if (last && has_next) S.a_ready(nxt);
            if constexpr (SP2) {
            PG8_LDB(B0, 0, 0); PG8_LDB(B1, 0, 1); PG8_SCHED; PG8_LDA(At, 0, 0); PG8_STAGE(PG8_SA(1, 1), a1 + hstep, voffA);
            PG8_WAIT_V(8); PG8_WAIT_L(0); PG8_BAR; PG8_MMA(0, 0, At, B0); PG8_MMA(0, 1, At, B1); PG8_BAR; PG8_SCHED;
            PG8_LDA(At, 0, 1); PG8_STAGE(PG8_SB(0, 0), b2, voffB); PG8_STAGE(PG8_SB(0, 1), b2 + hstep, voffB); PG8_STAGE(PG8_SA(0, 0), a2, voffA);
            PG8_WAIT_V(8); PG8_WAIT_L(0); PG8_BAR; PG8_MMA(1, 0, At, B0); PG8_MMA(1, 1, At, B1); PG8_BAR; PG8_SCHED;
            PG8_LDB(B0, 1, 0); PG8_LDB(B1, 1, 1); PG8_SCHED; PG8_LDA(At, 1, 0); PG8_STAGE(PG8_SA(0, 1), a2 + hstep, voffA);
            PG8_WAIT_V(8); PG8_WAIT_L(0); PG8_BAR; PG8_MMA(0, 0, At, B0); PG8_MMA(0, 1, At, B1); PG8_BAR; PG8_SCHED;
            PG8_LDA(At, 1, 1); PG8_STAGE(PG8_SB(1, 0), b3, voffB); PG8_STAGE(PG8_SB(1, 1), b3 + hstep, voffB); PG8_STAGE(PG8_SA(1, 0), a3, voffA);
            PG8_WAIT_V(8); PG8_WAIT_L(0); PG8_BAR; PG8_MMA(1, 0, At, B0); PG8_MMA(1, 1, At, B1); PG8_BAR; PG8_SCHED;
            } else {
            PG8_LDB(B0, 0, 0); PG8_SCHED; PG8_LDA(At, 0, 0); PG8_STAGE(PG8_SA(1, 1), a1 + hstep, voffA);
            PG8_WAIT_L(8); PG8_BAR; PG8_WAIT_L(0); PG8_MMA(0, 0, At, B0); PG8_BAR; PG8_SCHED;
            PG8_LDB(B1, 0, 1); PG8_STAGE(PG8_SB(0, 0), b2, voffB);
            PG8_BAR; PG8_WAIT_L(0); PG8_MMA(0, 1, At, B1); PG8_BAR;
            PG8_LDA(At, 0, 1); PG8_STAGE(PG8_SA(0, 0), a2, voffA);
            PG8_BAR; PG8_WAIT_L(0); PG8_MMA(1, 0, At, B0); PG8_BAR; PG8_SCHED;
            PG8_STAGE(PG8_SB(0, 1), b2 + hstep, voffB);
            PG8_WAIT_V(6); PG8_BAR; PG8_MMA(1, 1, At, B1); PG8_BAR;
            PG8_LDB(B0, 1, 0); PG8_SCHED; PG8_LDA(At, 1, 0); PG8_STAGE(PG8_SA(0, 1), a2 + hstep, voffA);
            PG8_WAIT_L(8); PG8_BAR; PG8_WAIT_L(0); PG8_MMA(0, 0, At, B0); PG8_BAR; PG8_SCHED;
            PG8_LDB(B1, 1, 1); PG8_STAGE(PG8_SB(1, 0), b3, voffB);
            PG8_BAR; PG8_WAIT_L(0); PG8_MMA(0, 1, At, B1); PG8_BAR;
            PG8_LDA(At, 1, 1); PG8_STAGE(PG8_SA(1, 0), a3, voffA);
            PG8_BAR; PG8_WAIT_L(0); PG8_MMA(1, 0, At, B0); PG8_BAR; PG8_SCHED;
            PG8_STAGE(PG8_SB(1, 1), b3 + hstep, voffB);
            PG8_WAIT_V(6); PG8_BAR; PG8_MMA(1, 1, At, B1); PG8_BAR;
            }
        }
        if constexpr (ALIGN_EPI) { if (wr == 0) PG8_BAR; }
        if constexpr (!Epi::AFTER_DRAIN) { E(acc, cur, wr, wc, fr, fq); S.done(cur); }
        if (!has_next) break;
        if (!E.keep(cur)) {
#pragma unroll
        for (int a = 0; a < 2; ++a)
#pragma unroll
            for (int b = 0; b < 2; ++b)
#pragma unroll
                for (int m = 0; m < 4; ++m)
#pragma unroll
                    for (int n = 0; n < 2; ++n) acc[a][b][m][n] = (f32x4){0.f, 0.f, 0.f, 0.f};
        }
        cur = nxt; cA = nA; cB = nB; ++ui;
        if constexpr (ALIGN_EPI) { if (wr == 1) PG8_BAR; }
    }
    PG8_WAIT_V(0);
    if constexpr (!ALIGN_EPI) { if (wr == 0) PG8_BAR; }
    PG8_BAR;
    if constexpr (Epi::AFTER_DRAIN) { E.fused(acc, cur, wr, wc, fr, fq, lds, wid, lane); S.done(cur); }
#undef PG8_SA
#undef PG8_SB
#undef PG8_STAGE
#undef PG8_LDA
#undef PG8_LDB
#undef PG8_MMA
#undef PG8_WAIT_V
#undef PG8_WAIT_L
#undef PG8_BAR
#undef PG8_SCHED
}
}
namespace attn_body {
using bf16=__hip_bfloat16;
using bf16x8=__attribute__((ext_vector_type(8)))short;
using s16x4=__attribute__((ext_vector_type(4)))short;
using f32x16=__attribute__((ext_vector_type(16)))float;
using u32x4=__attribute__((ext_vector_type(4)))unsigned;
constexpr int SEQ=8192,D=64;
constexpr int NW=8,QBLK=32,QB=QBLK*NW,KVBLK=64,NQB=SEQ/QB;
constexpr int ATTN_UNIT_ROWS=QB;
__device__ __forceinline__ int crow(int r,int hi){return (r&3)+8*(r>>2)+4*hi;}
#define SBAR() __builtin_amdgcn_sched_barrier(0)
__device__ __forceinline__ void cmask(f32x16&p0,f32x16&p1,int jb,int qrel,int hi){
  const float NEG=-INFINITY; int kb=64*jb+4*hi;
  #pragma unroll
  for(int r=0;r<16;++r){int kv=kb+(r&3)+8*(r>>2); if(kv>qrel)p0[r]=NEG; if(kv+32>qrel)p1[r]=NEG;}
}

constexpr int NSLOT=3, SLOTB=8192;
constexpr int LDS_K=0, LDS_V=NSLOT*SLOTB, LDS_WS=2*NSLOT*SLOTB, LDS_OST=LDS_WS+NW*64*4, LDS_BYTES=LDS_OST+NW*4096;
constexpr float C2=0.125f*1.4426950408889634f;
__device__ __forceinline__ void glds16(const void*gsrc,unsigned lds_dst){unsigned keep;
  asm volatile("s_mov_b32 %0, m0\n\ts_mov_b32 m0, %2\n\ts_nop 0\n\tglobal_load_lds_dwordx4 %1, off\n\ts_mov_b32 m0, %0":"=&s"(keep):"v"(gsrc),"s"(lds_dst):"memory");}
__device__ __forceinline__ float max3f(float a,float b,float c){float r;asm("v_max3_f32 %0, %1, %2, %3":"=v"(r):"v"(a),"v"(b),"v"(c));return r;}
__device__ __forceinline__ float max2f(float a,float b){float r;asm("v_max_f32_e32 %0, %1, %2":"=v"(r):"v"(a),"v"(b));return r;}
__device__ __forceinline__ float fadd_s(float a,float b){float r;asm("v_add_f32_e32 %0, %1, %2":"=v"(r):"v"(a),"v"(b));return r;}
__device__ __forceinline__ float fsub_s(float a,float b){float r;asm("v_sub_f32_e32 %0, %1, %2":"=v"(r):"v"(a),"v"(b));return r;}
typedef float f32x2_t __attribute__((ext_vector_type(2))); typedef __bf16 bf16x2_t __attribute__((ext_vector_type(2)));
__device__ __forceinline__ unsigned cvtpk_s(float lo,float hi){f32x2_t v={lo,hi};bf16x2_t b=__builtin_convertvector(v,bf16x2_t);return __builtin_bit_cast(unsigned,b);}
#define WAIT_BAR(N) asm volatile("s_waitcnt vmcnt(" #N ") lgkmcnt(0)\n\ts_barrier":::"memory")

__device__ __forceinline__ void qkt(f32x16&p0,f32x16&p1,const char*Kslot,const bf16x8*qr,const f32x16&negm,int r32,int hi){
  const char*kb=Kslot+hi*1024+r32*16;
  #pragma unroll
  for(int d0=0;d0<4;++d0){
    const bf16x8 b0=*reinterpret_cast<const bf16x8*>(kb+d0*2048);
    const bf16x8 b1=*reinterpret_cast<const bf16x8*>(kb+d0*2048+512);
    if(d0==0){p0=__builtin_amdgcn_mfma_f32_32x32x16_bf16(b0,qr[0],negm,0,0,0);p1=__builtin_amdgcn_mfma_f32_32x32x16_bf16(b1,qr[0],negm,0,0,0);}
    else{p0=__builtin_amdgcn_mfma_f32_32x32x16_bf16(b0,qr[d0],p0,0,0,0);p1=__builtin_amdgcn_mfma_f32_32x32x16_bf16(b1,qr[d0],p1,0,0,0);}}
}
typedef __attribute__((address_space(3))) const char* lds_cptr;
typedef short v4i16_t __attribute__((ext_vector_type(4)));
__device__ __forceinline__ void kload8(bf16x8*kf,lds_cptr kp){
  kf[0]=*(const __attribute__((address_space(3))) bf16x8*)(kp);      kf[1]=*(const __attribute__((address_space(3))) bf16x8*)(kp+512);
  kf[2]=*(const __attribute__((address_space(3))) bf16x8*)(kp+2048); kf[3]=*(const __attribute__((address_space(3))) bf16x8*)(kp+2560);
  kf[4]=*(const __attribute__((address_space(3))) bf16x8*)(kp+4096); kf[5]=*(const __attribute__((address_space(3))) bf16x8*)(kp+4608);
  kf[6]=*(const __attribute__((address_space(3))) bf16x8*)(kp+6144); kf[7]=*(const __attribute__((address_space(3))) bf16x8*)(kp+6656);
}
__device__ __forceinline__ void kload2(bf16x8*kf,lds_cptr kp,int j){ kf[2*j]=*(const __attribute__((address_space(3))) bf16x8*)(kp+j*2048); kf[2*j+1]=*(const __attribute__((address_space(3))) bf16x8*)(kp+j*2048+512); }
__device__ __forceinline__ s16x4 vtr(lds_cptr p){ return __builtin_bit_cast(s16x4,__builtin_amdgcn_ds_read_tr16_b64_v4i16((__attribute__((address_space(3))) v4i16_t*)p)); }
__device__ __forceinline__ float rowmax(const f32x16&p0,const f32x16&p1){
  float a=max3f(p0[0],p0[1],p1[0]),b=max3f(p0[2],p0[3],p1[1]);a=max3f(a,p1[2],p1[3]);
  #pragma unroll
  for(int r=4;r<16;r+=4){a=max3f(a,p0[r],p0[r+1]);b=max3f(b,p0[r+2],p0[r+3]);a=max3f(a,p1[r],p1[r+1]);b=max3f(b,p1[r+2],p1[r+3]);}
  const float m=max2f(a,b);
  auto rr=__builtin_amdgcn_permlane32_swap(__float_as_uint(m),__float_as_uint(m),false,false);
  return max2f(__uint_as_float(rr[0]),__uint_as_float(rr[1]));
}
__device__ __forceinline__ void pv(f32x16*o,int vb,bf16x8 pa0,bf16x8 pa1,bf16x8 pa2,bf16x8 pa3){
  #pragma unroll
  for(int d0=0;d0<2;++d0){s16x4 lo[4],hi[4];
    #pragma unroll
    for(int ks=0;ks<4;++ks){
      asm volatile("ds_read_b64_tr_b16 %0,%1 offset:%c2":"=&v"(lo[ks]):"v"(vb),"i"(d0*4096+ks*1024):"memory");
      asm volatile("ds_read_b64_tr_b16 %0,%1 offset:%c2":"=&v"(hi[ks]):"v"(vb),"i"(d0*4096+ks*1024+512):"memory");}
    asm volatile("s_waitcnt lgkmcnt(0)":::"memory");SBAR();
    #define PK(k) (bf16x8){lo[k][0],lo[k][1],lo[k][2],lo[k][3],hi[k][0],hi[k][1],hi[k][2],hi[k][3]}
    o[d0]=__builtin_amdgcn_mfma_f32_32x32x16_bf16(pa0,PK(0),o[d0],0,0,0);
    o[d0]=__builtin_amdgcn_mfma_f32_32x32x16_bf16(pa1,PK(1),o[d0],0,0,0);
    o[d0]=__builtin_amdgcn_mfma_f32_32x32x16_bf16(pa2,PK(2),o[d0],0,0,0);
    o[d0]=__builtin_amdgcn_mfma_f32_32x32x16_bf16(pa3,PK(3),o[d0],0,0,0);
    #undef PK
  }
}

#ifndef ATTN_STORE16
#define ATTN_STORE16(p,v) (*(u32x4*)(p)=(v))
#endif
template<int THRL,int PQ,int PK,int PV,int PO> __device__ __forceinline__ void attn_unit(int q0,const bf16*Qu,const bf16*__restrict__ Kh,const bf16*__restrict__ Vh,bf16*Ou,char*shm){
  int tid=threadIdx.x; asm volatile("":"+v"(tid)); const int lane=tid&63,r32=lane&31,hi=lane>>5; const int wid=__builtin_amdgcn_readfirstlane(tid>>6);
  const bf16*Qw=Qu+(long)(wid*QBLK)*PQ;
  const unsigned lds0=(unsigned)(uintptr_t)shm;
  float*wsf=(float*)(shm+LDS_WS)+wid*64;
  const bf16*ksrc=Kh+(long)lane*PK+wid*8;
  const bf16*vsrc=Vh+(long)(16*(wid&3)+(lane>>2))*PV+(wid>>2)*32+(lane&3)*8;
  const unsigned kdst=lds0+LDS_K+wid*1024, vdst=lds0+LDS_V+wid*1024;
  #define DMA_K(t,slot) glds16(ksrc+(long)(t)*KVBLK*PK,(unsigned)__builtin_amdgcn_readfirstlane(kdst+(slot)))
  #define DMA_V(t,slot) glds16(vsrc+(long)(t)*KVBLK*PV,(unsigned)__builtin_amdgcn_readfirstlane(vdst+(slot)))
  const int vb0=(int)(lds0+LDS_V)+((lane>>4)&1)*32+(lane&3)*8+(4*hi+((lane&15)>>2))*64;
  const char*Kbase=shm+LDS_K; bf16x8 kf[8];
  const lds_cptr shm3=(lds_cptr)shm; const lds_cptr kp0=shm3+LDS_K+hi*1024+r32*16; const lds_cptr vp0=shm3+LDS_V+((lane>>4)&1)*32+(lane&3)*8+(4*hi+((lane&15)>>2))*64;
  const int NT=(q0+QB)/KVBLK;
  DMA_K(0,0);DMA_V(0,0);DMA_K(1,SLOTB);
  bf16x8 qr[4];
  #pragma unroll
  for(int d0=0;d0<4;++d0)qr[d0]=*reinterpret_cast<const bf16x8*>(&Qw[(long)r32*PQ+d0*16+hi*8]);
  float mhat=0.f,l_reg=0.f;f32x16 o[2];o[0]=f32x16{};o[1]=f32x16{};f32x16 negm=f32x16{};asm volatile("":"+v"(negm));
  const int qrel=wid*QBLK+r32;
  #define CMASK(P0,P1,t) do{int jb_=(t)-(NT-4); if(jb_>=0)cmask(P0,P1,jb_,qrel,hi);}while(0)
  bool resc=false;
  #define START(P0,P1) do{ const float rm=rowmax(P0,P1); resc=false; \
    { const float dl=rm; mhat=fadd_s(mhat,dl); \
      _Pragma("unroll") for(int r=0;r<16;++r){P0[r]=fsub_s(P0[r],dl);P1[r]=fsub_s(P1[r],dl);} \
      _Pragma("unroll") for(int r=0;r<16;++r)negm[r]=-mhat; asm volatile("":"+v"(negm)); } \
    _Pragma("unroll") for(int r=0;r<16;++r)P0[r]=__builtin_amdgcn_exp2f(P0[r]); }while(0)
  #define RESC() do{ if(resc){ asm volatile("s_waitcnt lgkmcnt(0)":::"memory"); \
      _Pragma("unroll") for(int d_=0;d_<2;++d_) _Pragma("unroll") for(int r=0;r<16;++r)o[d_][r]*=wsf[crow(r,hi)]; } }while(0)
  f32x16 pA0,pA1,pB0,pB1;
  int sl_prev=0,sl_cur=0,sl_next=SLOTB;
  #define ROT() do{sl_prev=sl_cur;sl_cur=sl_next;sl_next=(sl_next==(NSLOT-1)*SLOTB)?0:sl_next+SLOTB;}while(0)
  DMA_K(2,2*SLOTB);
  WAIT_BAR(3);
  qkt(pA0,pA1,Kbase,qr,negm,r32,hi);asm volatile("s_nop 15\n\ts_nop 7":"+v"(pA0),"+v"(pA1));CMASK(pA0,pA1,0);
  START(pA0,pA1);
  _Pragma("unroll") for(int r=0;r<16;++r)pA1[r]=__builtin_amdgcn_exp2f(pA1[r]);
  WAIT_BAR(0);
  DMA_K(3,0);DMA_V(1,SLOTB);
  ROT();
  kload8(kf,kp0+sl_cur);
  WAIT_BAR(2);
  s16x4 vlo[8],vhi[8]; u32x4 pw0,pw1,pw2,pw3;
  #define PKW(P,B) cvtpk_s(P[B],P[B+1])
  #define PAF(k) __builtin_bit_cast(bf16x8,pw##k)
  #define VFR(i) (bf16x8){vlo[i][0],vlo[i][1],vlo[i][2],vlo[i][3],vhi[i][0],vhi[i][1],vhi[i][2],vhi[i][3]}
  #define PIN(x) asm volatile("":"+v"(x))
  #define MX3(a,b,c) __builtin_fmaxf(__builtin_fmaxf((a),(b)),(c))
  #define GAPA(MF,A0,A1,A2,A3,W0,W1,PW) do{ MF; sacc+=A0; sacc+=A1; sacc+=A2; sacc+=A3; PIN(sacc); W0; W1; PIN(PW); SBAR(); }while(0)
  #define EX(v) __builtin_amdgcn_exp2f(v)
  #define GAPB(MF,X,B) do{ MF; X[B]=EX(X[B]); X[B+1]=EX(X[B+1]); X[B+2]=EX(X[B+2]); X[B+3]=EX(X[B+3]); PIN(X); SBAR(); }while(0)
  #define VRD(i) do{ vlo[i]=vtr(vp_+(((i)>>2)*4096+((i)&3)*1024)); vhi[i]=vtr(vp_+(((i)>>2)*4096+((i)&3)*1024+512)); }while(0)
  #define KRD(G,j) do{ if(G){ kload2(kf,kp0+sl_next,j); SBAR(); } }while(0)
  #define STEP(C0,C1,P0,P1,t,GK,GV,GL) do{ SBAR(); \
    const lds_cptr vp_=vp0+sl_prev; \
    VRD(0); SBAR(); float sacc=(P0[0]+P0[1]); \
    GAPA(C0=__builtin_amdgcn_mfma_f32_32x32x16_bf16(kf[0],qr[0],negm,0,0,0), P0[2],P0[3],P0[4],P0[5],     pw0[0]=PKW(P0,0), pw0[1]=PKW(P0,2), pw0); \
    VRD(4); SBAR(); GAPA(C1=__builtin_amdgcn_mfma_f32_32x32x16_bf16(kf[1],qr[0],negm,0,0,0), P0[6],P0[7],P0[8],P0[9],     pw0[2]=PKW(P0,4), pw0[3]=PKW(P0,6), pw0); \
    VRD(1); SBAR(); GAPA(C0=__builtin_amdgcn_mfma_f32_32x32x16_bf16(kf[2],qr[1],C0,0,0,0),   P0[10],P0[11],P0[12],P0[13], pw1[0]=PKW(P0,8), pw1[1]=PKW(P0,10), pw1); \
    VRD(5); SBAR(); GAPA(C1=__builtin_amdgcn_mfma_f32_32x32x16_bf16(kf[3],qr[1],C1,0,0,0),   P0[14],P0[15],P1[0],P1[1],   pw1[2]=PKW(P0,12),pw1[3]=PKW(P0,14), pw1); \
    VRD(2); SBAR(); GAPA(C0=__builtin_amdgcn_mfma_f32_32x32x16_bf16(kf[4],qr[2],C0,0,0,0),   P1[2],P1[3],P1[4],P1[5],     pw2[0]=PKW(P1,0), pw2[1]=PKW(P1,2), pw2); \
    VRD(6); SBAR(); GAPA(C1=__builtin_amdgcn_mfma_f32_32x32x16_bf16(kf[5],qr[2],C1,0,0,0),   P1[6],P1[7],P1[8],P1[9],     pw2[2]=PKW(P1,4), pw2[3]=PKW(P1,6), pw2); \
    VRD(3); SBAR(); GAPA(C0=__builtin_amdgcn_mfma_f32_32x32x16_bf16(kf[6],qr[3],C0,0,0,0),   P1[10],P1[11],P1[12],P1[13], pw3[0]=PKW(P1,8), pw3[1]=PKW(P1,10), pw3); \
    VRD(7); SBAR(); GAPA(C1=__builtin_amdgcn_mfma_f32_32x32x16_bf16(kf[7],qr[3],C1,0,0,0),   P1[14],P1[15],0.f,0.f,       pw3[2]=PKW(P1,12),pw3[3]=PKW(P1,14), pw3); \
    l_reg+=sacc; \
    if(GK){DMA_K((t)+3,sl_cur);} if(GV){DMA_V((t)+1,sl_next);} \
    CMASK(C0,C1,t); \
    { float a=MX3(C0[0],C0[1],C1[0]),b=MX3(C0[2],C0[3],C1[1]); a=MX3(a,C1[2],C1[3]); \
      _Pragma("unroll") for(int r=4;r<16;r+=4){a=MX3(a,C0[r],C0[r+1]);b=MX3(b,C0[r+2],C0[r+3]);a=MX3(a,C1[r],C1[r+1]);b=MX3(b,C1[r+2],C1[r+3]);} \
      float rm=__builtin_fmaxf(a,b); { auto rr=__builtin_amdgcn_permlane32_swap(__float_as_uint(rm),__float_as_uint(rm),false,false); rm=__builtin_fmaxf(__uint_as_float(rr[0]),__uint_as_float(rr[1])); } \
      resc=false; \
      if(__builtin_expect(__any(rm>(float)THRL),0)){ const float dl=__builtin_fmaxf(rm,0.f); mhat+=dl; \
        _Pragma("unroll") for(int r=0;r<16;++r){C0[r]-=dl;C1[r]-=dl;} \
        _Pragma("unroll") for(int r=0;r<16;++r)negm[r]=-mhat; asm volatile("":"+v"(negm)); \
        const float f=__builtin_amdgcn_exp2f(-dl); l_reg*=f; if(hi==0)wsf[r32]=f; resc=true; } } \
    SBAR(); \
    GAPB(o[0]=__builtin_amdgcn_mfma_f32_32x32x16_bf16(PAF(0),VFR(0),o[0],0,0,0), C0,0); \
    GAPB(o[1]=__builtin_amdgcn_mfma_f32_32x32x16_bf16(PAF(0),VFR(4),o[1],0,0,0), C0,4); \
    KRD(GL,0); GAPB(o[0]=__builtin_amdgcn_mfma_f32_32x32x16_bf16(PAF(1),VFR(1),o[0],0,0,0), C0,8); \
    KRD(GL,1); GAPB(o[1]=__builtin_amdgcn_mfma_f32_32x32x16_bf16(PAF(1),VFR(5),o[1],0,0,0), C0,12); \
    KRD(GL,2); GAPB(o[0]=__builtin_amdgcn_mfma_f32_32x32x16_bf16(PAF(2),VFR(2),o[0],0,0,0), C1,0); \
    KRD(GL,3); GAPB(o[1]=__builtin_amdgcn_mfma_f32_32x32x16_bf16(PAF(2),VFR(6),o[1],0,0,0), C1,4); \
    GAPB(o[0]=__builtin_amdgcn_mfma_f32_32x32x16_bf16(PAF(3),VFR(3),o[0],0,0,0), C1,8); \
    GAPB(o[1]=__builtin_amdgcn_mfma_f32_32x32x16_bf16(PAF(3),VFR(7),o[1],0,0,0), C1,12); \
    }while(0)
  int t=1;
  #undef CMASK
  #define CMASK(P0,P1,t) do{}while(0)
  for(;t+5<NT;t+=2){
    STEP(pB0,pB1,pA0,pA1,t,true,true,true);     WAIT_BAR(2); RESC(); ROT();
    STEP(pA0,pA1,pB0,pB1,t+1,true,true,true);   WAIT_BAR(2); RESC(); ROT();
  }
  #undef CMASK
  #define CMASK(P0,P1,t) do{int jb_=(t)-(NT-4); if(jb_>=0)cmask(P0,P1,jb_,qrel,hi);}while(0)
  #define ENDW(tt) do{ if((tt)+3<NT){WAIT_BAR(2);} else if((tt)+2<NT){WAIT_BAR(1);} else {WAIT_BAR(0);} }while(0)
  for(;t+1<NT;t+=2){
    STEP(pB0,pB1,pA0,pA1,t,(t+3<NT),(t+1<NT),(t+1<NT));       ENDW(t);   RESC(); ROT();
    STEP(pA0,pA1,pB0,pB1,t+1,(t+4<NT),(t+2<NT),(t+2<NT));     ENDW(t+1); RESC(); ROT();
  }
  STEP(pB0,pB1,pA0,pA1,NT-1,false,false,false); RESC();
  { float sacc=pB0[0]+pB0[1]; _Pragma("unroll") for(int r=2;r<16;++r)sacc+=pB0[r]; _Pragma("unroll") for(int r=0;r<16;++r)sacc+=pB1[r]; l_reg+=sacc;
    pw0=(u32x4){PKW(pB0,0),PKW(pB0,2),PKW(pB0,4),PKW(pB0,6)};pw1=(u32x4){PKW(pB0,8),PKW(pB0,10),PKW(pB0,12),PKW(pB0,14)};pw2=(u32x4){PKW(pB1,0),PKW(pB1,2),PKW(pB1,4),PKW(pB1,6)};pw3=(u32x4){PKW(pB1,8),PKW(pB1,10),PKW(pB1,12),PKW(pB1,14)};
    SBAR(); pv(o,vb0+sl_cur,PAF(0),PAF(1),PAF(2),PAF(3)); }
  #undef PKW
  #undef PAF
  #undef VFR
  #undef PIN
  #undef MX3
  #undef GAPA
  #undef GAPB
  #undef EX
  #undef VRD
  #undef KRD
  #undef STEP
  #undef ENDW
  {auto rr=__builtin_amdgcn_permlane32_swap(__float_as_uint(l_reg),__float_as_uint(l_reg),false,false);l_reg=__uint_as_float(rr[0])+__uint_as_float(rr[1]);}
  if(hi==0)wsf[32+r32]=l_reg;asm volatile("s_waitcnt lgkmcnt(0)":::"memory");
  float rli[16];
  #pragma unroll
  for(int r=0;r<16;++r)rli[r]=__builtin_amdgcn_rcpf(wsf[32+crow(r,hi)]);
  bf16*Ow=Ou+(long)(wid*QBLK)*PO;
  { bf16*stg=(bf16*)(shm+LDS_OST)+wid*2048;
    #pragma unroll
    for(int r=0;r<16;++r){const int orow=crow(r,hi);
      #pragma unroll
      for(int d0=0;d0<2;++d0)stg[orow*64+d0*32+r32]=__float2bfloat16(o[d0][r]*rli[r]);}
    asm volatile("s_waitcnt lgkmcnt(0)":::"memory");
    #pragma unroll
    for(int i=0;i<4;++i){const int row=i*8+(lane>>3),ch=lane&7; const u32x4 v=*(const u32x4*)(stg+row*64+ch*8); ATTN_STORE16(Ow+(long)row*PO+ch*8,v);} }
  asm volatile("s_waitcnt lgkmcnt(0)\n\ts_barrier":::"memory");
  #undef DMA_K
  #undef DMA_V
  #undef CMASK
  #undef START
  #undef RESC
  #undef ROT
}
constexpr int VSLOTB=16384;
constexpr int L2_K=0, L2_V=NSLOT*SLOTB, L2_WS=L2_V+NSLOT*VSLOTB, L2_OST=L2_WS+NW*64*4, L2_QS=L2_OST+NW*4096, L2_BYTES=L2_QS+NW*4096;
__device__ __forceinline__ void pv128(f32x16*o,int vb,bf16x8 pa0,bf16x8 pa1,bf16x8 pa2,bf16x8 pa3){
  #pragma unroll
  for(int d0=0;d0<4;++d0){s16x4 lo[4],hi[4];
    #pragma unroll
    for(int ks=0;ks<4;++ks){
      asm volatile("ds_read_b64_tr_b16 %0,%1 offset:%c2":"=&v"(lo[ks]):"v"(vb),"i"(d0*4096+ks*1024):"memory");
      asm volatile("ds_read_b64_tr_b16 %0,%1 offset:%c2":"=&v"(hi[ks]):"v"(vb),"i"(d0*4096+ks*1024+512):"memory");}
    asm volatile("s_waitcnt lgkmcnt(0)":::"memory");SBAR();
    #define PK(k) (bf16x8){lo[k][0],lo[k][1],lo[k][2],lo[k][3],hi[k][0],hi[k][1],hi[k][2],hi[k][3]}
    o[d0]=__builtin_amdgcn_mfma_f32_32x32x16_bf16(pa0,PK(0),o[d0],0,0,0);
    o[d0]=__builtin_amdgcn_mfma_f32_32x32x16_bf16(pa1,PK(1),o[d0],0,0,0);
    o[d0]=__builtin_amdgcn_mfma_f32_32x32x16_bf16(pa2,PK(2),o[d0],0,0,0);
    o[d0]=__builtin_amdgcn_mfma_f32_32x32x16_bf16(pa3,PK(3),o[d0],0,0,0);
    #undef PK
  }
}
template<int THRL,int PQ,int PK,int PV,int PO> __device__ __forceinline__ void attn_unit128(int q0,const bf16*Qu,const bf16*__restrict__ Kh,const bf16*__restrict__ Vh,bf16*Ou,char*shm){
  int tid=threadIdx.x; asm volatile("":"+v"(tid)); const int lane=tid&63,r32=lane&31,hi=lane>>5; const int wid=__builtin_amdgcn_readfirstlane(tid>>6);
  const bf16*Qw=Qu+(long)(wid*QBLK)*PQ;
  const unsigned lds0=(unsigned)(uintptr_t)shm;
  float*wsf=(float*)(shm+L2_WS)+wid*64;
  const bf16*ksrc=Kh+(long)lane*PK+wid*8;
  const bf16*vsrc=Vh+(long)(16*(wid&3)+(lane>>2))*PV+(wid>>2)*32+(lane&3)*8;
  const unsigned kdst=lds0+L2_K+wid*1024, vdst=lds0+L2_V+wid*1024;
  #define DMA_K(t,slot) glds16(ksrc+(long)(t)*KVBLK*PK,(unsigned)__builtin_amdgcn_readfirstlane(kdst+(slot)))
  #define DMA_V(t,slot) do{ glds16(vsrc+(long)(t)*KVBLK*PV,(unsigned)__builtin_amdgcn_readfirstlane(vdst+2*(slot))); glds16(vsrc+(long)(t)*KVBLK*PV+64,(unsigned)__builtin_amdgcn_readfirstlane(vdst+2*(slot)+8192)); }while(0)
  const int vb0=(int)(lds0+L2_V)+((lane>>4)&1)*32+(lane&3)*8+(4*hi+((lane&15)>>2))*64;
  const char*Kbase=shm+L2_K; bf16x8 kf[8];
  const lds_cptr shm3=(lds_cptr)shm; const lds_cptr kp0=shm3+L2_K+hi*1024+r32*16; const lds_cptr vp0=shm3+L2_V+((lane>>4)&1)*32+(lane&3)*8+(4*hi+((lane&15)>>2))*64;
  const int NT=(q0+QB)/KVBLK;
  DMA_K(0,0);DMA_V(0,0);DMA_K(1,SLOTB);
  bf16x8 qr[4];
  #pragma unroll
  for(int d0=0;d0<4;++d0)qr[d0]=*(const __attribute__((address_space(1))) bf16x8*)(&Qw[(long)r32*PQ+d0*16+hi*8]);
  typedef __attribute__((address_space(3))) bf16x8* lds_q_ptr; const lds_q_ptr qsp=(lds_q_ptr)((__attribute__((address_space(3))) char*)shm+L2_QS+wid*4096+lane*16);
  #pragma unroll
  for(int d0=0;d0<4;++d0)qsp[d0*64]=qr[d0];
  #define QL(d0) (qsp[(d0)*64])
  float mhat=0.f,l_reg=0.f;f32x16 o[4];o[0]=f32x16{};o[1]=f32x16{};o[2]=f32x16{};o[3]=f32x16{};f32x16 negm=f32x16{};asm volatile("":"+v"(negm));
  const int qrel=wid*QBLK+r32;
  #define CMASK(P0,P1,t) do{int jb_=(t)-(NT-4); if(jb_>=0)cmask(P0,P1,jb_,qrel,hi);}while(0)
  bool resc=false;
  #define START(P0,P1) do{ const float rm=rowmax(P0,P1); resc=false; \
    { const float dl=rm; mhat=fadd_s(mhat,dl); \
      _Pragma("unroll") for(int r=0;r<16;++r){P0[r]=fsub_s(P0[r],dl);P1[r]=fsub_s(P1[r],dl);} \
      _Pragma("unroll") for(int r=0;r<16;++r)negm[r]=-mhat; asm volatile("":"+v"(negm)); } \
    _Pragma("unroll") for(int r=0;r<16;++r)P0[r]=__builtin_amdgcn_exp2f(P0[r]); }while(0)
  #define RESC() do{ if(resc){ asm volatile("s_waitcnt lgkmcnt(0)":::"memory"); \
      _Pragma("unroll") for(int d_=0;d_<4;++d_) _Pragma("unroll") for(int r=0;r<16;++r)o[d_][r]*=wsf[crow(r,hi)]; } }while(0)
  f32x16 pA0,pA1,pB0,pB1;
  int sl_prev=0,sl_cur=0,sl_next=SLOTB;
  #define ROT() do{sl_prev=sl_cur;sl_cur=sl_next;sl_next=(sl_next==(NSLOT-1)*SLOTB)?0:sl_next+SLOTB;}while(0)
  DMA_K(2,2*SLOTB);
  WAIT_BAR(3);
  qkt(pA0,pA1,Kbase,qr,negm,r32,hi);asm volatile("s_nop 15\n\ts_nop 7":"+v"(pA0),"+v"(pA1));CMASK(pA0,pA1,0);
  START(pA0,pA1);
  _Pragma("unroll") for(int r=0;r<16;++r)pA1[r]=__builtin_amdgcn_exp2f(pA1[r]);
  WAIT_BAR(0);
  DMA_K(3,0);DMA_V(1,SLOTB);
  ROT();
  kload8(kf,kp0+sl_cur);
  bf16x8 qa=QL(0), qb=QL(1);
  WAIT_BAR(3);
  s16x4 val,vah,vbl,vbh,vcl,vch,vdl,vdh; u32x4 pw0,pw1,pw2,pw3;
  #define PKW(P,B) cvtpk_s(P[B],P[B+1])
  #define PAF(k) __builtin_bit_cast(bf16x8,pw##k)
  #define PIN(x) asm volatile("":"+v"(x))
  #define MX3(a,b,c) __builtin_fmaxf(__builtin_fmaxf((a),(b)),(c))
  #define GAPA(MF,A0,A1,A2,A3,W0,W1,PW) do{ MF; sacc+=A0; sacc+=A1; sacc+=A2; sacc+=A3; PIN(sacc); W0; W1; PIN(PW); SBAR(); }while(0)
  #define EX(v) __builtin_amdgcn_exp2f(v)
  #define GAPB(MF,X,B) do{ MF; X[B]=EX(X[B]); X[B+1]=EX(X[B+1]); PIN(X); SBAR(); }while(0)
  #define VADDR(n) ((((n)&3)*4096)+(((n)>>2)*1024))
  #define VLD(S,n) do{ S##l=vtr(vp_+VADDR(n)); S##h=vtr(vp_+VADDR(n)+512); SBAR(); }while(0)
  #define VFRS(S) (bf16x8){S##l[0],S##l[1],S##l[2],S##l[3],S##h[0],S##h[1],S##h[2],S##h[3]}
  #define MF32(A,B,C) __builtin_amdgcn_mfma_f32_32x32x16_bf16(A,B,C,0,0,0)
  #define KRD(G,j) do{ if(G){ kload2(kf,kp0+sl_next,j); SBAR(); } }while(0)
  #define STEP(C0,C1,P0,P1,t,GK,GV,GL) do{ SBAR(); \
    const lds_cptr vp_=vp0+2*sl_prev; \
    float sacc=(P0[0]+P0[1]); \
    GAPA(C0=MF32(kf[0],qa,negm), P0[2],P0[3],P0[4],P0[5],     pw0[0]=PKW(P0,0), pw0[1]=PKW(P0,2), pw0); \
    GAPA(C1=MF32(kf[1],qa,negm), P0[6],P0[7],P0[8],P0[9],     pw0[2]=PKW(P0,4), pw0[3]=PKW(P0,6), pw0); \
    qa=QL(2); SBAR(); GAPA(C0=MF32(kf[2],qb,C0),     P0[10],P0[11],P0[12],P0[13], pw1[0]=PKW(P0,8), pw1[1]=PKW(P0,10), pw1); \
    GAPA(C1=MF32(kf[3],qb,C1),     P0[14],P0[15],P1[0],P1[1],   pw1[2]=PKW(P0,12),pw1[3]=PKW(P0,14), pw1); \
    qb=QL(3); SBAR(); GAPA(C0=MF32(kf[4],qa,C0),     P1[2],P1[3],P1[4],P1[5],     pw2[0]=PKW(P1,0), pw2[1]=PKW(P1,2), pw2); \
    GAPA(C1=MF32(kf[5],qa,C1),     P1[6],P1[7],P1[8],P1[9],     pw2[2]=PKW(P1,4), pw2[3]=PKW(P1,6), pw2); \
    GAPA(C0=MF32(kf[6],qb,C0),     P1[10],P1[11],P1[12],P1[13], pw3[0]=PKW(P1,8), pw3[1]=PKW(P1,10), pw3); \
    GAPA(C1=MF32(kf[7],qb,C1),     P1[14],P1[15],0.f,0.f,       pw3[2]=PKW(P1,12),pw3[3]=PKW(P1,14), pw3); \
    l_reg+=sacc; \
    VLD(va,0); VLD(vb,1); VLD(vc,2); \
    if(GK){DMA_K((t)+3,sl_cur);} if(GV){DMA_V((t)+1,sl_next);} \
    CMASK(C0,C1,t); \
    { float a=MX3(C0[0],C0[1],C1[0]),b=MX3(C0[2],C0[3],C1[1]); a=MX3(a,C1[2],C1[3]); \
      _Pragma("unroll") for(int r=4;r<16;r+=4){a=MX3(a,C0[r],C0[r+1]);b=MX3(b,C0[r+2],C0[r+3]);a=MX3(a,C1[r],C1[r+1]);b=MX3(b,C1[r+2],C1[r+3]);} \
      float rm=__builtin_fmaxf(a,b); { auto rr=__builtin_amdgcn_permlane32_swap(__float_as_uint(rm),__float_as_uint(rm),false,false); rm=__builtin_fmaxf(__uint_as_float(rr[0]),__uint_as_float(rr[1])); } \
      resc=false; \
      if(__builtin_expect(__any(rm>(float)THRL),0)){ const float dl=__builtin_fmaxf(rm,0.f); mhat+=dl; \
        _Pragma("unroll") for(int r=0;r<16;++r){C0[r]-=dl;C1[r]-=dl;} \
        _Pragma("unroll") for(int r=0;r<16;++r)negm[r]=-mhat; asm volatile("":"+v"(negm)); \
        const float f=__builtin_amdgcn_exp2f(-dl); l_reg*=f; if(hi==0)wsf[r32]=f; resc=true; } } \
    SBAR(); \
    VLD(vd,3); GAPB(o[0]=MF32(PAF(0),VFRS(va),o[0]), C0,0); \
    VLD(va,4); GAPB(o[1]=MF32(PAF(0),VFRS(vb),o[1]), C0,2); \
    VLD(vb,5); GAPB(o[2]=MF32(PAF(0),VFRS(vc),o[2]), C0,4); \
    VLD(vc,6); GAPB(o[3]=MF32(PAF(0),VFRS(vd),o[3]), C0,6); \
    VLD(vd,7); KRD(GL,0); GAPB(o[0]=MF32(PAF(1),VFRS(va),o[0]), C0,8); \
    VLD(va,8); KRD(GL,1); GAPB(o[1]=MF32(PAF(1),VFRS(vb),o[1]), C0,10); \
    VLD(vb,9); KRD(GL,2); GAPB(o[2]=MF32(PAF(1),VFRS(vc),o[2]), C0,12); \
    VLD(vc,10); KRD(GL,3); GAPB(o[3]=MF32(PAF(1),VFRS(vd),o[3]), C0,14); \
    VLD(vd,11); GAPB(o[0]=MF32(PAF(2),VFRS(va),o[0]), C1,0); \
    VLD(va,12); GAPB(o[1]=MF32(PAF(2),VFRS(vb),o[1]), C1,2); \
    VLD(vb,13); GAPB(o[2]=MF32(PAF(2),VFRS(vc),o[2]), C1,4); \
    VLD(vc,14); GAPB(o[3]=MF32(PAF(2),VFRS(vd),o[3]), C1,6); \
    VLD(vd,15); GAPB(o[0]=MF32(PAF(3),VFRS(va),o[0]), C1,8); \
    GAPB(o[1]=MF32(PAF(3),VFRS(vb),o[1]), C1,10); \
    GAPB(o[2]=MF32(PAF(3),VFRS(vc),o[2]), C1,12); \
    GAPB(o[3]=MF32(PAF(3),VFRS(vd),o[3]), C1,14); \
    qa=QL(0); qb=QL(1);   \
    }while(0)
  int t=1;
  #undef CMASK
  #define CMASK(P0,P1,t) do{}while(0)
  for(;t+5<NT;t+=2){
    STEP(pB0,pB1,pA0,pA1,t,true,true,true);     WAIT_BAR(3); RESC(); ROT();
    STEP(pA0,pA1,pB0,pB1,t+1,true,true,true);   WAIT_BAR(3); RESC(); ROT();
  }
  #undef CMASK
  #define CMASK(P0,P1,t) do{int jb_=(t)-(NT-4); if(jb_>=0)cmask(P0,P1,jb_,qrel,hi);}while(0)
  #define ENDW(tt) do{ if((tt)+3<NT){WAIT_BAR(3);} else if((tt)+2<NT){WAIT_BAR(2);} else {WAIT_BAR(0);} }while(0)
  for(;t+1<NT;t+=2){
    STEP(pB0,pB1,pA0,pA1,t,(t+3<NT),(t+1<NT),(t+1<NT));       ENDW(t);   RESC(); ROT();
    STEP(pA0,pA1,pB0,pB1,t+1,(t+4<NT),(t+2<NT),(t+2<NT));     ENDW(t+1); RESC(); ROT();
  }
  STEP(pB0,pB1,pA0,pA1,NT-1,false,false,false); RESC();
  { float sacc=pB0[0]+pB0[1]; _Pragma("unroll") for(int r=2;r<16;++r)sacc+=pB0[r]; _Pragma("unroll") for(int r=0;r<16;++r)sacc+=pB1[r]; l_reg+=sacc;
    pw0=(u32x4){PKW(pB0,0),PKW(pB0,2),PKW(pB0,4),PKW(pB0,6)};pw1=(u32x4){PKW(pB0,8),PKW(pB0,10),PKW(pB0,12),PKW(pB0,14)};pw2=(u32x4){PKW(pB1,0),PKW(pB1,2),PKW(pB1,4),PKW(pB1,6)};pw3=(u32x4){PKW(pB1,8),PKW(pB1,10),PKW(pB1,12),PKW(pB1,14)};
    SBAR(); pv128(o,vb0+2*sl_cur,PAF(0),PAF(1),PAF(2),PAF(3)); }
  #undef PKW
  #undef PAF
  #undef QL
  #undef VADDR
  #undef VLD
  #undef VFRS
  #undef MF32
  #undef PIN
  #undef MX3
  #undef GAPA
  #undef GAPB
  #undef EX
  #undef KRD
  #undef STEP
  #undef ENDW
  {auto rr=__builtin_amdgcn_permlane32_swap(__float_as_uint(l_reg),__float_as_uint(l_reg),false,false);l_reg=__uint_as_float(rr[0])+__uint_as_float(rr[1]);}
  if(hi==0)wsf[32+r32]=l_reg;asm volatile("s_waitcnt lgkmcnt(0)":::"memory");
  float rli[16];
  #pragma unroll
  for(int r=0;r<16;++r)rli[r]=__builtin_amdgcn_rcpf(wsf[32+crow(r,hi)]);
  bf16*Ow=Ou+(long)(wid*QBLK)*PO;
  { bf16*stg=(bf16*)(shm+L2_OST)+wid*2048;
    #pragma unroll
    for(int hp=0;hp<2;++hp){
      #pragma unroll
      for(int r=0;r<16;++r){const int orow=crow(r,hi);
        #pragma unroll
        for(int d0=0;d0<2;++d0)stg[orow*64+d0*32+r32]=__float2bfloat16(o[hp*2+d0][r]*rli[r]);}
      asm volatile("s_waitcnt lgkmcnt(0)":::"memory");
      #pragma unroll
      for(int i=0;i<4;++i){const int row=i*8+(lane>>3),ch=lane&7; const u32x4 v=*(const u32x4*)(stg+row*64+ch*8); *(__attribute__((address_space(1))) u32x4*)(Ow+(long)row*PO+hp*64+ch*8)=v;}
      asm volatile("s_waitcnt lgkmcnt(0)":::"memory");
    } }
  asm volatile("s_waitcnt lgkmcnt(0)\n\ts_barrier":::"memory");
  #undef DMA_K
  #undef DMA_V
  #undef CMASK
  #undef START
  #undef RESC
  #undef ROT
}
constexpr int ATTN_LDS_BYTES=LDS_BYTES;
#undef SBAR
#undef WAIT_BAR
}

#ifndef MK_MULTI
#define MK_MULTI 0
#endif
#ifndef REP_GEMM
#define REP_GEMM 1
#endif
#ifndef REP_ATTN
#define REP_ATTN 1
#endif
#ifndef REP_LIGHT
#define REP_LIGHT 1
#endif
#define LAS __attribute__((address_space(3)))
typedef unsigned short bf16;
typedef float f32x4 __attribute__((ext_vector_type(4)));
typedef unsigned u32x4 __attribute__((ext_vector_type(4)));
typedef unsigned u32x2 __attribute__((ext_vector_type(2)));
typedef short bf16x8 __attribute__((ext_vector_type(8)));
using pg8::cvt_pk_bf16;

constexpr int DM = 1024, NB = 4, SEQ = 8192, T = NB * SEQ, DEPTH = 2;
constexpr int NIN = 8704, NPROJ = 5632, NGATE = 3072;
constexpr float EPS = 1e-6f;
constexpr float C2 = 0.18033688011112042f;
__device__ const float LG2[4] = {-0.04580368961312479f, -0.02272007650008353f, -0.011315313227834146f, -0.005646563141142063f};
__device__ const float INV_A[8] = {1.0f, 0.19392274474868576f, 0.03760603093086393f, 0.007292664737217109f, 0.001414213562373095f, 0.0002742481756762073f, 5.318295896944988e-05f, 1.031338537721246e-05f};
__device__ const float INV_R[32] = {1.0f, 0.7429639507594948f, 0.551995432128157f, 0.41011270705513014f, 0.30469895709035083f, 0.22638034095214482f, 0.16819243248808696f, 0.1249609141291987f,
    0.09284145445194744f, 0.06897785379387654f, 0.05124805876960934f, 0.038075460212223716f, 0.028288694346259694f, 0.021017480113324882f, 0.015615230060004972f, 0.011601553017399714f,
    0.008619535664753033f, 0.006404004271197283f, 0.004757944314009409f, 0.0035349811050301057f, 0.0026263635276533325f, 0.0019512934226359642f, 0.0014497406703726315f, 0.001077105056036769f,
    0.0008002502278161052f, 0.0005945570708544394f, 0.00044173447031400687f, 0.0003281927872511474f, 0.0002438354098268829f, 0.00018116091942004152f, 0.00013459603241553644f, 0.0001f};

constexpr size_t MiB = 1u << 20;
constexpr size_t WS_WIN = 2 * MiB;
constexpr size_t WIN_L = (size_t)NIN * DM * 2;
constexpr size_t WS_WBR = 36 * MiB;
constexpr size_t WBR_L = (size_t)3 * DM * 512 * 2;
constexpr size_t WS_WOUT = 42 * MiB;
constexpr size_t WOUT_L = (size_t)DM * DM * 2;
constexpr size_t WS_ROPEA = 46 * MiB;
constexpr size_t WS_ROPER = 46 * MiB + 512 * 1024;
constexpr size_t WS_SSQ = 49 * MiB;
constexpr size_t WS_RSTD = 51 * MiB;
constexpr size_t WS_XB = 52 * MiB;
constexpr size_t WS_PREVT = 116 * MiB;
constexpr size_t WS_ACT = 148 * MiB;
constexpr size_t SEG512 = (size_t)T * 512 * 2;
constexpr size_t WS_QA = WS_ACT, WS_KA = WS_QA + SEG512, WS_VA = WS_KA + SEG512, WS_CX = WS_VA + SEG512, WS_CC = WS_CX + SEG512, WS_SCZ = WS_CC + SEG512,
                 WS_SZA = WS_SCZ + SEG512, WS_CB = WS_SZA + SEG512, WS_RQ = WS_CB + SEG512, WS_RK = WS_RQ + SEG512 / 2, WS_RV = WS_RK + SEG512 / 2, WS_SRZ = WS_RV + SEG512,
                 WS_END = WS_SRZ + SEG512;
constexpr size_t WS_G = WS_QA;
constexpr size_t WS_MERGED = WS_RQ;
constexpr size_t WS_KV = WS_CC;
constexpr size_t WS_OTMP = WS_CX;
static_assert(WS_END == 500 * MiB, "ws map");
constexpr int LDS_BYTES = 147456;
constexpr int NWAVES = 8;

__device__ __forceinline__ int orig_col(int p) {
    if (p < 1024) { int d = p & 63; if (d < 16) { const int blk = d >> 3, half = (d >> 2) & 1, e = d & 3; d = half * 8 + blk * 4 + e; } return (p & ~63) | d; }
    if (p >= 2048 && p < 4096) { const int r = p & 255; return 2048 + 512 * (r >> 6) + 64 * ((p - 2048) >> 8) + (r & 63); }
    if (p >= 4096 && p < 4608) { const int d = p & 63, blk = d >> 3, half = (d >> 2) & 1, e = d & 3; return (p & ~63) | (half * 32 + blk * 4 + e); }
    return p;
}
__device__ __forceinline__ float wave_sum(float v) {
#pragma unroll
    for (int o = 1; o < 64; o <<= 1) v += __shfl_xor(v, o);
    return v;
}
__device__ __forceinline__ float bf2f(unsigned short b) { return __uint_as_float((unsigned)b << 16); }
__device__ __forceinline__ float bflo(unsigned w) { return __uint_as_float(w << 16); }
__device__ __forceinline__ float bfhi(unsigned w) { return __uint_as_float(w & 0xffff0000u); }
__device__ __forceinline__ float sigmoidf_(float x) { return __builtin_amdgcn_rcpf(1.0f + __builtin_amdgcn_exp2f(-1.4426950408889634f * x)); }
__device__ __forceinline__ float siluf_(float x) { return x * sigmoidf_(x); }

__device__ __forceinline__ void unpack8(const u32x4 a, float (&o)[8]) { o[0] = bflo(a.x); o[1] = bfhi(a.x); o[2] = bflo(a.y); o[3] = bfhi(a.y); o[4] = bflo(a.z); o[5] = bfhi(a.z); o[6] = bflo(a.w); o[7] = bfhi(a.w); }
#define GAS __attribute__((address_space(1)))
#define EPI_FENCE() asm volatile("" ::: "memory")
__device__ __forceinline__ float ssq_sum(const f32x4 s0, const f32x4 s1, const f32x4 s2, const f32x4 s3) {
    return ((s0[0] + s0[1]) + (s0[2] + s0[3])) + ((s1[0] + s1[1]) + (s1[2] + s1[3])) + ((s2[0] + s2[1]) + (s2[2] + s2[3])) + ((s3[0] + s3[1]) + (s3[2] + s3[3]));
}
struct EpiProj {
    static constexpr bool PERM = true, AFTER_DRAIN = false;
    unsigned char* ws; const float* rstd; const float2* ropeA; const float2* ropeR;
    __device__ __forceinline__ bool keep(const pg8::Unit&) const { return false; }
    __device__ __forceinline__ void operator()(f32x4 (&acc)[2][2][4][2], const pg8::Unit& u, int wr, int wc, int fr, int fq) const {
        const int pn = u.pn;
        const int row0 = u.pm * 256 + wr * 64 + fr;
        if (pn >= 8 && pn < 16) {
            const bool isu = wc < 2;
            bf16* dstc = (bf16*)(ws + (isu ? WS_CX : WS_CB)) + (pn - 8) * 64 + (wc & 1) * 32 + 8 * fq;
            float rsv[8];
#pragma unroll
            for (int it = 0; it < 8; ++it) rsv[it] = ((const GAS float*)rstd)[row0 + (it >> 2) * 128 + (it & 3) * 16];
            EPI_FENCE();
#pragma unroll
            for (int it = 0; it < 8; ++it) {
                const int ai = it >> 2, m = it & 3, row = row0 + ai * 128 + m * 16;
                const float rs = rsv[it];
                f32x4 a0 = acc[ai][0][m][0] * rs, a1 = acc[ai][0][m][1] * rs, b0 = acc[ai][1][m][0] * rs, b1 = acc[ai][1][m][1] * rs;
                if (!isu) {
#pragma unroll
                    for (int e = 0; e < 4; ++e) { b0[e] = siluf_(b0[e]); b1[e] = siluf_(b1[e]); }
                }
                a0 = a0 * b0; a1 = a1 * b1;
                u32x4 w; w.x = cvt_pk_bf16(a0[0], a0[1]); w.y = cvt_pk_bf16(a0[2], a0[3]); w.z = cvt_pk_bf16(a1[0], a1[1]); w.w = cvt_pk_bf16(a1[2], a1[3]);
                *(GAS u32x4*)(dstc + (size_t)row * 512) = w;
            }
            return;
        }
        int seg, lt;
        if (pn < 16) { seg = pn >> 1; lt = pn & 1; } else if (pn < 18) { seg = 8 + (pn - 16); lt = 0; } else { seg = 10 + ((pn - 18) >> 1); lt = (pn - 18) & 1; }
        size_t off; int pitch = 512;
        switch (seg) {
            case 0: off = WS_QA; break; case 1: off = WS_KA; break; case 2: off = WS_VA; break; case 3: off = WS_SZA; break;
            case 8: off = WS_RQ; pitch = 256; break; case 9: off = WS_RK; pitch = 256; break; case 10: off = WS_RV; break; default: off = WS_SRZ; break;
        }
        bf16* dst = (bf16*)(ws + off);
        const int lc0 = lt * 256 + wc * 32 + 8 * fq;
        const int ropemode = (seg <= 1) ? (((wc & 1) == 0 && fq < 2) ? 1 : 0) : ((seg == 8 || seg == 9) ? 2 : 0);
        const bool dosilu = (seg == 3 || seg == 11);
        const float scale = (seg == 0) ? C2 : ((seg == 9) ? 0.125f : 1.0f);
        const float* ropebase = (ropemode == 1) ? (const float*)(ropeA + 4 * fq) : (const float*)(ropeR + (4 * (wc & 1) + fq) * 4);
        const int ropepitch = (ropemode == 1) ? 16 : 64;
        f32x4 cr0 = (f32x4){0.f, 0.f, 0.f, 0.f}, cr1 = cr0;
        float rsv[8];
#pragma unroll
        for (int it = 0; it < 8; ++it) rsv[it] = ((const GAS float*)rstd)[row0 + (it >> 2) * 128 + (it & 3) * 16];
        { if (ropemode) { const GAS f32x4* rp = (const GAS f32x4*)(ropebase + (size_t)(row0 & (SEQ - 1)) * ropepitch); cr0 = rp[0]; cr1 = rp[1]; } }
#pragma unroll
        for (int it = 0; it < 8; ++it) {
            const int ai = it >> 2, m = it & 3, row = row0 + ai * 128 + m * 16;
            f32x4 nr0 = cr0, nr1 = cr1;
            if (it < 7) { const int rn = row0 + ((it + 1) >> 2) * 128 + ((it + 1) & 3) * 16;
                if (ropemode) { const GAS f32x4* rp = (const GAS f32x4*)(ropebase + (size_t)(rn & (SEQ - 1)) * ropepitch); nr0 = rp[0]; nr1 = rp[1]; } }
            EPI_FENCE();
            const float rs = rsv[it] * scale;
#pragma unroll
            for (int bj = 0; bj < 2; ++bj) {
                f32x4 v0 = acc[ai][bj][m][0] * rs, v1 = acc[ai][bj][m][1] * rs;
                if (ropemode) {
                    const float cs[8] = {cr0[0], cr0[1], cr0[2], cr0[3], cr1[0], cr1[1], cr1[2], cr1[3]};
#pragma unroll
                    for (int e = 0; e < 4; ++e) { const float c = cs[2 * e], s = cs[2 * e + 1], x1 = v0[e], x2 = v1[e]; v0[e] = x1 * c - x2 * s; v1[e] = x2 * c + x1 * s; }
                }
                if (dosilu) {
#pragma unroll
                    for (int e = 0; e < 4; ++e) { v0[e] = siluf_(v0[e]); v1[e] = siluf_(v1[e]); }
                }
                u32x4 w; w.x = cvt_pk_bf16(v0[0], v0[1]); w.y = cvt_pk_bf16(v0[2], v0[3]); w.z = cvt_pk_bf16(v1[0], v1[1]); w.w = cvt_pk_bf16(v1[2], v1[3]);
                *(GAS u32x4*)(dst + (size_t)row * pitch + lc0 + bj * 128) = w;
            }
            cr0 = nr0; cr1 = nr1;
        }
    }
};
struct EpiGate {
    static constexpr bool PERM = true, AFTER_DRAIN = false;
    bf16* G; const float* rstd;
    __device__ __forceinline__ bool keep(const pg8::Unit&) const { return false; }
    __device__ __forceinline__ void operator()(f32x4 (&acc)[2][2][4][2], const pg8::Unit& u, int wr, int wc, int fr, int fq) const {
        const int col0 = u.pn * 256 + wc * 32 + 8 * fq, row0 = u.pm * 256 + wr * 64 + fr;
        float rsv[8];
#pragma unroll
        for (int it = 0; it < 8; ++it) rsv[it] = ((const GAS float*)rstd)[row0 + (it >> 2) * 128 + (it & 3) * 16] * -1.4426950408889634f;
        EPI_FENCE();
#pragma unroll
        for (int it = 0; it < 8; ++it) {
            const int ai = it >> 2, m = it & 3, row = row0 + ai * 128 + m * 16;
            const float rs = rsv[it];
#pragma unroll
            for (int bj = 0; bj < 2; ++bj) {
                f32x4 v0 = acc[ai][bj][m][0] * rs, v1 = acc[ai][bj][m][1] * rs;
#pragma unroll
                for (int e = 0; e < 4; ++e) { v0[e] = fmaxf(__builtin_amdgcn_rcpf(1.0f + __builtin_amdgcn_exp2f(v0[e])), 1e-30f); v1[e] = fmaxf(__builtin_amdgcn_rcpf(1.0f + __builtin_amdgcn_exp2f(v1[e])), 1e-30f); }
                u32x4 w; w.x = cvt_pk_bf16(v0[0], v0[1]); w.y = cvt_pk_bf16(v0[2], v0[3]); w.z = cvt_pk_bf16(v1[0], v1[1]); w.w = cvt_pk_bf16(v1[2], v1[3]);
                *(GAS u32x4*)(G + (size_t)row * NGATE + col0 + bj * 128) = w;
            }
        }
    }
};
struct EpiChain {
    static constexpr bool PERM = true, AFTER_DRAIN = false;
    const bf16* G; bf16* out;
    __device__ __forceinline__ bool keep(const pg8::Unit& u) const { return u.seg != 2; }
    __device__ __forceinline__ void operator()(f32x4 (&acc)[2][2][4][2], const pg8::Unit& u, int wr, int wc, int fr, int fq) const {
        const int col0 = u.pn * 256 + wc * 32 + 8 * fq, row0 = u.pm * 256 + wr * 64 + fr;
        const int seg = u.seg;
        const bf16* gbase = G + seg * DM + col0;
        u32x4 ga[2], gb[2];
#pragma unroll
        for (int bj = 0; bj < 2; ++bj) { const bf16* gp = gbase + (size_t)row0 * NGATE + bj * 128; ga[bj] = *(const GAS u32x4*)gp; gb[bj] = ga[bj]; if (seg != 2) gb[bj] = *(const GAS u32x4*)(gp + DM); }
#pragma unroll
        for (int it = 0; it < 8; ++it) {
            const int ai = it >> 2, m = it & 3, row = row0 + ai * 128 + m * 16;
            u32x4 na[2] = {ga[0], ga[1]}, nb[2] = {gb[0], gb[1]};
            if (it < 7) { const int rn = row0 + ((it + 1) >> 2) * 128 + ((it + 1) & 3) * 16;
#pragma unroll
                for (int bj = 0; bj < 2; ++bj) { const bf16* gp = gbase + (size_t)rn * NGATE + bj * 128; na[bj] = *(const GAS u32x4*)gp; nb[bj] = na[bj]; if (seg != 2) nb[bj] = *(const GAS u32x4*)(gp + DM); } }
            EPI_FENCE();
#pragma unroll
            for (int bj = 0; bj < 2; ++bj) {
                float f[8]; unpack8(ga[bj], f);
                if (seg != 2) {
                    float h[8]; unpack8(gb[bj], h);
#pragma unroll
                    for (int e = 0; e < 8; ++e) f[e] = f[e] * __builtin_amdgcn_rcpf(h[e]);
                }
                f32x4 v0 = acc[ai][bj][m][0], v1 = acc[ai][bj][m][1];
#pragma unroll
                for (int e = 0; e < 4; ++e) { v0[e] *= f[e]; v1[e] *= f[4 + e]; }
                if (seg != 2) { acc[ai][bj][m][0] = v0; acc[ai][bj][m][1] = v1; }
                else {
                    u32x4 w; w.x = cvt_pk_bf16(v0[0], v0[1]); w.y = cvt_pk_bf16(v0[2], v0[3]); w.z = cvt_pk_bf16(v1[0], v1[1]); w.w = cvt_pk_bf16(v1[2], v1[3]);
                    *(GAS u32x4*)(out + (size_t)row * DM + col0 + bj * 128) = w;
                }
            }
            ga[0] = na[0]; ga[1] = na[1]; gb[0] = nb[0]; gb[1] = nb[1];
        }
    }
};
struct ChainOrder {
    pg8::StaticOrder S;
    __device__ bool next(int i, pg8::Unit& u) const { if (!S.next(i / 3, u)) return false; u.seg = i % 3; return true; }
    __device__ __forceinline__ void a_ready(const pg8::Unit&) const {}
    __device__ __forceinline__ void done(const pg8::Unit&) const {}
};
template <bool LAST> struct EpiOutT {
    static constexpr bool PERM = true, AFTER_DRAIN = false;
    const float* xres; const bf16* xbres; float* xout; bf16* xb; float* ssq;
    __device__ __forceinline__ bool keep(const pg8::Unit&) const { return false; }
    __device__ __forceinline__ void operator()(f32x4 (&acc)[2][2][4][2], const pg8::Unit& u, int wr, int wc, int fr, int fq) const {
        const int col0 = u.pn * 256 + wc * 32 + 8 * fq, row0 = u.pm * 256 + wr * 64 + fr;
        f32x4 r[4]; u32x4 rb[2];
#pragma unroll
        for (int bj = 0; bj < 2; ++bj) {
            if (LAST) rb[bj] = *(const GAS u32x4*)(xbres + (size_t)row0 * DM + col0 + bj * 128);
            else { const float* p = xres + (size_t)row0 * DM + col0 + bj * 128; r[2 * bj] = *(const GAS f32x4*)p; r[2 * bj + 1] = *(const GAS f32x4*)(p + 4); } }
#pragma unroll
        for (int it = 0; it < 8; ++it) {
            const int ai = it >> 2, m = it & 3, row = row0 + ai * 128 + m * 16;
            f32x4 nr[4] = {r[0], r[1], r[2], r[3]}; u32x4 nrb[2] = {rb[0], rb[1]};
            if (it < 7) { const int rn = row0 + ((it + 1) >> 2) * 128 + ((it + 1) & 3) * 16;
#pragma unroll
                for (int bj = 0; bj < 2; ++bj) {
                    if (LAST) nrb[bj] = *(const GAS u32x4*)(xbres + (size_t)rn * DM + col0 + bj * 128);
                    else { const float* p = xres + (size_t)rn * DM + col0 + bj * 128; nr[2 * bj] = *(const GAS f32x4*)p; nr[2 * bj + 1] = *(const GAS f32x4*)(p + 4); } } }
            EPI_FENCE();
            float q = 0.f;
#pragma unroll
            for (int bj = 0; bj < 2; ++bj) {
                const size_t o = (size_t)row * DM + col0 + bj * 128;
                f32x4 r0, r1;
                if (LAST) { r0 = (f32x4){bflo(rb[bj].x), bfhi(rb[bj].x), bflo(rb[bj].y), bfhi(rb[bj].y)}; r1 = (f32x4){bflo(rb[bj].z), bfhi(rb[bj].z), bflo(rb[bj].w), bfhi(rb[bj].w)}; }
                else { r0 = r[2 * bj]; r1 = r[2 * bj + 1]; }
                const f32x4 v0 = acc[ai][bj][m][0] + r0, v1 = acc[ai][bj][m][1] + r1;
                q += ((v0[0] * v0[0] + v0[1] * v0[1]) + (v0[2] * v0[2] + v0[3] * v0[3])) + ((v1[0] * v1[0] + v1[1] * v1[1]) + (v1[2] * v1[2] + v1[3] * v1[3]));
                { u32x4 w; w.x = cvt_pk_bf16(v0[0], v0[1]); w.y = cvt_pk_bf16(v0[2], v0[3]); w.z = cvt_pk_bf16(v1[0], v1[1]); w.w = cvt_pk_bf16(v1[2], v1[3]);
                    *(GAS u32x4*)(xb + o) = w; }
            }
            q += __shfl_xor(q, 16); q += __shfl_xor(q, 32);
            if (fq == 0) ((GAS float*)ssq)[(size_t)row * 16 + u.pn * 4 + wc] = q;
            r[0] = nr[0]; r[1] = nr[1]; r[2] = nr[2]; r[3] = nr[3]; rb[0] = nrb[0]; rb[1] = nrb[1];
        }
    }
};

template <bool PERMUTE>
__device__ __forceinline__ void p0_transpose_item(const float* W, int K, int N, bf16* WT, const float* gk, LAS float* scr, int item, int lane) {
    const int nblk = N / 32, kb = item / nblk, nb = item % nblk, k0 = 64 * kb, n0 = 32 * nb;
    const int kr = lane >> 3, c4 = lane & 7;
    const int nsrc = PERMUTE ? orig_col(n0 + 4 * c4) : (n0 + 4 * c4);
    f32x4 wv[8];
#pragma unroll
    for (int i = 0; i < 8; ++i) wv[i] = *(const GAS f32x4*)(W + (size_t)(k0 + 8 * i + kr) * N + nsrc);
#pragma unroll
    for (int i = 0; i < 8; ++i) { const int kk = 8 * i + kr; f32x4 v = wv[i]; if (gk) v = v * gk[k0 + kk];
        LAS float* d = scr + kk * 33 + 4 * c4; d[0] = v[0]; d[1] = v[1]; d[2] = v[2]; d[3] = v[3]; }
    asm volatile("s_waitcnt lgkmcnt(0)" ::: "memory");
    const int c = lane & 7;
#pragma unroll
    for (int j = 0; j < 4; ++j) { const int n = (lane >> 3) + 8 * j; const LAS float* s = scr + (8 * c) * 33 + n;
        u32x4 o; o.x = cvt_pk_bf16(s[0 * 33], s[1 * 33]); o.y = cvt_pk_bf16(s[2 * 33], s[3 * 33]); o.z = cvt_pk_bf16(s[4 * 33], s[5 * 33]); o.w = cvt_pk_bf16(s[6 * 33], s[7 * 33]);
        *(GAS u32x4*)(WT + (size_t)(n0 + n) * K + k0 + 8 * c) = o; }
    asm volatile("s_waitcnt lgkmcnt(0)" ::: "memory");
}

struct Args { const float* in[9]; float* out; unsigned char* ws; int ph_lo, ph_hi; };

__device__ __forceinline__ void phase_prologue(const Args& a, LAS unsigned char* lds, int vcu, int G, int wave, int lane) {
    unsigned char* ws = a.ws;
    LAS float* scr = (LAS float*)(lds + wave * 16384);
    const int gw = vcu * NWAVES + wave, NGW = G * NWAVES;
    constexpr int I_IN = (DM / 64) * (NIN / 32), I_BR = (512 / 64) * (DM / 32), I_OUT = (DM / 64) * (DM / 32), I_L = I_IN + 3 * I_BR + I_OUT;
    for (int it = gw; it < DEPTH * I_L; it += NGW) {
        const int l = it / I_L; int r = it % I_L;
        if (r < I_IN) { p0_transpose_item<true>(a.in[2] + (size_t)l * DM * NIN, DM, NIN, (bf16*)(ws + WS_WIN + l * WIN_L), a.in[1] + l * DM, scr, r, lane); continue; } r -= I_IN;
        if (r < 3 * I_BR) { const int i = r / I_BR; p0_transpose_item<false>(a.in[6] + ((size_t)l * 3 + i) * 512 * DM, 512, DM, (bf16*)(ws + WS_WBR + l * WBR_L) + (size_t)i * DM * 512, nullptr, scr, r % I_BR, lane); continue; } r -= 3 * I_BR;
        p0_transpose_item<false>(a.in[7] + (size_t)l * DM * DM, DM, DM, (bf16*)(ws + WS_WOUT + l * WOUT_L), nullptr, scr, r, lane);
    }
    const float* x = a.in[0]; bf16* xb = (bf16*)(ws + WS_XB); float* ssq = (float*)(ws + WS_SSQ);
    for (int m0 = gw * 4; m0 < T; m0 += NGW * 4) {
        f32x4 v[4][4];
#pragma unroll
        for (int r = 0; r < 4; ++r) { const GAS f32x4* xr = (const GAS f32x4*)(x + (size_t)(m0 + r) * DM) + lane;
#pragma unroll
            for (int j = 0; j < 4; ++j) v[r][j] = xr[64 * j]; }
#pragma unroll
        for (int r = 0; r < 4; ++r) {
            float s = 0.f;
#pragma unroll
            for (int j = 0; j < 4; ++j) s += (v[r][j][0] * v[r][j][0] + v[r][j][1] * v[r][j][1]) + (v[r][j][2] * v[r][j][2] + v[r][j][3] * v[r][j][3]);
            s = wave_sum(s);
            GAS u32x2* o8 = (GAS u32x2*)(xb + (size_t)(m0 + r) * DM) + lane;
#pragma unroll
            for (int j = 0; j < 4; ++j) { u32x2 w; w.x = cvt_pk_bf16(v[r][j][0], v[r][j][1]); w.y = cvt_pk_bf16(v[r][j][2], v[r][j][3]); o8[64 * j] = w; }
            if (lane == 0) ((GAS float*)(ws + WS_RSTD))[m0 + r] = __builtin_amdgcn_rsqf(s * (1.0f / DM) + EPS);
        }
    }
    float2* ropeA = (float2*)(ws + WS_ROPEA); float2* ropeR = (float2*)(ws + WS_ROPER);
    const int gt = gw * 64 + lane, NT_ = NGW * 64;
    for (int i = gt; i < SEQ * 40; i += NT_) {
        float inv; float2* dst;
        if (i < SEQ * 8) { inv = INV_A[i & 7]; dst = ropeA + i; } else { const int k = i - SEQ * 8; inv = INV_R[k & 31]; dst = ropeR + k; }
        const int pos = (i < SEQ * 8) ? (i >> 3) : ((i - SEQ * 8) >> 5);
        const float ang = (float)pos * inv;
        double rev = (double)ang * 0.15915494309189533577; rev -= __builtin_rint(rev);
        const float rf = (float)rev;
        { typedef float f32x2v __attribute__((ext_vector_type(2))); *(GAS f32x2v*)dst = (f32x2v){__builtin_amdgcn_cosf(rf), __builtin_amdgcn_sinf(rf)}; }
    }
}

__device__ __forceinline__ void conv_item(unsigned char* ws, const float* cw, int item, int tid) {
    const bf16* U = (const bf16*)(ws + WS_CX); bf16* GB = (bf16*)(ws + WS_CB);
    const int ch = (tid & 63) * 8, t0 = item * 64 + (tid >> 6) * 8;
    float w0[8], w1[8], w2[8];
#pragma unroll
    for (int e = 0; e < 8; ++e) { w0[e] = cw[ch + e]; w1[e] = cw[512 + ch + e]; w2[e] = cw[1024 + ch + e]; }
    float um2[8], um1[8];
#pragma unroll
    for (int e = 0; e < 8; ++e) { um2[e] = 0.f; um1[e] = 0.f; }
    if ((t0 & (SEQ - 1)) >= 2) { unpack8(*(const GAS u32x4*)(U + (size_t)(t0 - 2) * 512 + ch), um2); unpack8(*(const GAS u32x4*)(U + (size_t)(t0 - 1) * 512 + ch), um1); }
    u32x4 ua[8], ga[8];
#pragma unroll
    for (int i = 0; i < 8; ++i) { const size_t o = (size_t)(t0 + i) * 512 + ch; ua[i] = *(const GAS u32x4*)(U + o); ga[i] = *(const GAS u32x4*)(GB + o); }
#pragma unroll
    for (int i = 0; i < 8; ++i) {
        float u[8], gb[8], y[8]; unpack8(ua[i], u); unpack8(ga[i], gb);
#pragma unroll
        for (int e = 0; e < 8; ++e) { y[e] = gb[e] * (w0[e] * um2[e] + w1[e] * um1[e] + w2[e] * u[e]); um2[e] = um1[e]; um1[e] = u[e]; }
        u32x4 w; w.x = cvt_pk_bf16(y[0], y[1]); w.y = cvt_pk_bf16(y[2], y[3]); w.z = cvt_pk_bf16(y[4], y[5]); w.w = cvt_pk_bf16(y[6], y[7]);
        *(GAS u32x4*)(GB + (size_t)(t0 + i) * 512 + ch) = w;
    }
}

constexpr int R_SQ = 0, R_SK = 18432, R_SVT = 36864, R_SPT = 71680, R_SP = 90112;
__device__ __forceinline__ bf16x8 lds_frag(LAS const unsigned char* p) { return *(LAS const bf16x8*)p; }

struct RetV { u32x4 v[4]; };
__device__ __forceinline__ void load_v(RetV& r, const bf16* Rv, int t0, int h, int tid) {
#pragma unroll
    for (int i = 0; i < 4; ++i) { const int id = tid + i * 512, m = id & 127, chn = id >> 7; r.v[i] = *(const GAS u32x4*)(Rv + (size_t)(t0 + m) * 512 + h * 128 + chn * 8); }
}
__device__ __forceinline__ void stage_vT(LAS unsigned char* lds, const RetV& r, int tid) {
#pragma unroll
    for (int i = 0; i < 4; ++i) {
        const int id = tid + i * 512, m = id & 127, chn = id >> 7; const u32x4 v = r.v[i];
        LAS bf16* d = (LAS bf16*)(lds + R_SVT) + (chn * 8) * 136 + m;
        d[0 * 136] = (bf16)(v.x & 0xffff); d[1 * 136] = (bf16)(v.x >> 16); d[2 * 136] = (bf16)(v.y & 0xffff); d[3 * 136] = (bf16)(v.y >> 16);
        d[4 * 136] = (bf16)(v.z & 0xffff); d[5 * 136] = (bf16)(v.z >> 16); d[6 * 136] = (bf16)(v.w & 0xffff); d[7 * 136] = (bf16)(v.w >> 16);
    }
}
struct RetK { u32x4 k[2]; };
__device__ __forceinline__ void retkv_load(unsigned char* ws, int item, int tid, RetV& rv, RetK& rk) {
    const int bh = item >> 6, n = item & 63, b = bh >> 2, h = bh & 3, t0 = b * SEQ + n * 128;
    load_v(rv, (const bf16*)(ws + WS_RV), t0, h, tid);
    const bf16* Rk = (const bf16*)(ws + WS_RK);
#pragma unroll
    for (int i = 0; i < 2; ++i) { const int id = tid + i * 512, m = id & 127, chn = id >> 7; rk.k[i] = *(const GAS u32x4*)(Rk + (size_t)(t0 + m) * 256 + h * 64 + chn * 8); }
}
__device__ __forceinline__ void retkv_items(unsigned char* ws, LAS unsigned char* lds, int first, int stride, int tid, int wave, int lane) {
    RetV rv; RetK rk;
    if (first < 1024) retkv_load(ws, first, tid, rv, rk);
    for (int item = first; item < 1024; item += stride) {
        const int h = (item >> 6) & 3;
        float* KV = (float*)(ws + WS_KV) + (size_t)item * 8192;
        const float lg = LG2[h];
        stage_vT(lds, rv, tid);
#pragma unroll
        for (int i = 0; i < 2; ++i) {
            const int id = tid + i * 512, m = id & 127, chn = id >> 7; const u32x4 v = rk.k[i];
            const float z = exp2f((float)(127 - m) * lg);
            LAS bf16* d = (LAS bf16*)(lds + R_SQ) + (chn * 8) * 136 + m;
            const unsigned p0 = cvt_pk_bf16(bflo(v.x) * z, bfhi(v.x) * z), p1 = cvt_pk_bf16(bflo(v.y) * z, bfhi(v.y) * z), p2 = cvt_pk_bf16(bflo(v.z) * z, bfhi(v.z) * z), p3 = cvt_pk_bf16(bflo(v.w) * z, bfhi(v.w) * z);
            d[0 * 136] = (bf16)(p0 & 0xffff); d[1 * 136] = (bf16)(p0 >> 16); d[2 * 136] = (bf16)(p1 & 0xffff); d[3 * 136] = (bf16)(p1 >> 16);
            d[4 * 136] = (bf16)(p2 & 0xffff); d[5 * 136] = (bf16)(p2 >> 16); d[6 * 136] = (bf16)(p3 & 0xffff); d[7 * 136] = (bf16)(p3 >> 16);
        }
        if (item + stride < 1024) retkv_load(ws, item + stride, tid, rv, rk);
        __syncthreads();
        const int dt = wave & 3, eg = wave >> 2, lr = lane & 15, lq = lane >> 4;
        f32x4 acc[4];
#pragma unroll
        for (int j = 0; j < 4; ++j) acc[j] = (f32x4){0.f, 0.f, 0.f, 0.f};
#pragma unroll
        for (int kk = 0; kk < 4; ++kk) {
            const bf16x8 af = lds_frag(lds + R_SQ + ((dt * 16 + lr) * 136 + kk * 32 + 8 * lq) * 2);
#pragma unroll
            for (int j = 0; j < 4; ++j) {
                const bf16x8 bfr = lds_frag(lds + R_SVT + (((eg * 4 + j) * 16 + lr) * 136 + kk * 32 + 8 * lq) * 2);
                acc[j] = __builtin_amdgcn_mfma_f32_16x16x32_bf16(af, bfr, acc[j], 0, 0, 0);
            }
        }
#pragma unroll
        for (int j = 0; j < 4; ++j) *(GAS f32x4*)(KV + (size_t)((eg * 4 + j) * 16 + lr) * 64 + dt * 16 + lq * 4) = acc[j];
        __syncthreads();
    }
}
__device__ __forceinline__ void scan_phase(unsigned char* ws, int vcu, int G, int tid, size_t dst_off = WS_PREVT) {
    const float* KV = (const float*)(ws + WS_KV); bf16* DST = (bf16*)(ws + dst_off);
    for (int gid = vcu * 512 + tid; gid < 16 * 8192; gid += G * 512) {
        const int bh = gid >> 13, rem = gid & 8191, h = bh & 3;
        const float decay = exp2f(128.0f * LG2[h]);
        const GAS float* p = (const GAS float*)(KV + ((size_t)bh * 64) * 8192 + rem); GAS bf16* pd = (GAS bf16*)(DST + ((size_t)bh * 64) * 8192 + rem);
        float st = 0.f;
#pragma unroll
        for (int n0 = 0; n0 < 64; n0 += 16) {
            float kv[16];
#pragma unroll
            for (int j = 0; j < 16; ++j) kv[j] = p[(size_t)(n0 + j) * 8192];
#pragma unroll
            for (int j = 0; j < 16; ++j) { pd[(size_t)(n0 + j) * 8192] = (bf16)(cvt_pk_bf16(st, 0.f) & 0xffff); st = decay * st + kv[j]; }
        }
    }
}
struct RetQKP { u32x4 q[2], k[2]; };
__device__ __forceinline__ void retout_load(unsigned char* ws, int item, int tid, RetV& rv) {
    const int bh = item >> 6, n = item & 63, b = bh >> 2, h = bh & 3, t0 = b * SEQ + n * 128;
    load_v(rv, (const bf16*)(ws + WS_RV), t0, h, tid);
}
__device__ __forceinline__ void retout_load_qk(unsigned char* ws, int item, int tid, RetQKP& r) {
    const int bh = item >> 6, n = item & 63, b = bh >> 2, h = bh & 3, t0 = b * SEQ + n * 128;
    const bf16* Rq = (const bf16*)(ws + WS_RQ); const bf16* Rk = (const bf16*)(ws + WS_RK);
#pragma unroll
    for (int i = 0; i < 2; ++i) {
        const int id = tid + i * 512, row = id >> 3, chn = id & 7;
        r.q[i] = *(const GAS u32x4*)(Rq + (size_t)(t0 + row) * 256 + h * 64 + chn * 8);
        r.k[i] = *(const GAS u32x4*)(Rk + (size_t)(t0 + row) * 256 + h * 64 + chn * 8);
    }
}
__device__ __forceinline__ void retout_item(unsigned char* ws, LAS unsigned char* lds, int item, int next_item, RetV& rv, int tid, int wave, int lane, size_t dst_off = WS_SRZ) {
    const int bh = item >> 6, n = item & 63, b = bh >> 2, h = bh & 3, t0 = b * SEQ + n * 128;
    const bf16* Z = (const bf16*)(ws + WS_SRZ); bf16* R = (bf16*)(ws + dst_off); const bf16* PT = (const bf16*)(ws + WS_PREVT) + (size_t)item * 8192;
    const float lg = LG2[h];
    retout_load(ws, item, tid, rv);
    RetQKP rq; retout_load_qk(ws, item, tid, rq);
    u32x4 pt[2];
#pragma unroll
    for (int i = 0; i < 2; ++i) pt[i] = *(const GAS u32x4*)(PT + (size_t)(tid + i * 512) * 8);
    stage_vT(lds, rv, tid);
#pragma unroll
    for (int i = 0; i < 2; ++i) {
        const int id = tid + i * 512, row = id >> 3, chn = id & 7;
        *(LAS u32x4*)(lds + R_SQ + row * 144 + chn * 16) = rq.q[i];
        *(LAS u32x4*)(lds + R_SK + row * 144 + chn * 16) = rq.k[i];
    }
#pragma unroll
    for (int i = 0; i < 2; ++i) { const int id = tid + i * 512, e = id >> 3, chn = id & 7; *(LAS u32x4*)(lds + R_SPT + e * 144 + chn * 16) = pt[i]; }
    __syncthreads();
    const int lr = lane & 15, lq = lane >> 4, c0 = wave * 16;
    bf16x8 aq[2];
#pragma unroll
    for (int kk = 0; kk < 2; ++kk) aq[kk] = lds_frag(lds + R_SQ + ((c0 + lr) * 72 + kk * 32 + 8 * lq) * 2);
#pragma unroll
    for (int mt = 0; mt < 8; ++mt) {
        f32x4 s = (f32x4){0.f, 0.f, 0.f, 0.f};
#pragma unroll
        for (int kk = 0; kk < 2; ++kk) {
            const bf16x8 bk = lds_frag(lds + R_SK + ((mt * 16 + lr) * 72 + kk * 32 + 8 * lq) * 2);
            s = __builtin_amdgcn_mfma_f32_16x16x32_bf16(aq[kk], bk, s, 0, 0, 0);
        }
        const int mm = mt * 16 + lr;
#pragma unroll
        for (int i = 0; i < 4; ++i) {
            const int c = c0 + lq * 4 + i, df = c - mm;
            const float pv = (df >= 0) ? s[i] * exp2f((float)df * lg) : 0.f;
            ((LAS bf16*)(lds + R_SP))[c * 136 + mm] = (bf16)(cvt_pk_bf16(pv, 0.f) & 0xffff);
        }
    }
    f32x4 acc[8];
#pragma unroll
    for (int et = 0; et < 8; ++et) {
        acc[et] = (f32x4){0.f, 0.f, 0.f, 0.f};
#pragma unroll
        for (int kk = 0; kk < 2; ++kk) {
            const bf16x8 bp = lds_frag(lds + R_SPT + ((et * 16 + lr) * 72 + kk * 32 + 8 * lq) * 2);
            acc[et] = __builtin_amdgcn_mfma_f32_16x16x32_bf16(aq[kk], bp, acc[et], 0, 0, 0);
        }
    }
    float xi[4];
#pragma unroll
    for (int i = 0; i < 4; ++i) xi[i] = exp2f((float)(lq * 4 + i + 1 + (c0 & 127)) * lg);
#pragma unroll
    for (int et = 0; et < 8; ++et)
#pragma unroll
        for (int i = 0; i < 4; ++i) acc[et][i] *= xi[i];
    asm volatile("s_waitcnt lgkmcnt(0)" ::: "memory");
#pragma unroll
    for (int kk = 0; kk < 4; ++kk) {
        const bf16x8 ap = lds_frag(lds + R_SP + ((c0 + lr) * 136 + kk * 32 + 8 * lq) * 2);
#pragma unroll
        for (int et = 0; et < 8; ++et) {
            const bf16x8 bv = lds_frag(lds + R_SVT + ((et * 16 + lr) * 136 + kk * 32 + 8 * lq) * 2);
            acc[et] = __builtin_amdgcn_mfma_f32_16x16x32_bf16(ap, bv, acc[et], 0, 0, 0);
        }
    }
    asm volatile("s_waitcnt lgkmcnt(0)" ::: "memory");
#pragma unroll
    for (int i = 0; i < 4; ++i) {
        float q = 0.f;
#pragma unroll
        for (int et = 0; et < 8; ++et) q += acc[et][i] * acc[et][i];
        q += __shfl_xor(q, 1); q += __shfl_xor(q, 2); q += __shfl_xor(q, 4); q += __shfl_xor(q, 8);
        const float rs = __builtin_amdgcn_rsqf(q * (1.0f / 128.0f) + EPS);
        LAS bf16* sp = (LAS bf16*)(lds + R_SP) + (c0 + lq * 4 + i) * 136 + lr;
#pragma unroll
        for (int et = 0; et < 8; ++et) sp[et * 16] = (bf16)(cvt_pk_bf16(acc[et][i] * rs, 0.f) & 0xffff);
    }
    asm volatile("s_waitcnt lgkmcnt(0)" ::: "memory");
#pragma unroll
    for (int i = 0; i < 4; ++i) {
        const int r = i * 4 + lq;
        const u32x4 o = *(LAS const u32x4*)(lds + R_SP + ((c0 + r) * 136 + 8 * lr) * 2);
        GAS u32x4* rp = (GAS u32x4*)(R + (size_t)(t0 + c0 + r) * 512 + h * 128 + 8 * lr);
        const u32x4 z = *(const GAS u32x4*)(Z + (size_t)(t0 + c0 + r) * 512 + h * 128 + 8 * lr);
        u32x4 w;
        w.x = cvt_pk_bf16(bflo(o.x) * bflo(z.x), bfhi(o.x) * bfhi(z.x)); w.y = cvt_pk_bf16(bflo(o.y) * bflo(z.y), bfhi(o.y) * bfhi(z.y));
        w.z = cvt_pk_bf16(bflo(o.z) * bflo(z.z), bfhi(o.z) * bfhi(z.z)); w.w = cvt_pk_bf16(bflo(o.w) * bflo(z.w), bfhi(o.w) * bfhi(z.w));
        *rp = w;
    }
    __syncthreads();
}

__device__ __forceinline__ void attn_post(unsigned char* ws, int b, int h, int qi, const bf16* otmp, int l, const float* lp, const float* subg, size_t dst_off = WS_SZA) {
    int tid_ = threadIdx.x; asm volatile("" : "+v"(tid_));
    const int lane = tid_ & 63, wave = __builtin_amdgcn_readfirstlane(tid_ >> 6);
    const float e1 = wave_sum(lp[lane] * lp[64 + lane]), e2 = wave_sum(lp[128 + lane] * lp[192 + lane]);
    const float lam_init = 0.8f - 0.6f * expf(-0.3f * (float)l);
    const float lam = expf(e1) - expf(e2) + lam_init, oml = 1.0f - lam_init;
    asm volatile("s_waitcnt vmcnt(0)" ::: "memory");
    __syncthreads();
    __builtin_amdgcn_fence(__ATOMIC_ACQUIRE, "agent");
    bf16* A = (bf16*)(ws + dst_off); const bf16* ZA = (const bf16*)(ws + WS_SZA);
    const int lr = lane & 15, lq = lane >> 4;
    float gg[8];
#pragma unroll
    for (int e = 0; e < 8; ++e) gg[e] = subg[8 * lr + e] * oml;
#pragma unroll 4
    for (int it = 0; it < 8; ++it) {
        const int row = wave * 32 + it * 4 + lq;
        const u32x4 o0 = *(const GAS u32x4*)(otmp + row * 256 + 8 * lr), o1 = *(const GAS u32x4*)(otmp + row * 256 + 128 + 8 * lr);
        GAS u32x4* ap = (GAS u32x4*)(A + (size_t)(b * SEQ + qi * 256 + row) * 512 + h * 128 + 8 * lr);
        const u32x4 z = *(const GAS u32x4*)(ZA + (size_t)(b * SEQ + qi * 256 + row) * 512 + h * 128 + 8 * lr);
        float d[8] = {bflo(o0.x) - lam * bflo(o1.x), bfhi(o0.x) - lam * bfhi(o1.x), bflo(o0.y) - lam * bflo(o1.y), bfhi(o0.y) - lam * bfhi(o1.y),
                      bflo(o0.z) - lam * bflo(o1.z), bfhi(o0.z) - lam * bfhi(o1.z), bflo(o0.w) - lam * bflo(o1.w), bfhi(o0.w) - lam * bfhi(o1.w)};
        float ss = ((d[0] * d[0] + d[1] * d[1]) + (d[2] * d[2] + d[3] * d[3])) + ((d[4] * d[4] + d[5] * d[5]) + (d[6] * d[6] + d[7] * d[7]));
        ss += __shfl_xor(ss, 1); ss += __shfl_xor(ss, 2); ss += __shfl_xor(ss, 4); ss += __shfl_xor(ss, 8);
        const float rs = __builtin_amdgcn_rsqf(ss * (1.0f / 128.0f) + EPS);
        const float zz[8] = {bflo(z.x), bfhi(z.x), bflo(z.y), bfhi(z.y), bflo(z.z), bfhi(z.z), bflo(z.w), bfhi(z.w)};
#pragma unroll
        for (int e = 0; e < 8; ++e) d[e] = d[e] * rs * gg[e] * zz[e];
        u32x4 w; w.x = cvt_pk_bf16(d[0], d[1]); w.y = cvt_pk_bf16(d[2], d[3]); w.z = cvt_pk_bf16(d[4], d[5]); w.w = cvt_pk_bf16(d[6], d[7]);
        *ap = w;
    }
    asm volatile("s_waitcnt vmcnt(0)" ::: "memory");
    __syncthreads();
}
__device__ __forceinline__ void attn_phase(unsigned char* ws, char* lds, int vcu, int G, int bx, int l, const float* lp, const float* subg) {
    const attn_body::bf16* Qa = (const attn_body::bf16*)(ws + WS_QA); const attn_body::bf16* Ka = (const attn_body::bf16*)(ws + WS_KA); const attn_body::bf16* Va = (const attn_body::bf16*)(ws + WS_VA);
    bf16* otmp = (bf16*)(ws + WS_OTMP) + (size_t)bx * 65536;
    for (int v = vcu; v < 256; v += G) {
        const int xg = v >> 5, j = v & 31;
        for (int u4 = 0; u4 < 4; ++u4) {
            const int bh = 2 * xg + (u4 >> 1), b = bh >> 2, h = bh & 3;
            const int qi = (u4 < 2) ? j : 31 - j, c = u4 & 1;
            for (int rp = 0; rp < REP_ATTN; ++rp) attn_body::attn_unit128<8, 512, 512, 512, 256>(qi * 256, Qa + (size_t)(b * SEQ + qi * 256) * 512 + (h * 2 + c) * 64, Ka + (size_t)(b * SEQ) * 512 + (h * 2 + c) * 64,
                                                        Va + (size_t)(b * SEQ) * 512 + h * 128, (attn_body::bf16*)otmp + c * 128, lds);
            if (c == 1) {
#ifdef PROBE_LIGHT
                attn_post(ws, b, h, qi, otmp, l, lp, subg, WS_SCZ);
#endif
                attn_post(ws, b, h, qi, otmp, l, lp, subg);
            }
        }
    }
}

#define GAS __attribute__((address_space(1)))
#define RLX_AGENT __ATOMIC_RELAXED, __HIP_MEMORY_SCOPE_AGENT
#define LDS_WAIT() asm volatile("s_waitcnt lgkmcnt(0)" ::: "memory")
#define VM_WAIT() asm volatile("s_waitcnt vmcnt(0)" ::: "memory")
__device__ __forceinline__ unsigned long long rt() { return __builtin_amdgcn_s_memrealtime(); }
#define XB_TMO      128
#define XB_XCNT(j)  (256  + 64 * (j))
#define XB_XSUB(j)  (1280 + 64 * (j))
#define XB_XGEN(j)  (2304 + 64 * (j))
#define XB_TOP      3328
#define XB_TOPGEN   3392
#define XCD_BAR_WORDS 3456
#define XB_SPIN_CAP (1u << 18)

__device__ __forceinline__ unsigned xb_ld(unsigned* p)              { return __hip_atomic_load(p, __ATOMIC_RELAXED, __HIP_MEMORY_SCOPE_AGENT); }
__device__ __forceinline__ unsigned xb_add(unsigned* p, unsigned v) { return __hip_atomic_fetch_add(p, v, __ATOMIC_RELAXED, __HIP_MEMORY_SCOPE_AGENT); }
__device__ __forceinline__ unsigned xb_xcc_id() { return (unsigned)__builtin_amdgcn_s_getreg((3 << 11) | 20) & 0xFu; }
#define XB_SPIN(cond, bar) do { unsigned _sp = 0; while (cond) { __builtin_amdgcn_s_sleep(1); \
    if ((++_sp & 255u) == 0u) { if (xb_ld(&(bar)[XB_TMO])) break; if (_sp > XB_SPIN_CAP) { atomicAdd(&(bar)[XB_TMO], 1u); break; } } } } while (0)

struct XcdBarrier {
    unsigned* bar; unsigned x;
    volatile LAS unsigned* st;
};

__device__ __forceinline__ XcdBarrier xcd_barrier_post(unsigned* bar, volatile LAS unsigned* st) {
    XcdBarrier b; b.bar = bar; b.x = xb_xcc_id(); b.st = st;
    if (threadIdx.x == 0) (void)xb_add(&bar[XB_XCNT(b.x)], 1u);
    return b;
}
__device__ __forceinline__ void xcd_barrier_complete(unsigned* bar, unsigned x, unsigned& nloc, unsigned& nx) {
    const unsigned G = gridDim.x * gridDim.y * gridDim.z;
    unsigned sum, cnt, mine, sp = 0u;
    for (;;) {
        sum = 0u; cnt = 0u; mine = 0u;
#pragma unroll
        for (unsigned j = 0; j < 16; ++j) { const unsigned c = xb_ld(&bar[XB_XCNT(j)]); sum += c; cnt += (c > 0u) ? 1u : 0u; mine = (j == x) ? c : mine; }
        if (sum == G) break;
        __builtin_amdgcn_s_sleep(1);
        if ((++sp & 255u) == 0u) { if (xb_ld(&bar[XB_TMO])) break; if (sp > XB_SPIN_CAP) { atomicAdd(&bar[XB_TMO], 1u); break; } }
    }
    nloc = mine > 0u ? mine : 1u; nx = cnt > 0u ? cnt : 1u;
}

__device__ __forceinline__ void xcd_barrier(const XcdBarrier& b) {
    asm volatile("s_waitcnt vmcnt(0)" ::: "memory");
    __syncthreads();
    if (threadIdx.x == 0) {
        unsigned* bar = b.bar;
        __builtin_amdgcn_s_waitcnt(0);
        unsigned nloc = b.st[0], nx = b.st[1];
        if (nloc == 0u) { xcd_barrier_complete(bar, b.x, nloc, nx); b.st[0] = nloc; b.st[1] = nx; }
        const unsigned old = xb_add(&bar[XB_XSUB(b.x)], 1u);
        const unsigned gen = old / nloc;
        if (old + 1u == (gen + 1u) * nloc) {
            __builtin_amdgcn_fence(__ATOMIC_RELEASE, "agent");
            asm volatile("s_waitcnt vmcnt(0)" ::: "memory");
            const unsigned og = xb_add(&bar[XB_TOP], 1u);
            const unsigned tg = og / nx;
            if (og + 1u == (tg + 1u) * nx) xb_add(&bar[XB_TOPGEN], 1u);
            else XB_SPIN(xb_ld(&bar[XB_TOPGEN]) == tg, bar);
            __builtin_amdgcn_fence(__ATOMIC_ACQUIRE, "agent");
            xb_add(&bar[XB_XGEN(b.x)], 1u);
            asm volatile("s_waitcnt vmcnt(0)" ::: "memory");
        } else {
            XB_SPIN(xb_ld(&bar[XB_XGEN(b.x)]) == gen, bar);
            __builtin_amdgcn_fence(__ATOMIC_ACQUIRE, "agent");
            asm volatile("s_waitcnt vmcnt(0)" ::: "memory");
        }
    }
    __syncthreads();
}

constexpr int PH_PER_LAYER = 6, N_PHASES = 1 + DEPTH * PH_PER_LAYER + 1;

__global__ void __launch_bounds__(NWAVES * 64, 2) trunk_fwd(Args args) {
    extern __shared__ __attribute__((aligned(16))) unsigned char lds_raw[];
    LAS unsigned char* lds = (LAS unsigned char*)lds_raw;
#define TIDS() int tid = threadIdx.x; asm volatile("" : "+v"(tid)); const int lane = tid & 63, wave = __builtin_amdgcn_readfirstlane(tid >> 6); (void)lane; (void)wave
#define WSO() unsigned char* ws = args.ws; asm volatile("" : "+s"(ws)); float* ssq = (float*)(ws + WS_SSQ); bf16* xb = (bf16*)(ws + WS_XB); (void)ssq; (void)xb
    const int G = gridDim.x, bx = blockIdx.x;
    const int vcu = (G % 8 == 0) ? (bx % 8) * (G / 8) + bx / 8 : bx;
    const int lo = args.ph_lo, hi = args.ph_hi;
#if MK_MULTI
#define SEAM() do {} while (0)
#else
    cg::grid_group grid = cg::this_grid();
    volatile LAS unsigned* bst = (volatile LAS unsigned*)(lds + LDS_BYTES - 16);
    if (threadIdx.x < 2) bst[threadIdx.x] = 0u;
    __syncthreads();
    XcdBarrier bar = xcd_barrier_post((unsigned*)args.ws, bst);
#define SEAM() xcd_barrier(bar)
#endif
#ifndef PHASE_MASK
#define PHASE_MASK 0x1ff
#endif
#define PH_ON(t) ((PHASE_MASK >> (t)) & 1)
#define IN(k) (lo <= (k) && (k) < hi)
#define BOTH(k) (IN(k) && IN((k) + 1))

    if (PH_ON(0) && IN(0)) { TIDS();
#if defined(PROBE_LIGHT) || defined(PROBE_PRO)
        phase_prologue(args, lds, vcu, G, wave, lane);
#endif
        phase_prologue(args, lds, vcu, G, wave, lane); if (BOTH(0)) {
#if MK_MULTI
        SEAM();
#else
        grid.sync();
#endif
    } }

    for (int l = 0; l < DEPTH; ++l) {
        const int p0 = 1 + l * PH_PER_LAYER;
        if (PH_ON(1) && IN(p0)) {
            WSO(); const bf16* Win = (const bf16*)(ws + WS_WIN + l * WIN_L);
            pg8::Gemm g{xb, xb, xb, Win, 0, T, NPROJ, DM}; pg8::StaticOrder S; S.init(T, NPROJ, G, bx);
            float* rstd = (float*)(ws + WS_RSTD) + (size_t)l * T;
            if (l > 0) {
                TIDS(); int lastpm = -1; pg8::Unit uu;
                for (int i = 0; S.next(i, uu); ++i) if (uu.pm != lastpm) { lastpm = uu.pm;
                    const int row = uu.pm * 256 + (tid >> 1); const GAS f32x4* sp = (const GAS f32x4*)(ssq + (size_t)row * 16 + (tid & 1) * 8);
                    const f32x4 a0 = sp[0], a1 = sp[1]; float s = ((a0[0] + a0[1]) + (a0[2] + a0[3])) + ((a1[0] + a1[1]) + (a1[2] + a1[3])); s += __shfl_xor(s, 1);
                    if ((tid & 1) == 0) ((GAS float*)rstd)[row] = __builtin_amdgcn_rsqf(s * (1.0f / DM) + EPS); }
                asm volatile("s_waitcnt vmcnt(0)" ::: "memory"); __syncthreads();
            }
            EpiProj E{ws, rstd, (const float2*)(ws + WS_ROPEA), (const float2*)(ws + WS_ROPER)};
            for (int rp = 0; rp < REP_GEMM; ++rp) pg8::gemm_phase<EpiProj, pg8::StaticOrder, true, true>(lds, g, S, E);
            if (BOTH(p0)) SEAM();
        }
        if (PH_ON(2) && IN(p0 + 1)) {
            WSO();
            TIDS();
            for (int rp = 0; rp < REP_LIGHT; ++rp) retkv_items(ws, lds, vcu, G, tid, wave, lane);
            for (int it = vcu; it < T / 64; it += G) conv_item(ws, args.in[5] + (size_t)l * 3 * 512, it, tid);
            if (BOTH(p0 + 1)) SEAM();
        }
        if (PH_ON(4) && IN(p0 + 2)) {
            WSO();
            { TIDS();
#ifdef PROBE_LIGHT
              scan_phase(ws, vcu, G, tid, WS_SCZ);
#endif
              scan_phase(ws, vcu, G, tid); }
            attn_phase(ws, (char*)lds_raw, vcu, G, bx, l, args.in[3] + (size_t)l * 4 * 64, args.in[4] + l * 128);
            if (BOTH(p0 + 2)) SEAM();
        }
        if (PH_ON(5) && IN(p0 + 3)) {
            WSO();
            const bf16* Win = (const bf16*)(ws + WS_WIN + l * WIN_L);
            pg8::Gemm g{xb, xb, xb, Win + (size_t)NPROJ * DM, 0, T, NGATE, DM}; pg8::StaticOrder S; S.init(T, NGATE, G, bx);
            EpiGate E{(bf16*)(ws + WS_G), (const float*)(ws + WS_RSTD) + (size_t)l * T};
            const int nb = bx & 3;
            for (int st = 0; st < 3; ++st) {
                if (st == 1) { for (int rp = 0; rp < REP_GEMM; ++rp) pg8::gemm_phase<EpiGate, pg8::StaticOrder, true, true>(lds, g, S, E); }
                else { TIDS(); RetV rv;
                    const int k0 = (st == 0) ? 0 : nb, k1 = (st == 0) ? nb : 4;
                    for (int k = k0; k < k1; ++k) { const int it = vcu + k * G; if (it < 1024) retout_item(ws, lds, it, it + G, rv, tid, wave, lane); }
                }
            }
            if (BOTH(p0 + 3)) SEAM();
        }
        if (PH_ON(6) && IN(p0 + 4)) {
            WSO();
            pg8::Gemm g{(const bf16*)(ws + WS_SZA), (const bf16*)(ws + WS_CB), (const bf16*)(ws + WS_SRZ), (const bf16*)(ws + WS_WBR + l * WBR_L), (size_t)DM * 512 * 2, T, DM, 512};
            ChainOrder S; S.S.init(T, DM, G, bx);
            EpiChain E{(const bf16*)(ws + WS_G), (bf16*)(ws + WS_MERGED)};
            for (int rp = 0; rp < REP_GEMM; ++rp) pg8::gemm_phase<EpiChain, ChainOrder, true, true>(lds, g, S, E);
            if (BOTH(p0 + 4)) SEAM();
        }
        if (PH_ON(7) && IN(p0 + 5)) {
            WSO();
            const bf16* mg = (const bf16*)(ws + WS_MERGED);
            pg8::Gemm g{mg, mg, mg, (const bf16*)(ws + WS_WOUT + l * WOUT_L), 0, T, DM, DM}; pg8::StaticOrder S; S.init(T, DM, G, bx);
            static_assert(DEPTH == 2, "residual hand-over below is written for two layers: layer 0 reads the f32 input, the last layer reads the bf16 stream");
            if (l + 1 < DEPTH) { EpiOutT<false> E{args.in[0], nullptr, nullptr, xb, ssq}; pg8::gemm_phase<EpiOutT<false>, pg8::StaticOrder, true, true>(lds, g, S, E); }
            else { EpiOutT<true> E{nullptr, xb, nullptr, xb, ssq}; pg8::gemm_phase<EpiOutT<true>, pg8::StaticOrder, true, true>(lds, g, S, E); }
            if (BOTH(p0 + 5)) SEAM();
        }
    }
    if (PH_ON(8) && IN(N_PHASES - 1)) {
        WSO(); TIDS(); const float* gf = args.in[8]; float* out = args.out;
        const int gw = vcu * NWAVES + wave, NGW = G * NWAVES;
        f32x4 gv[4];
#pragma unroll
        for (int j = 0; j < 4; ++j) gv[j] = *(const GAS f32x4*)(gf + (j >> 1) * 512 + 8 * lane + (j & 1) * 4);
        for (int m0 = gw * 4; m0 < T; m0 += NGW * 4) {
            u32x4 v[4][2]; float sv[4];
#pragma unroll
            for (int r = 0; r < 4; ++r) { const bf16* xr = xb + (size_t)(m0 + r) * DM + 8 * lane; sv[r] = (lane < 16) ? ((const GAS float*)ssq)[(size_t)(m0 + r) * 16 + lane] : 0.f;
                v[r][0] = *(const GAS u32x4*)xr; v[r][1] = *(const GAS u32x4*)(xr + 512); }
#pragma unroll
            for (int r = 0; r < 4; ++r) {
                float s = sv[r];
                s += __shfl_xor(s, 1); s += __shfl_xor(s, 2); s += __shfl_xor(s, 4); s += __shfl_xor(s, 8);
                s = __shfl(s, 0);
                const float rs = __builtin_amdgcn_rsqf(s * (1.0f / DM) + EPS);
                float* xw = out + (size_t)(m0 + r) * DM + 8 * lane;
#pragma unroll
                for (int hb = 0; hb < 2; ++hb) {
                    const u32x4 w = v[r][hb];
                    const f32x4 a = (f32x4){bflo(w.x), bfhi(w.x), bflo(w.y), bfhi(w.y)}, b = (f32x4){bflo(w.z), bfhi(w.z), bflo(w.w), bfhi(w.w)};
                    *(GAS f32x4*)(xw + hb * 512) = a * rs * gv[2 * hb]; *(GAS f32x4*)(xw + hb * 512 + 4) = b * rs * gv[2 * hb + 1];
                }
            }
        }
    }
#undef IN
#undef BOTH
#undef SEAM
}

extern "C" void kernel_launch(void* const* d_in, const int* in_sizes, int n_in, void* d_out, int out_size, void* d_ws, size_t ws_size, hipStream_t stream) {
    static int grid = 0;
    if (grid == 0) {
        if (n_in != 9 || in_sizes[0] != T * DM || out_size != T * DM || ws_size < WS_END) { fprintf(stderr, "kernel_launch: unexpected shapes / workspace (n_in %d, ws %zu)\n", n_in, ws_size); grid = -1; return; }
        int dev = 0, cus = 0, per_cu = 0;
        (void)hipGetDevice(&dev); (void)hipDeviceGetAttribute(&cus, hipDeviceAttributeMultiprocessorCount, dev);
        if (hipFuncSetAttribute((const void*)trunk_fwd, hipFuncAttributeMaxDynamicSharedMemorySize, LDS_BYTES) != hipSuccess) { fprintf(stderr, "kernel_launch: hipFuncSetAttribute failed\n"); grid = -1; return; }
        if (hipOccupancyMaxActiveBlocksPerMultiprocessor(&per_cu, (const void*)trunk_fwd, NWAVES * 64, LDS_BYTES) != hipSuccess || per_cu < 1) { fprintf(stderr, "kernel_launch: occupancy query gave %d\n", per_cu); per_cu = 1; }
        (void)hipGetLastError();
        grid = cus * per_cu;
    }
    if (grid < 0) return;
    Args a{};
    for (int i = 0; i < 9; ++i) a.in[i] = (const float*)d_in[i];
    a.out = (float*)d_out; a.ws = (unsigned char*)d_ws;
#if MK_MULTI
    for (int p = 0; p < N_PHASES; ++p) { a.ph_lo = p; a.ph_hi = p + 1; hipLaunchKernelGGL(trunk_fwd, dim3(grid), dim3(NWAVES * 64), LDS_BYTES, stream, a); }
#else
    a.ph_lo = 0; a.ph_hi = N_PHASES;
    if (hipMemsetAsync(d_ws, 0, 16384, stream) != hipSuccess) { fprintf(stderr, "kernel_launch: memset of the barrier words failed\n"); return; }
    void* kargs[] = {&a};
    hipError_t e = hipLaunchCooperativeKernel((const void*)trunk_fwd, dim3(grid), dim3(NWAVES * 64), kargs, LDS_BYTES, stream);
    if (e != hipSuccess) fprintf(stderr, "kernel_launch: cooperative launch failed: %s (grid %d)\n", hipGetErrorString(e), grid);
#endif
}
```
